# Optimizing an MI355X kernel written in HIP

```python
import math
import jax, jax.numpy as jnp
from jax import lax
import numpy as np

D_MODEL = 1024
BATCH = 1
SEQ = 16384
DEPTH = 1
DEC_BATCH = 32
DEC_SEQ = 32
PAST_LEN = 1024

CHUNK = 64
Q_BLOCK = 128
SSM_WIDTH = D_MODEL // 2
SSM_GROUP = 16
SSM_GROUPS = SSM_WIDTH // SSM_GROUP
SSM_STATE = 64
DT_MIN = 1e-3
DT_MAX = 1e-1
MLA_HEADS = 4
QK_NOPE = 128
QK_ROPE = 64
V_HEAD = 128
MLA_WIDTH = MLA_HEADS * V_HEAD
Q_LORA = 384
KV_LORA = 256
ROPE_THETA = 10000.0
MLA_SCALE = (QK_NOPE + QK_ROPE) ** -0.5
IN_WIDTH = SSM_WIDTH + Q_LORA + KV_LORA + QK_ROPE
MIX_WIDTH = SSM_WIDTH + MLA_WIDTH
N_MEM = 256
X_HEADS = 4
X_HEAD_DIM = D_MODEL // X_HEADS
D_FF = 4 * D_MODEL
ALPHA = (2 * DEPTH) ** 0.25
BETA = (8 * DEPTH) ** -0.25
EPS = 1e-5
NEG_INF = -1e30

kernel_name = "hymba_s5_mla_deepnorm_stream_step"


def _layer_norm(x, g, b):
    xf = x.astype(jnp.float32)
    mu = jnp.mean(xf, -1, keepdims=True)
    var = jnp.mean(jnp.square(xf - mu), -1, keepdims=True)
    return ((xf - mu) * lax.rsqrt(var + EPS) * g.astype(jnp.float32) + b.astype(jnp.float32)).astype(x.dtype)


def _rms_norm(x, g):
    xf = x.astype(jnp.float32)
    return (xf * lax.rsqrt(jnp.mean(xf * xf, -1, keepdims=True) + EPS) * g.astype(jnp.float32)).astype(x.dtype)


def _rope(x, pos):
    half = QK_ROPE // 2
    inv = ROPE_THETA ** (-jnp.arange(half, dtype=jnp.float32) / half)
    ang = pos.astype(jnp.float32)[:, None] * inv[None, :]
    cos = jnp.cos(ang)[None, :, None, :]
    sin = jnp.sin(ang)[None, :, None, :]
    xf = x.astype(jnp.float32)
    x1, x2 = xf[..., :half], xf[..., half:]
    return jnp.concatenate([x1 * cos - x2 * sin, x2 * cos + x1 * sin], -1).astype(x.dtype)


def _chunk_attend(q, k, v, q_pos, k_pos):
    s = jnp.einsum('bqhd,bkhd->bhqk', q, k).astype(jnp.float32) * MLA_SCALE
    mask = (k_pos // CHUNK)[None, :] <= (q_pos // CHUNK)[:, None]
    s = jnp.where(mask[None, None], s, NEG_INF)
    p = jax.nn.softmax(s, axis=-1).astype(v.dtype)
    return jnp.einsum('bhqk,bkhd->bqhd', p, v)


def _blocked_attend(q, k, v, q_pos, k_pos):
    b, s, hh, dk = q.shape
    nblk = s // Q_BLOCK
    qb = jnp.moveaxis(q.reshape(b, nblk, Q_BLOCK, hh, dk), 1, 0)
    pb = q_pos.reshape(nblk, Q_BLOCK)
    ob = lax.map(lambda qp: _chunk_attend(qp[0], k, v, qp[1], k_pos), (qb, pb))
    return jnp.moveaxis(ob, 0, 1).reshape(b, s, hh, v.shape[-1])


def _s5_scan(u, h0_re, h0_im, a_re, a_im, b_re, b_im, c_re, c_im, d_skip, log_dt):
    nb, s = u.shape[:2]
    f32 = jnp.float32
    ug = u.astype(f32).reshape(nb, s, SSM_GROUPS, SSM_GROUP)
    ar, ai = a_re.astype(f32), a_im.astype(f32)
    dt = jnp.exp(log_dt.astype(f32))[:, None]
    mag = jnp.exp(ar * dt)
    lb_re, lb_im = mag * jnp.cos(ai * dt), mag * jnp.sin(ai * dt)
    nr, ni = lb_re - 1.0, lb_im
    den = ar * ar + ai * ai
    f_re, f_im = (nr * ar + ni * ai) / den, (ni * ar - nr * ai) / den
    br, bi = b_re.astype(f32), b_im.astype(f32)
    bb_re = f_re[..., None] * br - f_im[..., None] * bi
    bb_im = f_re[..., None] * bi + f_im[..., None] * br
    bu_re = jnp.einsum('gph,bsgh->bsgp', bb_re, ug)
    bu_im = jnp.einsum('gph,bsgh->bsgp', bb_im, ug)
    h0r, h0i = h0_re.astype(f32), h0_im.astype(f32)
    bu_re = bu_re.at[:, 0].add(lb_re * h0r - lb_im * h0i)
    bu_im = bu_im.at[:, 0].add(lb_re * h0i + lb_im * h0r)
    a_seq_re = jnp.broadcast_to(lb_re, bu_re.shape)
    a_seq_im = jnp.broadcast_to(lb_im, bu_im.shape)

    def combine(e1, e2):
        a1r, a1i, b1r, b1i = e1
        a2r, a2i, b2r, b2i = e2
        return (a1r * a2r - a1i * a2i, a1r * a2i + a1i * a2r,
                a2r * b1r - a2i * b1i + b2r, a2r * b1i + a2i * b1r + b2i)

    _, _, xr, xi = lax.associative_scan(combine, (a_seq_re, a_seq_im, bu_re, bu_im), axis=1)
    y = (jnp.einsum('ghp,bsgp->bsgh', c_re.astype(f32), xr)
         - jnp.einsum('ghp,bsgp->bsgh', c_im.astype(f32), xi)
         + d_skip.astype(f32) * ug)
    return y.reshape(nb, s, SSM_WIDTH).astype(u.dtype), xr[:, -1], xi[:, -1]


def _token_mixer(h, pos, past_ckv, past_kpe, ssm0_re, ssm0_im, block_sweep,
                 w_in, g_q, w_q_up, g_kv, w_kv_up, a_re, a_im, b_re, b_im, c_re, c_im,
                 d_skip, log_dt, w_glu, g_out_ssm, g_out_mla, w_o):
    nb, s = h.shape[:2]
    proj = jnp.einsum('bsd,de->bse', h, w_in)
    u, c_q, c_kv, k_pe = jnp.split(
        proj, [SSM_WIDTH, SSM_WIDTH + Q_LORA, SSM_WIDTH + Q_LORA + KV_LORA], axis=-1)
    y_ssm, ssm_re, ssm_im = _s5_scan(u, ssm0_re, ssm0_im, a_re, a_im, b_re, b_im,
                                     c_re, c_im, d_skip, log_dt)
    g = jnp.einsum('bsc,ce->bse', jax.nn.gelu(y_ssm), w_glu)
    o_ssm = g[..., :SSM_WIDTH] * jax.nn.sigmoid(g[..., SSM_WIDTH:])
    q = jnp.einsum('bsr,rhe->bshe', _rms_norm(c_q, g_q), w_q_up)
    q = jnp.concatenate([q[..., :QK_NOPE], _rope(q[..., QK_NOPE:], pos)], -1)
    ckv_new = _rms_norm(c_kv, g_kv)
    kpe_new = _rope(k_pe[:, :, None, :], pos)[:, :, 0, :]
    if past_ckv is None:
        ckv_all, kpe_all, k_pos = ckv_new, kpe_new, pos
    else:
        past_len = past_ckv.shape[1]
        ckv_all = jnp.concatenate([past_ckv.astype(ckv_new.dtype), ckv_new], 1)
        kpe_all = jnp.concatenate([past_kpe.astype(kpe_new.dtype), kpe_new], 1)
        k_pos = jnp.concatenate([jnp.arange(past_len, dtype=jnp.int32), pos])
    kv = jnp.einsum('bsr,rhe->bshe', ckv_all, w_kv_up)
    k = jnp.concatenate(
        [kv[..., :QK_NOPE], jnp.broadcast_to(kpe_all[:, :, None, :], kv.shape[:3] + (QK_ROPE,))], -1)
    v = kv[..., QK_NOPE:]
    if block_sweep:
        attn = _blocked_attend(q, k, v, pos, k_pos)
    else:
        attn = _chunk_attend(q, k, v, pos, k_pos)
    o_mla = attn.reshape(nb, s, MLA_WIDTH)
    mixed = jnp.concatenate([_rms_norm(o_ssm, g_out_ssm), _rms_norm(o_mla, g_out_mla)], -1)
    return jnp.einsum('bsc,cd->bsd', mixed, w_o), ckv_new, kpe_new, ssm_re, ssm_im


def _mem_kv(mem, w_xk, w_xv):
    return (jnp.einsum('bmd,dhe->bmhe', mem, w_xk), jnp.einsum('bmd,dhe->bmhe', mem, w_xv))


def _mem_attend(h, mem_k, mem_v, w_xq, w_xo):
    q = jnp.einsum('bsd,dhe->bshe', h, w_xq)
    s = jnp.einsum('bshe,bmhe->bhsm', q, mem_k.astype(q.dtype)).astype(jnp.float32) * (X_HEAD_DIM ** -0.5)
    p = jax.nn.softmax(s, axis=-1).astype(q.dtype)
    o = jnp.einsum('bhsm,bmhe->bshe', p, mem_v.astype(q.dtype))
    return jnp.einsum('bshe,hed->bsd', o, w_xo)


def _sq_relu_mlp(h, w_ff1, w_ff2):
    z = jax.nn.relu(jnp.einsum('bsd,df->bsf', h, w_ff1))
    return jnp.einsum('bsf,fd->bsd', z * z, w_ff2)


def _layer(h, pos, past_ckv, past_kpe, ssm0_re, ssm0_im, mem_k, mem_v, block_sweep,
           w_in, g_q, w_q_up, g_kv, w_kv_up, a_re, a_im, b_re, b_im, c_re, c_im, d_skip,
           log_dt, w_glu, g_out_ssm, g_out_mla, w_o, w_xq, w_xo, w_ff1, w_ff2, ln_g, ln_b):
    a, ckv, kpe, sr, si = _token_mixer(
        h, pos, past_ckv, past_kpe, ssm0_re, ssm0_im, block_sweep,
        w_in, g_q, w_q_up, g_kv, w_kv_up, a_re, a_im, b_re, b_im, c_re, c_im,
        d_skip, log_dt, w_glu, g_out_ssm, g_out_mla, w_o)
    h = _layer_norm(ALPHA * h + a, ln_g[0], ln_b[0])
    h = _layer_norm(ALPHA * h + _mem_attend(h, mem_k, mem_v, w_xq, w_xo), ln_g[1], ln_b[1])
    h = _layer_norm(ALPHA * h + _sq_relu_mlp(h, w_ff1, w_ff2), ln_g[2], ln_b[2])
    return h, ckv, kpe, sr, si


def setup_inputs(seed: int = 0) -> dict:
    key = jax.random.key(seed)
    ks = iter(jax.random.split(key, 40))
    f32 = jnp.float32

    def nrm(shape, scale):
        return jax.random.normal(next(ks), shape, f32) * scale

    L, G, P, H = DEPTH, SSM_GROUPS, SSM_STATE, SSM_GROUP
    n = jnp.arange(P, dtype=f32)
    log_dt = math.log(DT_MIN) + jax.random.uniform(next(ks), (L, G), f32) * (math.log(DT_MAX) - math.log(DT_MIN))
    return {
        "x_prompt": nrm((BATCH, SEQ, D_MODEL), 1.0),
        "x_sample": nrm((DEC_BATCH, DEC_SEQ, D_MODEL), 1.0),
        "mem_prompt": nrm((BATCH, N_MEM, D_MODEL), 1.0),
        "cache_mla_ckv": nrm((L, DEC_BATCH, PAST_LEN, KV_LORA), 1.0),
        "cache_mla_kpe": nrm((L, DEC_BATCH, PAST_LEN, QK_ROPE), 1.0),
        "state_ssm_re": nrm((L, DEC_BATCH, G, P), 0.1),
        "state_ssm_im": nrm((L, DEC_BATCH, G, P), 0.1),
        "cache_mem_k": nrm((L, DEC_BATCH, N_MEM, X_HEADS, X_HEAD_DIM), 1.0),
        "cache_mem_v": nrm((L, DEC_BATCH, N_MEM, X_HEADS, X_HEAD_DIM), 1.0),
        "w_in": nrm((L, D_MODEL, IN_WIDTH), D_MODEL ** -0.5),
        "g_q": 1.0 + nrm((L, Q_LORA), 0.01),
        "w_q_up": nrm((L, Q_LORA, MLA_HEADS, QK_NOPE + QK_ROPE), Q_LORA ** -0.5),
        "g_kv": 1.0 + nrm((L, KV_LORA), 0.01),
        "w_kv_up": nrm((L, KV_LORA, MLA_HEADS, QK_NOPE + V_HEAD), KV_LORA ** -0.5),
        "a_re": -0.5 + nrm((L, G, P), 0.01),
        "a_im": math.pi * n + nrm((L, G, P), 0.01),
        "b_re": nrm((L, G, P, H), (2 * H) ** -0.5),
        "b_im": nrm((L, G, P, H), (2 * H) ** -0.5),
        "c_re": nrm((L, G, H, P), (2 * P) ** -0.5),
        "c_im": nrm((L, G, H, P), (2 * P) ** -0.5),
        "d_skip": nrm((L, G, H), 1.0),
        "log_dt": log_dt,
        "w_glu": nrm((L, SSM_WIDTH, 2 * SSM_WIDTH), SSM_WIDTH ** -0.5),
        "g_out_ssm": 1.0 + nrm((L, SSM_WIDTH), 0.01),
        "g_out_mla": 1.0 + nrm((L, MLA_WIDTH), 0.01),
        "w_o": nrm((L, MIX_WIDTH, D_MODEL), MIX_WIDTH ** -0.5 * BETA),
        "w_xq": nrm((L, D_MODEL, X_HEADS, X_HEAD_DIM), D_MODEL ** -0.5),
        "w_xk": nrm((L, D_MODEL, X_HEADS, X_HEAD_DIM), D_MODEL ** -0.5),
        "w_xv": nrm((L, D_MODEL, X_HEADS, X_HEAD_DIM), D_MODEL ** -0.5),
        "w_xo": nrm((L, X_HEADS, X_HEAD_DIM, D_MODEL), D_MODEL ** -0.5 * BETA),
        "w_ff1": nrm((L, D_MODEL, D_FF), D_MODEL ** -0.5),
        "w_ff2": nrm((L, D_FF, D_MODEL), D_FF ** -0.5 * BETA),
        "ln_g": 1.0 + nrm((L, 3, D_MODEL), 0.01),
        "ln_b": nrm((L, 3, D_MODEL), 0.01),
    }


def reference(x_prompt, x_sample, mem_prompt, cache_mla_ckv, cache_mla_kpe, state_ssm_re,
              state_ssm_im, cache_mem_k, cache_mem_v, w_in, g_q, w_q_up, g_kv, w_kv_up,
              a_re, a_im, b_re, b_im, c_re, c_im, d_skip, log_dt, w_glu, g_out_ssm,
              g_out_mla, w_o, w_xq, w_xk, w_xv, w_xo, w_ff1, w_ff2, ln_g, ln_b):
    nbp, sp = x_prompt.shape[:2]
    sd = x_sample.shape[1]
    past_len = cache_mla_ckv.shape[2]
    pos_p = jnp.arange(sp, dtype=jnp.int32)
    pos_s = past_len + jnp.arange(sd, dtype=jnp.int32)
    zero_state = jnp.zeros((nbp, SSM_GROUPS, SSM_STATE), jnp.float32)

    hp, hs = x_prompt, x_sample
    ckv_p, kpe_p, sre_p, sim_p, mk_p, mv_p = [], [], [], [], [], []
    ckv_s, kpe_s, sre_s, sim_s = [], [], [], []
    for l in range(DEPTH):
        lw = (w_in[l], g_q[l], w_q_up[l], g_kv[l], w_kv_up[l], a_re[l], a_im[l], b_re[l],
              b_im[l], c_re[l], c_im[l], d_skip[l], log_dt[l], w_glu[l], g_out_ssm[l],
              g_out_mla[l], w_o[l], w_xq[l], w_xo[l], w_ff1[l], w_ff2[l], ln_g[l], ln_b[l])
        mk, mv = _mem_kv(mem_prompt, w_xk[l], w_xv[l])
        hp, c1, k1, r1, i1 = _layer(hp, pos_p, None, None, zero_state, zero_state,
                                    mk, mv, True, *lw)
        ckv_p.append(c1); kpe_p.append(k1); sre_p.append(r1); sim_p.append(i1)
        mk_p.append(mk); mv_p.append(mv)
        hs, c2, k2, r2, i2 = _layer(hs, pos_s, cache_mla_ckv[l], cache_mla_kpe[l],
                                    state_ssm_re[l], state_ssm_im[l],
                                    cache_mem_k[l], cache_mem_v[l], False, *lw)
        ckv_s.append(c2); kpe_s.append(k2); sre_s.append(r2); sim_s.append(i2)

    return (hp, hs,
            jnp.stack(ckv_p), jnp.stack(kpe_p), jnp.stack(sre_p), jnp.stack(sim_p),
            jnp.stack(mk_p), jnp.stack(mv_p),
            jnp.stack(ckv_s), jnp.stack(kpe_s), jnp.stack(sre_s), jnp.stack(sim_s))
```

```cpp
#include <hip/hip_runtime.h>
#include <hip/hip_cooperative_groups.h>
#include <cstdio>
#include <cstdint>
namespace cg = cooperative_groups;

#ifndef N_LAUNCH_MODE
#define N_LAUNCH_MODE 1
#endif

#define LAS __attribute__((address_space(3)))
#define PG8_LAS LAS
typedef unsigned short bf16_t;
typedef short bf16x8 __attribute__((ext_vector_type(8)));
typedef float f32x4 __attribute__((ext_vector_type(4)));
typedef float f32x16 __attribute__((ext_vector_type(16)));
typedef unsigned u32x4 __attribute__((ext_vector_type(4)));
typedef unsigned u32x2 __attribute__((ext_vector_type(2)));

constexpr int TP = 16384, TS = 1024, MTOK = TP + TS;
constexpr int DM = 1024, NPAST = 1024, KVS = 1056;
constexpr int KVROWS = TP + 32 * KVS;
constexpr int KVPAD = KVROWS + 64;
constexpr float EPSN = 1e-5f;
constexpr float ALPHA = 1.189207115002721f;
constexpr float LOG2E = 1.4426950408889634f;
constexpr float QSCALE = 0.07216878364870322f * LOG2E;
constexpr float XSCALE = 0.0625f * LOG2E;

constexpr size_t O_Y = 0, O_CKVP = 17825792, O_KPEP = 22020096, O_SREP = 23068672, O_SIMP = 23070720, O_MKP = 23072768,
                 O_MVP = 23334912, O_CKVS = 23597056, O_KPES = 23859200, O_SRES = 23924736, O_SIMS = 23990272;

constexpr size_t MiB = 1u << 20;
constexpr size_t al256(size_t x) { return (x + 255) & ~(size_t)255; }
constexpr size_t W_WIN = 0;
constexpr size_t W_WQ = W_WIN + al256(1280 * 1024 * 2);
constexpr size_t W_WK = W_WQ + al256(768 * 384 * 2);
constexpr size_t W_WV = W_WK + al256(512 * 256 * 2);
constexpr size_t W_WGLU = W_WV + al256(512 * 256 * 2);
constexpr size_t W_WO = W_WGLU + al256(1024 * 512 * 2);
constexpr size_t W_WXQ = W_WO + 2 * MiB;
constexpr size_t W_WXK = W_WXQ + 2 * MiB;
constexpr size_t W_WXV = W_WXK + 2 * MiB;
constexpr size_t W_WXO = W_WXV + 2 * MiB;
constexpr size_t W_WFF1 = W_WXO + 2 * MiB;
constexpr size_t W_WFF2 = W_WFF1 + 8 * MiB;
constexpr size_t W_CSXQ = W_WFF2 + 8 * MiB;
constexpr size_t W_BWXQ = W_CSXQ + 4096;
constexpr size_t W_CSFF1 = W_BWXQ + 4096;
constexpr size_t W_BWFF1 = W_CSFF1 + 16384;
constexpr size_t W_LAM = W_BWFF1 + 16384;
constexpr size_t W_LAM64 = W_LAM + 16384;
constexpr size_t W_BB = W_LAM64 + 16384;
constexpr size_t W_MEMB = W_BB + 2 * 32 * 64 * 16 * 4;
constexpr size_t W_XK0 = W_MEMB + 256 * 1024 * 2;
constexpr size_t W_XVT0 = W_XK0 + 256 * 1024 * 2;
constexpr size_t W_STSSM = W_XVT0 + 256 * 1024 * 2;
constexpr size_t W_STMLA = W_STSSM + al256(16 * MTOK * 4);
constexpr size_t W_ST1 = W_STMLA + al256(4 * MTOK * 4);
constexpr size_t W_ST2 = W_ST1 + al256(32 * MTOK * 4);
constexpr size_t W_SEND = W_ST2 + al256(32 * MTOK * 4);
constexpr size_t W_BAR = W_SEND + 256 * 2 * 2048 * 4;
constexpr size_t BAR_BYTES = 16384;
constexpr size_t W_ACT = (W_BAR + BAR_BYTES + MiB - 1) / MiB * MiB;
constexpr size_t A_KN = W_ACT, A_VT = W_ACT + 50 * MiB, A_Q = W_ACT + 100 * MiB, A_KPE = W_ACT + 126 * MiB, A_CKV = W_ACT + 133 * MiB,
                 A_CQN = W_ACT + 158 * MiB, A_MIX = W_ACT + 171 * MiB, A_PQ = W_ACT, A_XB = W_ACT + 51 * MiB, A_R1B = W_ACT,
                 A_XQ = W_ACT + 34 * MiB, A_XKS = W_ACT + 68 * MiB, A_XVTS = W_ACT + 84 * MiB, A_XO = W_ACT + 101 * MiB,
                 A_R2B = W_ACT + 140 * MiB, A_Z = W_ACT, WS_END = W_ACT + 205 * MiB;
static_assert(WS_END <= 256 * MiB, "workspace");
static_assert((size_t)KVPAD * 512 * 2 <= 50 * MiB && (size_t)MTOK * 768 * 2 <= 26 * MiB && (size_t)KVPAD * 64 * 2 <= 7 * MiB && (size_t)KVPAD * 256 * 2 <= 25 * MiB &&
              (size_t)MTOK * 384 * 2 <= 13 * MiB && (size_t)MTOK * 1024 * 2 <= 34 * MiB && (size_t)MTOK * 768 * 4 <= 51 * MiB && (size_t)MTOK * 4096 * 2 <= 136 * MiB, "regions");

constexpr int LDS_BYTES = 141312 + 64;

__constant__ double c_invrev[32] = {0.15915494309189535,0.11934937021124886,0.089499401608891013,0.067115083005227255,0.050329212104487035,0.037741584717419771,0.028302195830623399,0.02122365276477766,0.015915494309189534,0.011934937021124886,0.0089499401608891024,0.0067115083005227253,0.0050329212104487037,0.0037741584717419772,0.0028302195830623399,0.0021223652764777662,0.0015915494309189536,0.0011934937021124885,0.00089499401608891024,0.0006711508300522726,0.00050329212104487033,0.00037741584717419774,0.00028302195830623395,0.00021223652764777661,0.00015915494309189535,0.00011934937021124886,8.9499401608891018e-05,6.7115083005227254e-05,5.0329212104487035e-05,3.7741584717419777e-05,2.8302195830623396e-05,2.1223652764777659e-05};

__device__ __forceinline__ unsigned cvt_pk_bf16(float lo, float hi) { unsigned r; asm volatile("v_cvt_pk_bf16_f32 %0, %1, %2" : "=v"(r) : "v"(lo), "v"(hi)); return r; }
__device__ __forceinline__ u32x2 pack4(f32x4 v) { u32x2 w; w.x = cvt_pk_bf16(v[0], v[1]); w.y = cvt_pk_bf16(v[2], v[3]); return w; }
__device__ __forceinline__ float bf16_round(float x) { return __uint_as_float(cvt_pk_bf16(x, 0.f) << 16); }
__device__ __forceinline__ void rope_cs(int pos, int i, float& c, float& s) {
    double rev = (double)pos * c_invrev[i]; rev -= __builtin_floor(rev); const float r = (float)rev;
    s = __builtin_amdgcn_sinf(r); c = __builtin_amdgcn_cosf(r);
}
__device__ __forceinline__ int tok_pos(int row) { return row < TP ? row : NPAST + ((row - TP) & 31); }
__device__ __forceinline__ int swap23(int r) { return (r & ~12) | ((r & 4) << 1) | ((r & 8) >> 1); }
__device__ __forceinline__ int tok_kvrow(int row) { return row < TP ? row : TP + ((row - TP) >> 5) * KVS + NPAST + ((row - TP) & 31); }

struct Args { const float* in[34]; float* out; unsigned char* ws; int ph_lo, ph_hi; };
struct Frame {
    const Args* a; float* out; unsigned char* ws; LAS unsigned char* lds;
    int tid, lane, wid, G, bid;
};

namespace pg8 {
constexpr int BM = 256, BK = 64, HALF = 128, HTB = HALF * BK * 2, STAGE_BYTES = 8 * HTB, NXCD = 8, WGM = 8;
__host__ __device__ __forceinline__ int lds_byte(int r, int c) { const int st = (r >> 4) * 2 + (c >> 5), rr = r & 15, cc = c & 31, ob = rr * 64 + cc * 2; return st * 1024 + (ob ^ (((ob >> 9) & 1) << 5)); }
__host__ __device__ __forceinline__ void stage_rc(int b, int& R, int& C) { const int st = b / 1024, sb = b % 1024, swz = sb ^ (((sb >> 9) & 1) << 5); R = (st >> 1) * 16 + swz / 64; C = (st & 1) * 32 + (swz % 64) / 2; }
__host__ __device__ __forceinline__ int perm32(int rho) { const int n = rho >> 4, i = rho & 15; return 8 * (i >> 2) + 4 * n + (i & 3); }
struct Unit { int pm, pn, idx, ko; };
struct Gemm { const bf16_t* A; const bf16_t* Bt; int M, N, K, LD; };
struct StaticOrder {
    int nM, nN, nwg, G, c;
    __device__ __forceinline__ void init(int M, int N, int G_, int c_, int rot) { nM = M / BM; nN = N / BM; nwg = nM * nN; G = G_; c = (c_ + rot) % G_; }
    __device__ __forceinline__ bool next(int i, Unit& u) const {
        const long L = (long)i * G + c; if (L >= nwg) return false;
        int wgid = (int)L; { const int q = nwg / NXCD, r = nwg % NXCD, xcd = wgid % NXCD, off = wgid / NXCD; wgid = (xcd < r ? xcd * (q + 1) : r * (q + 1) + (xcd - r) * q) + off; }
        const int nig = WGM * nN, gid = wgid / nig, fm = gid * WGM, gsz = (nM - fm) < WGM ? (nM - fm) : WGM;
        u.pm = fm + ((wgid % nig) % gsz); u.pn = (wgid % nig) / gsz; u.idx = i; u.ko = 0; return true;
    }
    __device__ __forceinline__ void a_ready(const Unit&) const {}
    __device__ __forceinline__ void done(const Unit&) const {}
};
struct SplitKOrder {
    int nt, nN, ns, ks, G, c;
    __device__ __forceinline__ bool next(int i, Unit& u) const { const int L = i * G + c; if (L >= nt * ns) return false; const int t = L % nt, s = L / nt; u.pm = t / nN; u.pn = t % nN; u.idx = i; u.ko = s * ks; return true; }
    __device__ __forceinline__ void a_ready(const Unit&) const {}
    __device__ __forceinline__ void done(const Unit&) const {}
};
template <class Epi, class Sched, bool ALIGN_EPI = false, bool SP2 = false>
__device__ __forceinline__ void gemm_phase(PG8_LAS unsigned char* lds, const Gemm g, const Sched& S, const Epi& E) {
    const int tid = threadIdx.x, wid = __builtin_amdgcn_readfirstlane(tid >> 6), lane = tid & 63, wr = wid >> 2, wc = wid & 3, fr = lane & 15, fq = lane >> 4;
    int K_ = g.K; asm volatile("" : "+s"(K_)); const int K = K_, nt = K / BK, LD = g.LD ? g.LD : K;
    unsigned voffA[2], voffB[2];
#pragma unroll
    for (int i = 0; i < 2; ++i) { int R, C; stage_rc(tid * 16 + i * 8192, R, C); const int Rb = Epi::PERM ? ((R & ~31) + perm32(R & 31)) : R;
        voffA[i] = (unsigned)(R * LD + C) * 2u; voffB[i] = (unsigned)(Rb * LD + C) * 2u; }
    const size_t kstep = (size_t)(BK * 2);
    const size_t hstep = (size_t)HALF * LD * 2;
    const size_t tstep = 2 * hstep;
    const unsigned ldsw = (unsigned)wid * 1024u;
    const int aoff = lds_byte(wr * 64 + fr, fq * 8), boff = lds_byte(wc * 32 + fr, fq * 8);
#define PG8_SA(b, h) (((b) * 2 + (h)) * HTB)
#define PG8_SB(b, h) ((4 + (b) * 2 + (h)) * HTB)
#define PG8_STAGE(bufoff, gbase, voff) do { _Pragma("unroll") for (int _i = 0; _i < 2; ++_i) \
        __builtin_amdgcn_global_load_lds((const unsigned*)((const char*)(gbase) + (voff)[_i]), (PG8_LAS unsigned*)(lds + (bufoff) + ldsw + _i * 8192), 16, 0, 0); } while (0)
#define PG8_LDA(dst, b, h) do { _Pragma("unroll") for (int m = 0; m < 4; ++m) _Pragma("unroll") for (int k = 0; k < 2; ++k) dst[m][k] = *(const PG8_LAS bf16x8*)(lds + PG8_SA(b, h) + aoff + m * 2048 + k * 1024); } while (0)
#define PG8_LDB(dst, b, h) do { _Pragma("unroll") for (int n = 0; n < 2; ++n) _Pragma("unroll") for (int k = 0; k < 2; ++k) dst[n][k] = *(const PG8_LAS bf16x8*)(lds + PG8_SB(b, h) + boff + n * 2048 + k * 1024); } while (0)
#define PG8_MMA(ai, bj, At, Bt) do { __builtin_amdgcn_s_setprio(1); _Pragma("unroll") for (int m = 0; m < 4; ++m) _Pragma("unroll") for (int n = 0; n < 2; ++n) _Pragma("unroll") for (int k = 0; k < 2; ++k) \
        acc[ai][bj][m][n] = __builtin_amdgcn_mfma_f32_16x16x32_bf16(Bt[n][k], At[m][k], acc[ai][bj][m][n], 0, 0, 0); __builtin_amdgcn_s_setprio(0); } while (0)
#define PG8_WAIT_V(n) asm volatile("s_waitcnt vmcnt(" #n ")" ::: "memory")
#define PG8_WAIT_L(n) asm volatile("s_waitcnt lgkmcnt(" #n ")" ::: "memory")
#define PG8_BAR __builtin_amdgcn_s_barrier()
#define PG8_SCHED __builtin_amdgcn_sched_barrier(0)
    Unit cur, nxt; int ui = 0;
    if (!S.next(0, cur)) return;
    f32x4 acc[2][2][4][2];
#pragma unroll
    for (int a = 0; a < 2; ++a)
#pragma unroll
        for (int b = 0; b < 2; ++b)
#pragma unroll
            for (int m = 0; m < 4; ++m)
#pragma unroll
                for (int n = 0; n < 2; ++n) acc[a][b][m][n] = (f32x4){0.f, 0.f, 0.f, 0.f};
    bf16x8 At[4][2], B0[2][2], B1[2][2];
    const char* cA = (const char*)g.A + (size_t)cur.pm * tstep + (size_t)cur.ko * 2; const char* cB = (const char*)g.Bt + (size_t)cur.pn * tstep + (size_t)cur.ko * 2;
    S.a_ready(cur);
    if constexpr (SP2) {
        PG8_STAGE(PG8_SB(0, 0), cB, voffB); PG8_STAGE(PG8_SB(0, 1), cB + hstep, voffB); PG8_STAGE(PG8_SA(0, 0), cA, voffA); PG8_STAGE(PG8_SA(0, 1), cA + hstep, voffA);
        if (wr == 1) PG8_BAR;
        PG8_WAIT_V(2); PG8_BAR;
        PG8_STAGE(PG8_SB(1, 0), cB + kstep, voffB); PG8_STAGE(PG8_SA(1, 0), cA + kstep, voffA); PG8_STAGE(PG8_SB(1, 1), cB + hstep + kstep, voffB);
        PG8_WAIT_V(6); PG8_BAR;
    } else {
        PG8_STAGE(PG8_SB(0, 0), cB, voffB); PG8_STAGE(PG8_SA(0, 0), cA, voffA); PG8_STAGE(PG8_SB(0, 1), cB + hstep, voffB); PG8_STAGE(PG8_SA(0, 1), cA + hstep, voffA);
        if (wr == 1) PG8_BAR;
        PG8_WAIT_V(4); PG8_BAR;
        PG8_STAGE(PG8_SB(1, 0), cB + kstep, voffB); PG8_STAGE(PG8_SA(1, 0), cA + kstep, voffA); PG8_STAGE(PG8_SB(1, 1), cB + hstep + kstep, voffB);
        PG8_WAIT_V(6); PG8_BAR;
    }
    for (;;) {
        const bool has_next = S.next(ui + 1, nxt);
        const char* nA = has_next ? (const char*)g.A + (size_t)nxt.pm * tstep + (size_t)nxt.ko * 2 : cA; const char* nB = has_next ? (const char*)g.Bt + (size_t)nxt.pn * tstep + (size_t)nxt.ko * 2 : cB;
        for (int t = 0; t < nt; t += 2) {
            const bool last = (t == nt - 2);
            if constexpr (Epi::MIDK) { if (t == (nt >> 1)) E.mid(acc, cur, wr, fr); }
            const char* a1 = cA + (size_t)(t + 1) * kstep;
            const char* a2 = last ? nA : cA + (size_t)(t + 2) * kstep; const char* b2 = last ? nB : cB + (size_t)(t + 2) * kstep;
            const char* a3 = a2 + kstep; const char* b3 = b2 + kstep;
            if (last && has_next) S.a_ready(nxt);
            if constexpr (SP2) {
            PG8_LDB(B0, 0, 0); PG8_LDB(B1, 0, 1); PG8_SCHED; PG8_LDA(At, 0, 0); PG8_STAGE(PG8_SA(1, 1), a1 + hstep, voffA);
            PG8_WAIT_V(8); PG8_WAIT_L(0); PG8_BAR; PG8_MMA(0, 0, At, B0); PG8_MMA(0, 1, At, B1); PG8_BAR; PG8_SCHED;
            PG8_LDA(At, 0, 1); PG8_STAGE(PG8_SB(0, 0), b2, voffB); PG8_STAGE(PG8_SB(0, 1), b2 + hstep, voffB); PG8_STAGE(PG8_SA(0, 0), a2, voffA);
            PG8_WAIT_V(8); PG8_WAIT_L(0); PG8_BAR; PG8_MMA(1, 0, At, B0); PG8_MMA(1, 1, At, B1); PG8_BAR; PG8_SCHED;
            PG8_LDB(B0, 1, 0); PG8_LDB(B1, 1, 1); PG8_SCHED; PG8_LDA(At, 1, 0); PG8_STAGE(PG8_SA(0, 1), a2 + hstep, voffA);
            PG8_WAIT_V(8); PG8_WAIT_L(0); PG8_BAR; PG8_MMA(0, 0, At, B0); PG8_MMA(0, 1, At, B1); PG8_BAR; PG8_SCHED;
            PG8_LDA(At, 1, 1); PG8_STAGE(PG8_SB(1, 0), b3, voffB); PG8_STAGE(PG8_SB(1, 1), b3 + hstep, voffB); PG8_STAGE(PG8_SA(1, 0), a3, voffA);
            PG8_WAIT_V(8); PG8_WAIT_L(0); PG8_BAR; PG8_MMA(1, 0, At, B0); PG8_MMA(1, 1, At, B1); PG8_BAR; PG8_SCHED;
            } else {
            PG8_LDB(B0, 0, 0); PG8_SCHED; PG8_LDA(At, 0, 0); PG8_STAGE(PG8_SA(1, 1), a1 + hstep, voffA);
            PG8_WAIT_L(8); PG8_BAR; PG8_WAIT_L(0); PG8_MMA(0, 0, At, B0); PG8_BAR; PG8_SCHED;
            PG8_LDB(B1, 0, 1); PG8_STAGE(PG8_SB(0, 0), b2, voffB);
            PG8_BAR; PG8_WAIT_L(0); PG8_MMA(0, 1, At, B1); PG8_BAR;
            PG8_LDA(At, 0, 1); PG8_STAGE(PG8_SA(0, 0), a2, voffA);
            PG8_BAR; PG8_WAIT_L(0); PG8_MMA(1, 0, At, B0); PG8_BAR; PG8_SCHED;
            PG8_STAGE(PG8_SB(0, 1), b2 + hstep, voffB);
            PG8_WAIT_V(6); PG8_BAR; PG8_MMA(1, 1, At, B1); PG8_BAR;
            PG8_LDB(B0, 1, 0); PG8_SCHED; PG8_LDA(At, 1, 0); PG8_STAGE(PG8_SA(0, 1), a2 + hstep, voffA);
            PG8_WAIT_L(8); PG8_BAR; PG8_WAIT_L(0); PG8_MMA(0, 0, At, B0); PG8_BAR; PG8_SCHED;
            PG8_LDB(B1, 1, 1); PG8_STAGE(PG8_SB(1, 0), b3, voffB);
            PG8_BAR; PG8_WAIT_L(0); PG8_MMA(0, 1, At, B1); PG8_BAR;
            PG8_LDA(At, 1, 1); PG8_STAGE(PG8_SA(1, 0), a3, voffA);
            PG8_BAR; PG8_WAIT_L(0); PG8_MMA(1, 0, At, B0); PG8_BAR; PG8_SCHED;
            PG8_STAGE(PG8_SB(1, 1), b3 + hstep, voffB);
            PG8_WAIT_V(6); PG8_BAR; PG8_MMA(1, 1, At, B1); PG8_BAR;
            }
        }
        if constexpr (ALIGN_EPI) { if (wr == 0) PG8_BAR; }
        if constexpr (!Epi::AFTER_DRAIN) { E(acc, cur, wr, wc, fr, fq); S.done(cur); }
        if (!has_next) break;
#pragma unroll
        for (int a = 0; a < 2; ++a)
#pragma unroll
            for (int b = 0; b < 2; ++b)
#pragma unroll
                for (int m = 0; m < 4; ++m)
#pragma unroll
                    for (int n = 0; n < 2; ++n) acc[a][b][m][n] = (f32x4){0.f, 0.f, 0.f, 0.f};
        cur = nxt; cA = nA; cB = nB; ++ui;
        if constexpr (ALIGN_EPI) { if (wr == 1) PG8_BAR; }
    }
    PG8_WAIT_V(0);
    if constexpr (!ALIGN_EPI) { if (wr == 0) PG8_BAR; }
    PG8_BAR;
    if constexpr (Epi::AFTER_DRAIN) { E.fused(acc, cur, wr, wc, fr, fq, lds, wid, lane); S.done(cur); }
#undef PG8_SA
#undef PG8_SB
#undef PG8_STAGE
#undef PG8_LDA
#undef PG8_LDB
#undef PG8_MMA
#undef PG8_WAIT_V
#undef PG8_WAIT_L
#undef PG8_BAR
#undef PG8_SCHED
}
}
using pg8::Unit;
typedef f32x4 Acc[2][2][4][2];
#define EPI_ROWS _Pragma("unroll") for (int ai = 0; ai < 2; ++ai) _Pragma("unroll") for (int m = 0; m < 4; ++m)
#define EPI_COLS _Pragma("unroll") for (int bj = 0; bj < 2; ++bj) _Pragma("unroll") for (int n = 0; n < 2; ++n)

struct EpiProj {
    static constexpr bool PERM = false, AFTER_DRAIN = false, MIDK = false;
    float* U; float* PQ;
    __device__ __forceinline__ void operator()(const Acc& acc, const Unit& u, int wr, int wc, int fr, int fq) const {
        const bool isu = u.pn < 2; float* base = isu ? U : PQ; const int ld = isu ? 512 : 768; const int c0 = (isu ? u.pn : u.pn - 2) * 256 + wc * 32 + 4 * fq;
        EPI_ROWS { const int row = u.pm * 256 + ai * 128 + wr * 64 + m * 16 + fr; float* rp = base + (size_t)row * ld + c0;
            EPI_COLS *(f32x4*)(rp + bj * 128 + n * 16) = acc[ai][bj][m][n]; }
    }
};
struct EpiSlab {
    static constexpr bool PERM = false, AFTER_DRAIN = false, MIDK = false;
    float* S;
    __device__ __forceinline__ void operator()(const Acc& acc, const Unit& u, int wr, int wc, int fr, int fq) const {
        float* base = S + (size_t)(u.ko >> 9) * 1024 * 1024 + u.pn * 256 + wc * 32 + 4 * fq;
        EPI_ROWS { const int row = u.pm * 256 + ai * 128 + wr * 64 + m * 16 + fr;
            EPI_COLS *(f32x4*)(base + (size_t)row * 1024 + bj * 128 + n * 16) = acc[ai][bj][m][n]; }
    }
};
template <bool VT> struct EpiStore {
    static constexpr bool PERM = !VT, AFTER_DRAIN = false, MIDK = false;
    bf16_t* O; int ldc; float* F32; int ldf; float* F32T; int ldt; int rowswap;
    __device__ __forceinline__ void operator()(const Acc& acc, const Unit& u, int wr, int wc, int fr, int fq) const {
        if constexpr (VT) { const int sw = ((fq & 1) << 1) | (fq >> 1);
            EPI_ROWS { const int row = u.pm * 256 + ai * 128 + wr * 64 + m * 16 + fr;
                EPI_COLS { const int cb = u.pn * 256 + bj * 128 + wc * 32 + n * 16; const f32x4 v = acc[ai][bj][m][n];
                    *(u32x2*)(O + (size_t)row * ldc + cb + 4 * sw) = pack4(v);
                    if (F32) *(f32x4*)(F32 + (size_t)row * ldf + cb + 4 * fq) = v;
                    if (F32T) { _Pragma("unroll") for (int j = 0; j < 4; ++j) F32T[(size_t)(cb + 4 * fq + j) * ldt + row] = v[j]; } } }
        } else {
            EPI_ROWS { const int row = u.pm * 256 + ai * 128 + wr * 64 + m * 16 + fr;
                _Pragma("unroll") for (int bj = 0; bj < 2; ++bj) { const int cb = u.pn * 256 + bj * 128 + wc * 32 + 8 * fq; const f32x4 v0 = acc[ai][bj][m][0], v1 = acc[ai][bj][m][1];
                    const u32x2 h0 = pack4(v0), h1 = pack4(v1); u32x4 w; w.x = h0.x; w.y = h0.y; w.z = h1.x; w.w = h1.y;
                    *(u32x4*)(O + (size_t)(rowswap ? swap23(row) : row) * ldc + cb) = w;
                    if (F32) { *(f32x4*)(F32 + (size_t)row * ldf + cb) = v0; *(f32x4*)(F32 + (size_t)row * ldf + cb + 4) = v1; }
                    if (F32T) { _Pragma("unroll") for (int j = 0; j < 4; ++j) { F32T[(size_t)(cb + j) * ldt + row] = v0[j]; F32T[(size_t)(cb + 4 + j) * ldt + row] = v1[j]; } } } }
        }
    }
};
struct EpiQ {
    static constexpr bool PERM = false, AFTER_DRAIN = false, MIDK = false;
    bf16_t* Q;
    __device__ __forceinline__ void operator()(const Acc& acc, const Unit& u, int wr, int wc, int fr, int fq) const {
        EPI_ROWS { const int row = u.pm * 256 + ai * 128 + wr * 64 + m * 16 + fr; bf16_t* qp = Q + (size_t)row * 768;
            if (u.pn < 2) { EPI_COLS { const int h = 2 * u.pn + bj, d = wc * 32 + n * 16 + 4 * fq; *(u32x2*)(qp + h * 192 + d) = pack4(acc[ai][bj][m][n] * QSCALE); } }
            else { const int pos = tok_pos(row);
                _Pragma("unroll") for (int n = 0; n < 2; ++n) { f32x4 o1, o2;
                    _Pragma("unroll") for (int j = 0; j < 4; ++j) { float c, s; rope_cs(pos, n * 16 + 4 * fq + j, c, s); const float x1 = acc[ai][0][m][n][j], x2 = acc[ai][1][m][n][j];
                        o1[j] = (x1 * c - x2 * s) * QSCALE; o2[j] = (x2 * c + x1 * s) * QSCALE; }
                    *(u32x2*)(qp + wc * 192 + 128 + n * 16 + 4 * fq) = pack4(o1); *(u32x2*)(qp + wc * 192 + 160 + n * 16 + 4 * fq) = pack4(o2); } }
        }
    }
};
struct EpiGlu {
    static constexpr bool PERM = true, AFTER_DRAIN = false, MIDK = false;
    bf16_t* MIX; float* ST;
    __device__ __forceinline__ void operator()(const Acc& acc, const Unit& u, int wr, int wc, int fr, int fq) const {
        EPI_ROWS { const int row = u.pm * 256 + ai * 128 + wr * 64 + m * 16 + fr; float q = 0.f; u32x2 h[2];
            _Pragma("unroll") for (int n = 0; n < 2; ++n) { const f32x4 v = acc[ai][0][m][n], g = acc[ai][1][m][n]; f32x4 o;
                _Pragma("unroll") for (int j = 0; j < 4; ++j) { o[j] = v[j] * __builtin_amdgcn_rcpf(1.f + __builtin_amdgcn_exp2f(-g[j] * LOG2E)); q += o[j] * o[j]; }
                h[n] = pack4(o); }
            u32x4 w; w.x = h[0].x; w.y = h[0].y; w.z = h[1].x; w.w = h[1].y;
            *(u32x4*)(MIX + (size_t)row * 1024 + u.pn * 128 + wc * 32 + 8 * fq) = w;
            q += __shfl_xor(q, 16); q += __shfl_xor(q, 32);
            if (fq == 0) ST[(size_t)(u.pn * 4 + wc) * MTOK + row] = q; }
    }
};
__device__ __forceinline__ void ln_stats16(const float* PS, const float* PQ, int row, float& mu, float& rstd) {
    float s = 0.f, q = 0.f;
#pragma unroll
    for (int i = 0; i < 16; ++i) { s += PS[(size_t)i * MTOK + row]; q += PQ[(size_t)i * MTOK + row]; }
    mu = s * (1.f / 1024.f); const float var = q * (1.f / 1024.f) - mu * mu; rstd = rsqrtf(var + EPSN);
}
template <int MODE> struct EpiRes {
    static constexpr bool PERM = true, AFTER_DRAIN = false, MIDK = (MODE == 0);
    const float* xp; const float* xs; float* R; bf16_t* Rb; const float* PSin; const float* PQin; const float* g; const float* b; float* PSout; float* PQout; const LAS float* tab;
    __device__ __forceinline__ void mid(Acc& acc, const Unit& u, int wr, int fr) const {
        EPI_ROWS { const float ratio = tab[(u.idx & 1) * 512 + ai * 128 + wr * 64 + m * 16 + fr];
            EPI_COLS acc[ai][bj][m][n] *= ratio; }
    }
    __device__ __forceinline__ void operator()(const Acc& acc, const Unit& u, int wr, int wc, int fr, int fq) const {
        const int c0 = u.pn * 256 + wc * 32 + 8 * fq;
        EPI_ROWS { const int row = u.pm * 256 + ai * 128 + wr * 64 + m * 16 + fr; float rowscale = 1.f, mu = 0.f, rstd = 1.f;
            if (MODE == 0) rowscale = tab[(u.idx & 1) * 512 + 256 + ai * 128 + wr * 64 + m * 16 + fr]; else { mu = tab[u.idx * 512 + ai * 128 + wr * 64 + m * 16 + fr]; rstd = tab[u.idx * 512 + 256 + ai * 128 + wr * 64 + m * 16 + fr]; }
            const float* rsrc = MODE == 0 ? (row < TP ? xp + (size_t)row * 1024 : xs + (size_t)(row - TP) * 1024) : R + (size_t)row * 1024;
            float s = 0.f, q = 0.f;
            EPI_COLS { const int col = c0 + bj * 128 + n * 4; f32x4 res = *(const f32x4*)(rsrc + col);
                if (MODE == 1) { const f32x4 g4 = *(const f32x4*)(g + col), b4 = *(const f32x4*)(b + col); res = (res - mu) * rstd * g4 + b4; }
                const f32x4 v = res * ALPHA + acc[ai][bj][m][n] * rowscale;
                s += (v[0] + v[1]) + (v[2] + v[3]); q += (v[0] * v[0] + v[1] * v[1]) + (v[2] * v[2] + v[3] * v[3]);
                *(f32x4*)(R + (size_t)row * 1024 + col) = v;
                if (Rb) *(u32x2*)(Rb + (size_t)row * 1024 + col) = pack4(v); }
            s += __shfl_xor(s, 16); s += __shfl_xor(s, 32); q += __shfl_xor(q, 16); q += __shfl_xor(q, 32);
            if (fq == 0) { PSout[(size_t)(u.pn * 4 + wc) * MTOK + row] = s; PQout[(size_t)(u.pn * 4 + wc) * MTOK + row] = q; } }
    }
};
template <int ACT> struct EpiLnAct {
    static constexpr bool PERM = true, AFTER_DRAIN = false, MIDK = false;
    const LAS float* tab; const float* cs; const float* bw; bf16_t* O; int ldc;
    __device__ __forceinline__ void operator()(const Acc& acc, const Unit& u, int wr, int wc, int fr, int fq) const {
        const int c0 = u.pn * 256 + wc * 32 + 8 * fq; f32x4 cs4[2][2], bw4[2][2];
        EPI_COLS { cs4[bj][n] = *(const f32x4*)(cs + c0 + bj * 128 + n * 4); bw4[bj][n] = *(const f32x4*)(bw + c0 + bj * 128 + n * 4); }
        EPI_ROWS { const int row = u.pm * 256 + ai * 128 + wr * 64 + m * 16 + fr; const float mu = tab[u.idx * 512 + ai * 128 + wr * 64 + m * 16 + fr], rstd = tab[u.idx * 512 + 256 + ai * 128 + wr * 64 + m * 16 + fr];
            _Pragma("unroll") for (int bj = 0; bj < 2; ++bj) { u32x2 h[2];
                _Pragma("unroll") for (int n = 0; n < 2; ++n) { f32x4 v = (acc[ai][bj][m][n] - cs4[bj][n] * mu) * rstd + bw4[bj][n];
                    if (ACT == 0) v = v * XSCALE; else { _Pragma("unroll") for (int j = 0; j < 4; ++j) { const float r = fmaxf(v[j], 0.f); v[j] = r * r; } }
                    h[n] = pack4(v); }
                u32x4 w; w.x = h[0].x; w.y = h[0].y; w.z = h[1].x; w.w = h[1].y;
                *(u32x4*)(O + (size_t)row * ldc + c0 + bj * 128) = w; } }
    }
};

__device__ __forceinline__ void wo_fill_tab(const Unit& u, const float* STssm, const float* STmla, LAS float* tab) {
    const int t = threadIdx.x;
    if (t < 256) { const int row = u.pm * 256 + t; float s1 = 0.f, s2 = 0.f;
#pragma unroll
        for (int i = 0; i < 16; ++i) s1 += STssm[(size_t)i * MTOK + row];
#pragma unroll
        for (int i = 0; i < 4; ++i) s2 += STmla[(size_t)i * MTOK + row];
        const float r1 = rsqrtf(s1 * (1.f / 512.f) + EPSN), r2 = rsqrtf(s2 * (1.f / 512.f) + EPSN);
        tab[(u.idx & 1) * 512 + t] = r1 / r2; tab[(u.idx & 1) * 512 + 256 + t] = r2; }
}

__device__ __forceinline__ void ln_fill_tab(const pg8::StaticOrder& S, const float* PS, const float* PQ, LAS float* tab) {
    const int t = threadIdx.x; Unit u;
    if (t < 256) {
#pragma unroll 1
        for (int i = 0; i < 5; ++i) if (S.next(i, u)) { float mu, rstd; ln_stats16(PS, PQ, u.pm * 256 + t, mu, rstd); tab[i * 512 + t] = mu; tab[i * 512 + 256 + t] = rstd; } }
    __syncthreads();
}

template <int DQK, int DKN, int DV, bool SPLITDV>
__device__ __forceinline__ void attn_unit(LAS unsigned char* lds, const bf16_t* Qp, int ldq, const bf16_t* Kn, int ldkn, const bf16_t* Kpe, const bf16_t* Vt, int ldvt,
                                          int ntiles, int kvlim, bf16_t* Op, int ldo, float* statp, int nrows) {
    constexpr int NS = DQK / 16, KROWB = DQK * 2 + 16, VROWB = 144, KTILE = 64 * KROWB, VTILE = DV * VROWB, STAGE = KTILE + VTILE;
    constexpr int CPR = DQK / 8, KCH = 64 * CPR / 512, VCH = DV * 8 / 512, NKH = SPLITDV ? 2 : 1, NDB = 4;
    static_assert((SPLITDV ? DV / 64 : DV / 32) == NDB, "value tiling");
    int tid_ = threadIdx.x; asm volatile("" : "+v"(tid_));
    const int tid = tid_, wid = __builtin_amdgcn_readfirstlane(tid >> 6), lane = tid & 63, r32 = lane & 31, hi = lane >> 5, rg = wid & 3, grp = wid >> 2;
    const int keyoff = SPLITDV ? 0 : 32 * grp, dbase = SPLITDV ? grp * (DV / 2) : 0;
    const bool wact = kvlim > 0;
    bf16x8 qf[NS];
    { const bf16_t* qrow = Qp + (size_t)(rg * 32 + r32) * ldq + hi * 8;
#pragma unroll
      for (int s = 0; s < NS; ++s) qf[s] = wact ? *(const bf16x8*)(qrow + 16 * s) : (bf16x8){0, 0, 0, 0, 0, 0, 0, 0}; }
    constexpr bool KREG = (CPR == 32) && (DKN == DQK);
    const bf16_t* kp[KREG ? 1 : KCH]; int kst[KREG ? 1 : KCH], kld[KREG ? 1 : KCH];
    if constexpr (KREG) { const int row = tid >> 5, cc = tid & 31; kp[0] = Kn + (size_t)row * ldkn + cc * 8; kst[0] = 64 * ldkn; kld[0] = row * KROWB + cc * 16; }
    else {
#pragma unroll
        for (int i = 0; i < KCH; ++i) { const int c = tid + 512 * i, row = c / CPR, cc = c - row * CPR;
            if (cc < DKN / 8) { kp[i] = Kn + (size_t)row * ldkn + cc * 8; kst[i] = 64 * ldkn; } else { kp[i] = Kpe + (size_t)row * 64 + (cc - DKN / 8) * 8; kst[i] = 64 * 64; }
            kld[i] = row * KROWB + cc * 16; } }
    const bf16_t* vp0 = Vt + (size_t)(tid >> 3) * ldvt + (tid & 7) * 8; const int vld0 = KTILE + (tid >> 3) * VROWB + (tid & 7) * 16;
#define KP(i) (KREG ? kp[0] + (size_t)(i) * 16 * ldkn : kp[KREG ? 0 : (i)])
#define KST(i) kst[KREG ? 0 : (i)]
#define KLD(i) (KREG ? kld[0] + (i) * 16 * KROWB : kld[KREG ? 0 : (i)])
    u32x4 sk[KCH], sv[VCH];
#define AT_ISSUE_K(t) do { _Pragma("unroll") for (int i = 0; i < KCH; ++i) sk[i] = *(const u32x4*)(KP(i) + (size_t)(t) * KST(i)); } while (0)
#define AT_ISSUE_V(t) do { _Pragma("unroll") for (int i = 0; i < VCH; ++i) sv[i] = *(const u32x4*)(vp0 + (size_t)(i) * 64 * ldvt + (size_t)(t) * 64); } while (0)
#define AT_ISSUE(t) do { AT_ISSUE_K(t); AT_ISSUE_V(t); } while (0)
#define AT_WRITE(st) do { _Pragma("unroll") for (int i = 0; i < KCH; ++i) *(LAS u32x4*)(lds + (st) * STAGE + KLD(i)) = sk[i]; \
                          _Pragma("unroll") for (int i = 0; i < VCH; ++i) *(LAS u32x4*)(lds + (st) * STAGE + vld0 + (i) * 64 * VROWB) = sv[i]; } while (0)
    f32x16 o[NDB];
#pragma unroll
    for (int d = 0; d < NDB; ++d)
#pragma unroll
        for (int r = 0; r < 16; ++r) o[d][r] = 0.f;
    float mrun = -1e30f, lrun = 0.f;
    const int kboff = (keyoff + r32) * KROWB + hi * 16, vboff = KTILE + (dbase + r32) * VROWB + keyoff * 2 + hi * 16;
    AT_ISSUE(0); AT_WRITE(0); __syncthreads();
    if (!SPLITDV && ntiles > 1) AT_ISSUE(1);
    for (int t = 0; t < ntiles; ++t) {
        const int st = t & 1;
        if (SPLITDV) { if (t + 1 < ntiles) AT_ISSUE_K(t + 1); }
        else if (grp == 1) { if (t + 1 < ntiles) AT_WRITE(st ^ 1); if (t + 2 < ntiles) AT_ISSUE(t + 2); }
        if (t * 64 + keyoff < kvlim) {
            f32x16 p[NKH];
            const LAS unsigned char* kb = lds + st * STAGE + kboff;
#pragma unroll
            for (int kh = 0; kh < NKH; ++kh) {
#pragma unroll
                for (int r = 0; r < 16; ++r) p[kh][r] = 0.f;
#pragma unroll
                for (int s = 0; s < NS; ++s) { const bf16x8 kf = *(const LAS bf16x8*)(kb + kh * 32 * KROWB + s * 32); p[kh] = __builtin_amdgcn_mfma_f32_32x32x16_bf16(kf, qf[s], p[kh], 0, 0, 0); }
            }
            float tmax = p[0][0];
#pragma unroll
            for (int kh = 0; kh < NKH; ++kh)
#pragma unroll
                for (int r = 0; r < 16; ++r) tmax = fmaxf(tmax, p[kh][r]);
            { auto rr = __builtin_amdgcn_permlane32_swap(__float_as_uint(tmax), __float_as_uint(tmax), false, false); tmax = fmaxf(__uint_as_float(rr[0]), __uint_as_float(rr[1])); }
            const float mnew = fmaxf(mrun, tmax);
            if (__any(mnew > mrun)) { const float alpha = __builtin_amdgcn_exp2f(mrun - mnew); lrun *= alpha; mrun = mnew;
#pragma unroll
                for (int d = 0; d < NDB; ++d)
#pragma unroll
                    for (int r = 0; r < 16; ++r) o[d][r] *= alpha; }
            float ls = 0.f;
#pragma unroll
            for (int kh = 0; kh < NKH; ++kh)
#pragma unroll
                for (int r = 0; r < 16; ++r) { p[kh][r] = __builtin_amdgcn_exp2f(p[kh][r] - mrun); ls += p[kh][r]; }
            lrun += ls;
            bf16x8 pf[NKH * 2];
#pragma unroll
            for (int kh = 0; kh < NKH; ++kh)
#pragma unroll
                for (int s2 = 0; s2 < 2; ++s2) { u32x4 w; w.x = cvt_pk_bf16(p[kh][8 * s2 + 0], p[kh][8 * s2 + 1]); w.y = cvt_pk_bf16(p[kh][8 * s2 + 2], p[kh][8 * s2 + 3]);
                    w.z = cvt_pk_bf16(p[kh][8 * s2 + 4], p[kh][8 * s2 + 5]); w.w = cvt_pk_bf16(p[kh][8 * s2 + 6], p[kh][8 * s2 + 7]); pf[kh * 2 + s2] = *(bf16x8*)&w; }
            if (SPLITDV && t + 1 < ntiles) AT_ISSUE_V(t + 1);
            const LAS unsigned char* vb = lds + st * STAGE + vboff;
#pragma unroll
            for (int d = 0; d < NDB; ++d)
#pragma unroll
                for (int ks = 0; ks < NKH * 2; ++ks) { const bf16x8 vf = *(const LAS bf16x8*)(vb + d * 32 * VROWB + ks * 32); o[d] = __builtin_amdgcn_mfma_f32_32x32x16_bf16(vf, pf[ks], o[d], 0, 0, 0); }
        } else if (SPLITDV && t + 1 < ntiles) AT_ISSUE_V(t + 1);
        if (SPLITDV && t + 1 < ntiles) AT_WRITE(st ^ 1);
        if (!SPLITDV && grp == 0) { if (t + 1 < ntiles) AT_WRITE(st ^ 1); if (t + 2 < ntiles) AT_ISSUE(t + 2); }
        __syncthreads();
    }
#undef AT_ISSUE
#undef AT_ISSUE_K
#undef AT_ISSUE_V
#undef KP
#undef KST
#undef KLD
#undef AT_WRITE
    lrun += __shfl_xor(lrun, 32);
    if (!SPLITDV) {
        LAS float* MO = (LAS float*)lds; LAS float* MM = (LAS float*)(lds + 65536); LAS float* ML = (LAS float*)(lds + 65536 + 1024);
        if (grp == 1) {
#pragma unroll
            for (int d = 0; d < NDB; ++d)
#pragma unroll
                for (int r = 0; r < 16; ++r) MO[(rg * 64 + d * 16 + r) * 64 + lane] = o[d][r];
            MM[rg * 64 + lane] = mrun; ML[rg * 64 + lane] = lrun;
        }
        __syncthreads();
        if (grp == 0) {
            const float m1 = MM[rg * 64 + lane], l1 = ML[rg * 64 + lane], ms = fmaxf(mrun, m1);
            const float a0 = __builtin_amdgcn_exp2f(mrun - ms), a1 = __builtin_amdgcn_exp2f(m1 - ms);
            lrun = lrun * a0 + l1 * a1;
#pragma unroll
            for (int d = 0; d < NDB; ++d)
#pragma unroll
                for (int r = 0; r < 16; ++r) o[d][r] = o[d][r] * a0 + MO[(rg * 64 + d * 16 + r) * 64 + lane] * a1;
        }
    }
    if (SPLITDV || grp == 0) {
        const float inv = __builtin_amdgcn_rcpf(lrun); const int row = rg * 32 + r32; const bool ok = wact && row < nrows; float ss = 0.f;
        bf16_t* orow = Op + (size_t)row * ldo + dbase + 4 * hi;
#pragma unroll
        for (int d = 0; d < NDB; ++d)
#pragma unroll
            for (int g4 = 0; g4 < 4; ++g4) { f32x4 v; v[0] = o[d][4 * g4] * inv; v[1] = o[d][4 * g4 + 1] * inv; v[2] = o[d][4 * g4 + 2] * inv; v[3] = o[d][4 * g4 + 3] * inv;
                ss += (v[0] * v[0] + v[1] * v[1]) + (v[2] * v[2] + v[3] * v[3]);
                if (ok) *(u32x2*)(orow + 32 * d + 8 * g4) = pack4(v); }
        ss += __shfl_xor(ss, 32);
        if (statp && ok && hi == 0) statp[row] = ss;
    }
    __syncthreads();
}


__device__ __forceinline__ float gelu_tanh(float x) { const float z2 = 1.5957691216057308f * (x + 0.044715f * x * x * x); return x * __builtin_amdgcn_rcpf(1.f + __builtin_amdgcn_exp2f(-z2 * LOG2E)); }
struct SsmU { bf16x8 hi, lo; };
__device__ __forceinline__ void split_hilo(f32x4 a, f32x4 b, u32x4& hi, u32x4& lo) {
    hi.x = cvt_pk_bf16(a[0], a[1]); hi.y = cvt_pk_bf16(a[2], a[3]); hi.z = cvt_pk_bf16(b[0], b[1]); hi.w = cvt_pk_bf16(b[2], b[3]);
    lo.x = cvt_pk_bf16(a[0] - __uint_as_float(hi.x << 16), a[1] - __uint_as_float(hi.x & 0xffff0000u)); lo.y = cvt_pk_bf16(a[2] - __uint_as_float(hi.y << 16), a[3] - __uint_as_float(hi.y & 0xffff0000u));
    lo.z = cvt_pk_bf16(b[0] - __uint_as_float(hi.z << 16), b[1] - __uint_as_float(hi.z & 0xffff0000u)); lo.w = cvt_pk_bf16(b[2] - __uint_as_float(hi.w << 16), b[3] - __uint_as_float(hi.w & 0xffff0000u));
}
struct SsmW { float lr, li; bf16x8 ab[8]; };
__device__ __forceinline__ void ssm_load_w(const Frame& F, int g, int lane, SsmW& w) {
    const float* LAM = (const float*)(F.ws + W_LAM); const float* BB = (const float*)(F.ws + W_BB);
    w.lr = LAM[g * 64 + lane]; w.li = LAM[2048 + g * 64 + lane];
    const int q = lane >> 4;
#pragma unroll
    for (int blk = 0; blk < 8; ++blk) { const int row = 16 * blk + (lane & 15);
        const float* bp = (row < 64 ? BB + (size_t)(g * 64 + row) * 16 : BB + 32768 + (size_t)(g * 64 + row - 64) * 16) + 8 * (q & 1);
        u32x4 hi, lo; split_hilo(*(const f32x4*)bp, *(const f32x4*)(bp + 4), hi, lo); const u32x4 sel = q < 2 ? hi : lo; w.ab[blk] = *(const bf16x8*)&sel; }
}
__device__ __forceinline__ void ssm_load_u(const float* U, int tb, int g, int lane, SsmU& ub) {
    const int q = lane >> 4; const float* up = U + (size_t)(tb + (lane & 15)) * 512 + g * 16 + 8 * (q & 1);
    u32x4 hi, lo; split_hilo(*(const f32x4*)up, *(const f32x4*)(up + 4), hi, lo); if (q >= 2) lo = (u32x4){0u, 0u, 0u, 0u};
    ub.hi = *(const bf16x8*)&hi; ub.lo = *(const bf16x8*)&lo;
}
template <bool WR> __device__ __forceinline__ void ssm_block16(const SsmW& w, const SsmU& ub, int lane, float& xr, float& xi, LAS float* XW) {
#pragma unroll
    for (int blk = 0; blk < 8; ++blk) { f32x4 d = {0.f, 0.f, 0.f, 0.f};
        d = __builtin_amdgcn_mfma_f32_16x16x32_bf16(w.ab[blk], ub.hi, d, 0, 0, 0); d = __builtin_amdgcn_mfma_f32_16x16x32_bf16(w.ab[blk], ub.lo, d, 0, 0, 0);
        *(LAS f32x4*)(XW + (lane & 15) * 132 + 16 * blk + 4 * (lane >> 4)) = d; }
    float br[16], bi[16];
#pragma unroll
    for (int t = 0; t < 16; ++t) { br[t] = XW[t * 132 + lane]; bi[t] = XW[t * 132 + 64 + lane]; }
#pragma unroll
    for (int t = 0; t < 16; ++t) { const float nr = fmaf(w.lr, xr, fmaf(-w.li, xi, br[t])), ni = fmaf(w.lr, xi, fmaf(w.li, xr, bi[t])); xr = nr; xi = ni;
        if (WR) { XW[t * 132 + lane] = xr; XW[t * 132 + 64 + lane] = xi; } }
}
__device__ __forceinline__ void ssm_pass_a(const Frame& F) {
    const float* U = F.out; float* SEND = (float*)(F.ws + W_SEND); LAS float* XW = (LAS float*)(F.lds + F.wid * 8448);
    const int g = (F.bid * 8 + F.wid) & 31, p = F.lane; SsmW w; ssm_load_w(F, g, p, w);
    for (int it = F.bid * 8 + F.wid; it < 256 * 32; it += F.G * 8) { const int c = it >> 5;
        float xr = 0.f, xi = 0.f;
        SsmU ub[4];
#pragma unroll
        for (int sb = 0; sb < 4; ++sb) ssm_load_u(U, c * 64 + sb * 16, g, p, ub[sb]);
#pragma unroll
        for (int sb = 0; sb < 4; ++sb) ssm_block16<false>(w, ub[sb], p, xr, xi, XW);
        SEND[(size_t)c * 4096 + g * 64 + p] = xr; SEND[(size_t)c * 4096 + 2048 + g * 64 + p] = xi; }
}
__device__ __forceinline__ void ssm_pass_b(const Frame& F, int b0) {
    float* SEND = (float*)(F.ws + W_SEND); const float* LAM64 = (const float*)(F.ws + W_LAM64);
    const int i = b0 * 512 + F.tid; if (i < 0 || i >= 2048) return;
    const float l6r = LAM64[i], l6i = LAM64[2048 + i]; float xr = 0.f, xi = 0.f;
    float nr_[16], ni_[16];
#pragma unroll
    for (int j = 0; j < 16; ++j) { nr_[j] = SEND[(size_t)j * 4096 + i]; ni_[j] = SEND[(size_t)j * 4096 + 2048 + i]; }
    for (int c0 = 0; c0 < 256; c0 += 16) { float sr[16], si[16];
#pragma unroll
        for (int j = 0; j < 16; ++j) { sr[j] = nr_[j]; si[j] = ni_[j]; }
        if (c0 + 16 < 256) {
#pragma unroll
            for (int j = 0; j < 16; ++j) { nr_[j] = SEND[(size_t)(c0 + 16 + j) * 4096 + i]; ni_[j] = SEND[(size_t)(c0 + 16 + j) * 4096 + 2048 + i]; } }
#pragma unroll
        for (int j = 0; j < 16; ++j) { SEND[(size_t)(c0 + j) * 4096 + i] = xr; SEND[(size_t)(c0 + j) * 4096 + 2048 + i] = xi;
            const float nr = fmaf(l6r, xr, fmaf(-l6i, xi, sr[j])), ni = fmaf(l6r, xi, fmaf(l6i, xr, si[j])); xr = nr; xi = ni; } }
}
__device__ __forceinline__ void ssm_pass_c(const Frame& F) {
    const float* U = F.out; bf16_t* YG = (bf16_t*)((unsigned char*)F.out + 36 * MiB); const float* SEND = (const float*)(F.ws + W_SEND);
    const float* c_re = F.a->in[18]; const float* c_im = F.a->in[19]; const float* dsk = F.a->in[20];
    LAS float* XW = (LAS float*)(F.lds + F.wid * 8448);
    const int p = F.lane, hq = 4 * (F.lane >> 4), tl = F.lane & 15;
    const int g = (F.bid * 8 + F.wid) & 31; SsmW w; ssm_load_w(F, g, p, w);
    bf16x8 cab[4];
#pragma unroll
    for (int ks = 0; ks < 4; ++ks) { const int k = 32 * ks + 8 * (F.lane >> 4); const float* cp = ks < 2 ? c_re + (size_t)(g * 16 + tl) * 64 + k : c_im + (size_t)(g * 16 + tl) * 64 + (k - 64);
        f32x4 a = *(const f32x4*)cp, b = *(const f32x4*)(cp + 4); if (ks >= 2) { a = -a; b = -b; }
        u32x4 w; w.x = cvt_pk_bf16(a[0], a[1]); w.y = cvt_pk_bf16(a[2], a[3]); w.z = cvt_pk_bf16(b[0], b[1]); w.w = cvt_pk_bf16(b[2], b[3]); cab[ks] = *(bf16x8*)&w; }
    const f32x4 ds4 = *(const f32x4*)(dsk + g * 16 + hq);
    for (int it = F.bid * 8 + F.wid; it < 9216; it += F.G * 8) {
        const bool prompt = it < 8192; const int c = prompt ? (it >> 5) : ((it - 8192) >> 5);
        float xr, xi; int tok0, nsb;
        if (prompt) { xr = SEND[(size_t)c * 4096 + g * 64 + p]; xi = SEND[(size_t)c * 4096 + 2048 + g * 64 + p];
            tok0 = c * 64; nsb = 4;
        } else { xr = F.a->in[5][(size_t)(c * 32 + g) * 64 + p]; xi = F.a->in[6][(size_t)(c * 32 + g) * 64 + p]; tok0 = TP + c * 32; nsb = 2; }
        SsmU ub[4]; f32x4 u4a[4];
#pragma unroll
        for (int sb = 0; sb < 4; ++sb) { ssm_load_u(U, tok0 + sb * 16, g, p, ub[sb]); u4a[sb] = *(const f32x4*)(U + (size_t)(tok0 + sb * 16 + tl) * 512 + g * 16 + hq); }
#pragma unroll
        for (int sb = 0; sb < 4; ++sb) { if (sb >= nsb) break; const int tb = tok0 + sb * 16;
            ssm_block16<true>(w, ub[sb], p, xr, xi, XW);
            f32x4 y0 = {0.f, 0.f, 0.f, 0.f}, y1 = {0.f, 0.f, 0.f, 0.f};
#pragma unroll
            for (int ks = 0; ks < 4; ++ks) { const LAS float* xp = XW + tl * 132 + 32 * ks + 8 * (F.lane >> 4); const f32x4 xa = *(const LAS f32x4*)xp, xb = *(const LAS f32x4*)(xp + 4);
                u32x4 w; w.x = cvt_pk_bf16(xa[0], xa[1]); w.y = cvt_pk_bf16(xa[2], xa[3]); w.z = cvt_pk_bf16(xb[0], xb[1]); w.w = cvt_pk_bf16(xb[2], xb[3]); const bf16x8 xf = *(bf16x8*)&w;
                if (ks & 1) y1 = __builtin_amdgcn_mfma_f32_16x16x32_bf16(cab[ks], xf, y1, 0, 0, 0); else y0 = __builtin_amdgcn_mfma_f32_16x16x32_bf16(cab[ks], xf, y0, 0, 0, 0); }
            f32x4 y = y0 + y1 + ds4 * u4a[sb];
#pragma unroll
            for (int j = 0; j < 4; ++j) y[j] = gelu_tanh(y[j]);
            *(u32x2*)(YG + (size_t)(tb + tl) * 512 + g * 16 + hq) = pack4(y);
        }
        if (prompt) { if (c == 255) { F.out[O_SREP + g * 64 + p] = xr; F.out[O_SIMP + g * 64 + p] = xi; } }
        else { F.out[O_SRES + (size_t)(c * 32 + g) * 64 + p] = xr; F.out[O_SIMS + (size_t)(c * 32 + g) * 64 + p] = xi; }
    }
}

__device__ __forceinline__ float wave_sum(float v) {
#pragma unroll
    for (int o = 32; o > 0; o >>= 1) v += __shfl_xor(v, o);
    return v;
}
__device__ __forceinline__ void post_rows(const Frame& F) {
    const float* PQ = (const float*)(F.ws + A_PQ); bf16_t* CQN = (bf16_t*)(F.ws + A_CQN); bf16_t* CKV = (bf16_t*)(F.ws + A_CKV); bf16_t* KPE = (bf16_t*)(F.ws + A_KPE);
    const float* gkv = F.a->in[12];
    const int l = F.lane, rstep = F.G * 8; int row = F.bid * 8 + F.wid;
    f32x4 nq0 = {0.f, 0.f, 0.f, 0.f}, nkv = nq0; u32x2 nq1 = {0u, 0u}; float npe = 0.f;
    if (row < MTOK) { const float* pr = PQ + (size_t)row * 768; nq0 = *(const f32x4*)(pr + 4 * l); nq1 = *(const u32x2*)(pr + 256 + 2 * l); nkv = *(const f32x4*)(pr + 384 + 4 * l); npe = pr[640 + l]; }
    for (; row < MTOK; row += rstep) {
        const f32x4 q0 = nq0, kv = nkv; const u32x2 q1r = nq1; const float pe = npe; const float q10 = __uint_as_float(q1r.x), q11 = __uint_as_float(q1r.y);
        if (row + rstep < MTOK) { const float* pr = PQ + (size_t)(row + rstep) * 768; nq0 = *(const f32x4*)(pr + 4 * l); nq1 = *(const u32x2*)(pr + 256 + 2 * l); nkv = *(const f32x4*)(pr + 384 + 4 * l); npe = pr[640 + l]; }
        const float sq = wave_sum((q0[0] * q0[0] + q0[1] * q0[1]) + (q0[2] * q0[2] + q0[3] * q0[3]) + q10 * q10 + q11 * q11);
        const float skv = wave_sum((kv[0] * kv[0] + kv[1] * kv[1]) + (kv[2] * kv[2] + kv[3] * kv[3]));
        const float rq = rsqrtf(sq * (1.f / 384.f) + EPSN), rkv = rsqrtf(skv * (1.f / 256.f) + EPSN);
        *(u32x2*)(CQN + (size_t)row * 384 + 4 * l) = pack4(q0 * rq); *(unsigned*)(CQN + (size_t)row * 384 + 256 + 2 * l) = cvt_pk_bf16(q10 * rq, q11 * rq);
        const f32x4 g4 = *(const f32x4*)(gkv + 4 * l); const f32x4 kvn = kv * rkv * g4; const int kr = tok_kvrow(row);
        float* oc = row < TP ? F.out + O_CKVP + (size_t)row * 256 : F.out + O_CKVS + (size_t)(row - TP) * 256; float* ok = row < TP ? F.out + O_KPEP + (size_t)row * 64 : F.out + O_KPES + (size_t)(row - TP) * 64;
        *(f32x4*)(oc + 4 * l) = kvn; *(u32x2*)(CKV + (size_t)kr * 256 + 4 * l) = pack4(kvn);
        float c, s; rope_cs(tok_pos(row), l & 31, c, s); const float other = __shfl_xor(pe, 32);
        const float ro = l < 32 ? pe * c - other * s : pe * c + other * s;
        ok[l] = ro; const float ron = __shfl_xor(ro, 1); if ((l & 1) == 0) *(unsigned*)(KPE + (size_t)swap23(kr) * 64 + l) = cvt_pk_bf16(ro, ron); }
}
__device__ __forceinline__ void final_ln(const Frame& F) {
    const float* g = F.a->in[32] + 2048; const float* b = F.a->in[33] + 2048;
    const int rstep = F.G * 8; int row = F.bid * 8 + F.wid; f32x4 nv[4];
#pragma unroll
    for (int i = 0; i < 4; ++i) nv[i] = row < MTOK ? *(const f32x4*)(F.out + O_Y + (size_t)row * 1024 + i * 256 + 4 * F.lane) : (f32x4){0.f, 0.f, 0.f, 0.f};
    for (; row < MTOK; row += rstep) { float* pr = F.out + O_Y + (size_t)row * 1024; f32x4 v[4]; float s = 0.f;
#pragma unroll
        for (int i = 0; i < 4; ++i) { v[i] = nv[i]; s += (v[i][0] + v[i][1]) + (v[i][2] + v[i][3]); }
        if (row + rstep < MTOK) {
#pragma unroll
            for (int i = 0; i < 4; ++i) nv[i] = *(const f32x4*)(pr + (size_t)rstep * 1024 + i * 256 + 4 * F.lane); }
        if (row >= TP) {
            const float* ST2 = (const float*)(F.ws + W_ST2); float mu2, rstd2; ln_stats16(ST2, ST2 + 16 * MTOK, row, mu2, rstd2);
            const float* SL = (const float*)(F.ws + A_R2B) + (size_t)(row - TP) * 1024; s = 0.f;
#pragma unroll
            for (int i = 0; i < 4; ++i) { const int c = i * 256 + 4 * F.lane; const f32x4 g1 = *(const f32x4*)(F.a->in[32] + 1024 + c), b1 = *(const f32x4*)(F.a->in[33] + 1024 + c);
                f32x4 a = (v[i] - mu2) * rstd2 * g1 + b1; a = a * ALPHA;
#pragma unroll
                for (int k = 0; k < 8; ++k) a = a + *(const f32x4*)(SL + (size_t)k * 1024 * 1024 + c);
                v[i] = a; s += (a[0] + a[1]) + (a[2] + a[3]); } }
        const float mu = wave_sum(s) * (1.f / 1024.f); float q = 0.f;
#pragma unroll
        for (int i = 0; i < 4; ++i) { const f32x4 d = v[i] - mu; q += (d[0] * d[0] + d[1] * d[1]) + (d[2] * d[2] + d[3] * d[3]); }
        const float rstd = rsqrtf(wave_sum(q) * (1.f / 1024.f) + EPSN);
#pragma unroll
        for (int i = 0; i < 4; ++i) { const f32x4 g4 = *(const f32x4*)(g + i * 256 + 4 * F.lane), b4 = *(const f32x4*)(b + i * 256 + 4 * F.lane); *(f32x4*)(pr + i * 256 + 4 * F.lane) = (v[i] - mu) * rstd * g4 + b4; } }
}

struct MapId { __device__ __forceinline__ int operator()(int n) const { return n; } };
struct MapWin { __device__ __forceinline__ int operator()(int n) const { return n < 1216 ? n : -1; } };
struct MapWq { __device__ __forceinline__ int operator()(int n) const { if (n < 512) return (n >> 7) * 192 + (n & 127); const int x = n - 512, part = x >> 7, h = (x >> 5) & 3, i = x & 31; return h * 192 + 128 + part * 32 + i; } };
struct MapWk { __device__ __forceinline__ int operator()(int n) const { return (n >> 7) * 256 + (n & 127); } };
struct MapWv { __device__ __forceinline__ int operator()(int n) const { return (n >> 7) * 256 + 128 + (n & 127); } };
struct MapGlu { __device__ __forceinline__ int operator()(int n) const { const int pn = n >> 8, bj = (n >> 7) & 1, x = n & 127; return bj * 512 + pn * 128 + x; } };
template <class CM, bool PERMK = false> __device__ __forceinline__ void wconv(const Frame& F, bf16_t* __restrict__ dst, const float* __restrict__ src, int ld, int K, int N, CM cm, const float* sc0, const float* sc1, int ksplit, int& rot) {
    const int ntn = N >> 5, ntiles = ntn * (K >> 6), tid = F.tid, kr = tid >> 3, nq = tid & 7;
    LAS float* T = (LAS float*)F.lds;
    for (int base = ((F.bid + F.G - rot % F.G) % F.G) * 4; base < ntiles; base += F.G * 4) { f32x4 v[4];
#pragma unroll
        for (int u = 0; u < 4; ++u) { const int tile = base + u; v[u] = (f32x4){0.f, 0.f, 0.f, 0.f};
            if (tile < ntiles) { const int tn = tile % ntn, tk = tile / ntn, col = cm(tn * 32), k = tk * 64 + kr;
                if (col >= 0) { v[u] = *(const f32x4*)(src + (size_t)k * ld + col + 4 * nq); if (sc0) v[u] = v[u] * (k < ksplit ? sc0[k] : sc1[k - ksplit]); } } }
#pragma unroll
        for (int u = 0; u < 4; ++u) {
#pragma unroll
            for (int j = 0; j < 4; ++j) T[u * 2112 + kr * 33 + 4 * nq + j] = v[u][j]; }
        __syncthreads();
        { const int half = tid >> 8, tt = tid & 255, n = tt >> 3, kq = tt & 7;
#pragma unroll
          for (int uu = 0; uu < 2; ++uu) { const int u = half * 2 + uu, tile = base + u;
              if (tile < ntiles) { const int tn = tile % ntn, tk = tile / ntn; float x[8];
#pragma unroll
                  for (int j = 0; j < 8; ++j) { const int pos = 8 * kq + j, kk = PERMK ? ((pos & ~12) | ((pos & 4) << 1) | ((pos & 8) >> 1)) : pos; x[j] = T[u * 2112 + kk * 33 + n]; }
                  u32x4 w; w.x = cvt_pk_bf16(x[0], x[1]); w.y = cvt_pk_bf16(x[2], x[3]); w.z = cvt_pk_bf16(x[4], x[5]); w.w = cvt_pk_bf16(x[6], x[7]);
                  *(u32x4*)(dst + (size_t)(tn * 32 + n) * K + tk * 64 + 8 * kq) = w; } } }
        __syncthreads(); }
    rot += (ntiles + 3) >> 2;
}
__device__ __forceinline__ void cvt_flat(const Frame& F, bf16_t* __restrict__ dst, const float* __restrict__ src, long n8) {
    const long gs = (long)F.G * 512;
    for (long base = (long)F.bid * 512 + F.tid; base < n8; base += 4 * gs) { f32x4 a[4], b[4];
#pragma unroll
        for (int u = 0; u < 4; ++u) { const long i = base + u * gs; const long ii = i < n8 ? i : 0; a[u] = *(const f32x4*)(src + ii * 8); b[u] = *(const f32x4*)(src + ii * 8 + 4); }
#pragma unroll
        for (int u = 0; u < 4; ++u) { const long i = base + u * gs; if (i < n8) { u32x4 w; w.x = cvt_pk_bf16(a[u][0], a[u][1]); w.y = cvt_pk_bf16(a[u][2], a[u][3]); w.z = cvt_pk_bf16(b[u][0], b[u][1]); w.w = cvt_pk_bf16(b[u][2], b[u][3]); *(u32x4*)(dst + i * 8) = w; } } }
}
__device__ __forceinline__ void colsum_job(const Frame& F, const float* W, int N, const float* g, const float* b, float* cs, float* bw, int rotb) {
    LAS float* red = (LAS float*)F.lds;
    const int seg = F.tid >> 4, col = F.tid & 15;
    for (int task = (F.bid + F.G - rotb % F.G) % F.G; task < N / 16; task += F.G) { const int n = task * 16 + col; float s = 0.f, t = 0.f;
#pragma unroll
        for (int j = 0; j < 32; ++j) { const int k = seg * 32 + j; const float w = W[(size_t)k * N + n]; s += bf16_round(w * g[k]); t = fmaf(b[k], w, t); }
        red[F.tid] = s; red[512 + F.tid] = t; __syncthreads();
        if (F.tid < 16) { float a = 0.f, c = 0.f;
#pragma unroll
            for (int i = 0; i < 32; ++i) { a += red[i * 16 + F.tid]; c += red[512 + i * 16 + F.tid]; }
            cs[n] = a; bw[n] = c; }
        __syncthreads(); }
}
__device__ __forceinline__ void ssm_consts(const Frame& F) {
    const int i = F.bid * 512 + F.tid; if (i >= 2048) return;
    const int g = i >> 6; float* LAM = (float*)(F.ws + W_LAM); float* LAM64 = (float*)(F.ws + W_LAM64); float* BB = (float*)(F.ws + W_BB);
    const double ar = F.a->in[14][i], ai = F.a->in[15][i], dt = exp((double)F.a->in[21][g]);
    const double mag = exp(ar * dt), lr = mag * cos(ai * dt), li = mag * sin(ai * dt);
    LAM[i] = (float)lr; LAM[2048 + i] = (float)li;
    double pr = lr, pi = li;
#pragma unroll
    for (int k = 0; k < 6; ++k) { const double nr = pr * pr - pi * pi, ni = 2.0 * pr * pi; pr = nr; pi = ni; }
    LAM64[i] = (float)pr; LAM64[2048 + i] = (float)pi;
    const double nr = lr - 1.0, ni = li, den = ar * ar + ai * ai, fr = (nr * ar + ni * ai) / den, fi = (ni * ar - nr * ai) / den;
#pragma unroll
    for (int h = 0; h < 16; ++h) { const double br = F.a->in[16][(size_t)i * 16 + h], bi = F.a->in[17][(size_t)i * 16 + h];
        BB[(size_t)i * 16 + h] = (float)(fr * br - fi * bi); BB[32768 + (size_t)i * 16 + h] = (float)(fr * bi + fi * br); }
}
__device__ __forceinline__ void cvt_caches(const Frame& F, int b0, int nb) {
    unsigned char* ws = F.ws; { bf16_t* CKV = (bf16_t*)(ws + A_CKV); bf16_t* KPE = (bf16_t*)(ws + A_KPE); const long gs = (long)nb * 512;
#pragma unroll 4
      for (long i = (long)b0 * 512 + F.tid; i < 32L * 1024 * 32; i += gs) { const int c8 = (int)(i & 31), j = (int)((i >> 5) & 1023), bb = (int)(i >> 15);
          const float* s = F.a->in[3] + ((size_t)(bb * 1024 + j) * 256 + c8 * 8); const f32x4 a = *(const f32x4*)s, b = *(const f32x4*)(s + 4);
          u32x4 w; w.x = cvt_pk_bf16(a[0], a[1]); w.y = cvt_pk_bf16(a[2], a[3]); w.z = cvt_pk_bf16(b[0], b[1]); w.w = cvt_pk_bf16(b[2], b[3]);
          *(u32x4*)(CKV + (size_t)(TP + bb * KVS + j) * 256 + c8 * 8) = w; }
#pragma unroll 2
      for (long i = (long)b0 * 512 + F.tid; i < 32L * 1024 * 8; i += gs) { const int c8 = (int)(i & 7), j = (int)((i >> 3) & 1023), bb = (int)(i >> 13);
          const float* s = F.a->in[4] + ((size_t)(bb * 1024 + j) * 64 + c8 * 8); const f32x4 a = *(const f32x4*)s, b = *(const f32x4*)(s + 4);
          u32x4 w; w.x = cvt_pk_bf16(a[0], a[1]); w.y = cvt_pk_bf16(a[2], a[3]); w.z = cvt_pk_bf16(b[0], b[1]); w.w = cvt_pk_bf16(b[2], b[3]);
          *(u32x4*)(KPE + (size_t)swap23(TP + bb * KVS + j) * 64 + c8 * 8) = w; } }
}
#ifndef PRO_DUP
#define PRO_DUP 0
#endif
#define DUPP(j) _Pragma("unroll") for (int rp_ = 0; rp_ < (((PRO_DUP >> (j)) & 1) ? 2 : 1); ++rp_)
__device__ __forceinline__ void prologue(const Frame& F) {
    unsigned char* ws = F.ws;
    DUPP(0) ssm_consts(F);
    int rot = 8;
    DUPP(1) {
    wconv(F, (bf16_t*)(ws + W_WIN), F.a->in[9], 1216, 1024, 1280, MapWin(), nullptr, nullptr, 0, rot);
    }
    DUPP(2) {
    if (F.G > 8) { if (F.bid >= 4) { Frame F2 = F; F2.bid = F.bid - 4; F2.G = F.G - 4; cvt_flat(F2, (bf16_t*)(ws + A_XB), F.a->in[0], (long)TP * 128); } }
    else cvt_flat(F, (bf16_t*)(ws + A_XB), F.a->in[0], (long)TP * 128);
    cvt_flat(F, (bf16_t*)(ws + A_XB) + (size_t)TP * 1024, F.a->in[1], (long)TS * 128);
    cvt_flat(F, (bf16_t*)(ws + W_MEMB), F.a->in[2], 256 * 128);
    }
    DUPP(1) {
    wconv(F, (bf16_t*)(ws + W_WXK), F.a->in[27], 1024, 1024, 1024, MapId(), nullptr, nullptr, 0, rot);
    wconv(F, (bf16_t*)(ws + W_WXV), F.a->in[28], 1024, 1024, 1024, MapId(), nullptr, nullptr, 0, rot);
    wconv(F, (bf16_t*)(ws + W_WQ), F.a->in[11], 768, 384, 768, MapWq(), F.a->in[10], F.a->in[10], 384, rot);
    wconv(F, (bf16_t*)(ws + W_WK), F.a->in[13], 1024, 256, 512, MapWk(), nullptr, nullptr, 0, rot);
    wconv(F, (bf16_t*)(ws + W_WV), F.a->in[13], 1024, 256, 512, MapWv(), nullptr, nullptr, 0, rot);
    wconv(F, (bf16_t*)(ws + W_WGLU), F.a->in[22], 1024, 512, 1024, MapGlu(), nullptr, nullptr, 0, rot);
    wconv(F, (bf16_t*)(ws + W_WO), F.a->in[25], 1024, 1024, 1024, MapId(), F.a->in[23], F.a->in[24], 512, rot);
    wconv(F, (bf16_t*)(ws + W_WXQ), F.a->in[26], 1024, 1024, 1024, MapId(), F.a->in[32], F.a->in[32], 1024, rot);
    wconv(F, (bf16_t*)(ws + W_WXO), F.a->in[29], 1024, 1024, 1024, MapId(), nullptr, nullptr, 0, rot);
    wconv(F, (bf16_t*)(ws + W_WFF1), F.a->in[30], 4096, 1024, 4096, MapId(), F.a->in[32] + 1024, F.a->in[32] + 1024, 1024, rot);
    wconv(F, (bf16_t*)(ws + W_WFF2), F.a->in[31], 1024, 4096, 1024, MapId(), nullptr, nullptr, 0, rot);
    }
    DUPP(4) {
    colsum_job(F, F.a->in[26], 1024, F.a->in[32], F.a->in[33], (float*)(ws + W_CSXQ), (float*)(ws + W_BWXQ), 0);
    colsum_job(F, F.a->in[30], 4096, F.a->in[32] + 1024, F.a->in[33] + 1024, (float*)(ws + W_CSFF1), (float*)(ws + W_BWFF1), 64);
    }
}
__device__ __forceinline__ void cvt_memcache(const Frame& F, int b0, int bstride) {
    bf16_t* XKS = (bf16_t*)(F.ws + A_XKS); bf16_t* XVTS = (bf16_t*)(F.ws + A_XVTS); const float* ck = F.a->in[7]; const float* cv = F.a->in[8];
    const long gs = (long)bstride * 512;
    for (long i = (long)b0 * 512 + F.tid; i < 32L * 256 * 128; i += gs) { const f32x4 a = *(const f32x4*)(ck + i * 8), b = *(const f32x4*)(ck + i * 8 + 4);
        const long rowi = i >> 7, c8 = i & 127; const long drow = (rowi & ~255L) | swap23((int)(rowi & 255));
        u32x4 w; w.x = cvt_pk_bf16(a[0], a[1]); w.y = cvt_pk_bf16(a[2], a[3]); w.z = cvt_pk_bf16(b[0], b[1]); w.w = cvt_pk_bf16(b[2], b[3]); *(u32x4*)(XKS + drow * 1024 + c8 * 8) = w; }
    { Frame F2 = F; F2.bid = b0; F2.G = bstride; int rot = 0;
      for (int bb = 0; bb < 32; ++bb) wconv<MapId, false>(F2, XVTS + (size_t)bb * 262144, cv + (size_t)bb * 262144, 1024, 256, 1024, MapId(), nullptr, nullptr, 0, rot); }
}

#define XB_TMO      128
#define XB_XCNT(j)  (256  + 64 * (j))
#define XB_XSUB(j)  (1280 + 64 * (j))
#define XB_XGEN(j)  (2304 + 64 * (j))
#define XB_TOP      3328
#define XB_TOPGEN   3392
#define XCD_BAR_WORDS 3456
#define XB_SPIN_CAP (1u << 18)

__device__ __forceinline__ unsigned xb_ld(unsigned* p)              { return __hip_atomic_load(p, __ATOMIC_RELAXED, __HIP_MEMORY_SCOPE_AGENT); }
__device__ __forceinline__ unsigned xb_add(unsigned* p, unsigned v) { return __hip_atomic_fetch_add(p, v, __ATOMIC_RELAXED, __HIP_MEMORY_SCOPE_AGENT); }
__device__ __forceinline__ unsigned xb_xcc_id() { return (unsigned)__builtin_amdgcn_s_getreg((3 << 11) | 20) & 0xFu; }
#define XB_SPIN(cond, bar) do { unsigned _sp = 0; while (cond) { __builtin_amdgcn_s_sleep(1); \
    if ((++_sp & 255u) == 0u) { if (xb_ld(&(bar)[XB_TMO])) break; if (_sp > XB_SPIN_CAP) { atomicAdd(&(bar)[XB_TMO], 1u); break; } } } } while (0)

struct XcdBarrier {
    unsigned* bar; unsigned x;
    volatile LAS unsigned* st;
};

__device__ __forceinline__ XcdBarrier xcd_barrier_post(unsigned* bar, volatile LAS unsigned* st) {
    XcdBarrier b; b.bar = bar; b.x = xb_xcc_id(); b.st = st;
    if (threadIdx.x == 0) (void)xb_add(&bar[XB_XCNT(b.x)], 1u);
    return b;
}
__device__ __forceinline__ void xcd_barrier_complete(unsigned* bar, unsigned x, unsigned& nloc, unsigned& nx) {
    const unsigned G = gridDim.x * gridDim.y * gridDim.z;
    unsigned sum, cnt, mine, sp = 0u;
    for (;;) {
        sum = 0u; cnt = 0u; mine = 0u;
#pragma unroll
        for (unsigned j = 0; j < 16; ++j) { const unsigned c = xb_ld(&bar[XB_XCNT(j)]); sum += c; cnt += (c > 0u) ? 1u : 0u; mine = (j == x) ? c : mine; }
        if (sum == G) break;
        __builtin_amdgcn_s_sleep(1);
        if ((++sp & 255u) == 0u) { if (xb_ld(&bar[XB_TMO])) break; if (sp > XB_SPIN_CAP) { atomicAdd(&bar[XB_TMO], 1u); break; } }
    }
    nloc = mine > 0u ? mine : 1u; nx = cnt > 0u ? cnt : 1u;
}

__device__ __forceinline__ void xcd_barrier(const XcdBarrier& b) {
    asm volatile("s_waitcnt vmcnt(0)" ::: "memory");
    __syncthreads();
    if (threadIdx.x == 0) {
        unsigned* bar = b.bar;
        __builtin_amdgcn_s_waitcnt(0);
        unsigned nloc = b.st[0], nx = b.st[1];
        if (nloc == 0u) { xcd_barrier_complete(bar, b.x, nloc, nx); b.st[0] = nloc; b.st[1] = nx; }
        const unsigned old = xb_add(&bar[XB_XSUB(b.x)], 1u);
        const unsigned gen = old / nloc;
        if (old + 1u == (gen + 1u) * nloc) {
            __builtin_amdgcn_fence(__ATOMIC_RELEASE, "agent");
            asm volatile("s_waitcnt vmcnt(0)" ::: "memory");
            const unsigned og = xb_add(&bar[XB_TOP], 1u);
            const unsigned tg = og / nx;
            if (og + 1u == (tg + 1u) * nx) xb_add(&bar[XB_TOPGEN], 1u);
            else XB_SPIN(xb_ld(&bar[XB_TOPGEN]) == tg, bar);
            __builtin_amdgcn_fence(__ATOMIC_ACQUIRE, "agent");
            xb_add(&bar[XB_XGEN(b.x)], 1u);
            asm volatile("s_waitcnt vmcnt(0)" ::: "memory");
        } else {
            XB_SPIN(xb_ld(&bar[XB_XGEN(b.x)]) == gen, bar);
            __builtin_amdgcn_fence(__ATOMIC_ACQUIRE, "agent");
            asm volatile("s_waitcnt vmcnt(0)" ::: "memory");
        }
    }
    __syncthreads();
}

constexpr int NPHASE = 13;
#ifndef PHASE_MASK
#define PHASE_MASK 0x1FFF
#endif
#ifndef SUBMASK
#define SUBMASK 0xFF
#endif
#define SUB(j) if ((SUBMASK >> (j)) & 1)
#ifndef DUP_MASK
#define DUP_MASK 0
#endif
#define DUP(k) _Pragma("unroll") for (int rep_ = 0; rep_ < (((DUP_MASK >> (k)) & 1) ? 2 : 1); ++rep_)
#define PH(k) if (!((PHASE_MASK >> (k)) & 1)) break;
using pg8::Gemm; using pg8::StaticOrder;
#define RUN_GEMM_LN(EPI, gm, e, PS_, PQ_) do { StaticOrder S_; S_.init((gm).M, (gm).N, F.G, F.bid, 0); ln_fill_tab(S_, PS_, PQ_, (LAS float*)(F.lds + 131072)); pg8::gemm_phase<EPI, StaticOrder, true, true>(F.lds, gm, S_, e); } while (0)
#define RUN_GEMM(EPI, gm, e, rot) do { StaticOrder S_; S_.init((gm).M, (gm).N, F.G, F.bid, rot); pg8::gemm_phase<EPI, StaticOrder, true, true>(F.lds, gm, S_, e); } while (0)

#define WS (F.ws)
#define U (F.a->out)
#define YG ((bf16_t*)((unsigned char*)F.a->out + 36 * MiB))
#define STSSM ((float*)(WS + W_STSSM))
#define STMLA ((float*)(WS + W_STMLA))
#define ST1 ((float*)(WS + W_ST1))
#define ST2 ((float*)(WS + W_ST2))
#define KN ((bf16_t*)(WS + A_KN))
#define VT ((bf16_t*)(WS + A_VT))
#define Q ((bf16_t*)(WS + A_Q))
#define KPE ((bf16_t*)(WS + A_KPE))
#define MIX ((bf16_t*)(WS + A_MIX))
#define R (F.a->out + O_Y)
__global__ void __launch_bounds__(512, 2) fwd_kernel(Args a) {
    extern __shared__ __attribute__((aligned(16))) unsigned char lds_raw[];
    Frame F;
    F.a = (const Args*)__builtin_amdgcn_kernarg_segment_ptr();
    F.out = a.out; F.ws = a.ws; F.lds = (LAS unsigned char*)lds_raw; F.tid = threadIdx.x; F.lane = F.tid & 63; F.wid = __builtin_amdgcn_readfirstlane(F.tid >> 6); F.G = gridDim.x; F.bid = blockIdx.x;
    const int lo = a.ph_lo, hi = a.ph_hi;
    volatile LAS unsigned* bst = (volatile LAS unsigned*)(F.lds + LDS_BYTES - 16);
    if (F.tid < 2) bst[F.tid] = 0u;
    __syncthreads();
    (void)xcd_barrier_post((unsigned*)(WS + W_BAR), bst);
    if (hi > 1000) cg::this_grid().sync();
#define GSYNC(k) if ((k) + 1 < hi) { XcdBarrier b_; b_.bar = (unsigned*)(F.a->ws + W_BAR); b_.x = xb_xcc_id(); b_.st = (volatile LAS unsigned*)(F.lds + LDS_BYTES - 16); xcd_barrier(b_); }
        if (((PHASE_MASK >> 0) & 1) && lo <= 0 && 0 < hi) DUP(0) { prologue(F); }
        if (lo <= 0 && 0 < hi) GSYNC(0)
        if (((PHASE_MASK >> 1) & 1) && lo <= 1 && 1 < hi) DUP(1) { {
            SUB(0) { Gemm g{(const bf16_t*)(WS + A_XB), (const bf16_t*)(WS + W_WIN), MTOK, 1280, 1024}; EpiProj e{U, (float*)(WS + A_PQ)}; RUN_GEMM(EpiProj, g, e, 0); }
            SUB(1) { Gemm g{(const bf16_t*)(WS + W_MEMB), (const bf16_t*)(WS + W_WXK), 256, 1024, 1024}; EpiStore<false> e{(bf16_t*)(WS + W_XK0), 1024, F.a->out + O_MKP, 1024, nullptr, 0, 1}; RUN_GEMM(EpiStore<false>, g, e, 172); }
            SUB(2) { Gemm g{(const bf16_t*)(WS + W_WXV), (const bf16_t*)(WS + W_MEMB), 1024, 256, 1024}; EpiStore<false> e{(bf16_t*)(WS + W_XVT0), 256, nullptr, 0, F.a->out + O_MVP, 1024, 0}; RUN_GEMM(EpiStore<false>, g, e, 168); }
            if (F.G > 92) { if (F.bid >= 92) cvt_caches(F, F.bid - 92, F.G - 92); } else cvt_caches(F, F.bid, F.G);
        } }
        if (lo <= 1 && 1 < hi) GSYNC(1)
        if (((PHASE_MASK >> 2) & 1) && lo <= 2 && 2 < hi) DUP(2) { post_rows(F); ssm_pass_a(F); }
        if (lo <= 2 && 2 < hi) GSYNC(2)
        if (((PHASE_MASK >> 3) & 1) && lo <= 3 && 3 < hi) DUP(3) { {
            SUB(0) ssm_pass_b(F, F.bid - (F.G - 4)); __syncthreads();
            SUB(1) { Gemm g{(const bf16_t*)(WS + A_CQN), (const bf16_t*)(WS + W_WQ), MTOK, 768, 384}; EpiQ e{Q}; RUN_GEMM(EpiQ, g, e, 0); }
            SUB(2) { Gemm g{(const bf16_t*)(WS + A_CKV), (const bf16_t*)(WS + W_WK), KVROWS, 512, 256}; EpiStore<false> e{KN, 512, nullptr, 0, nullptr, 0, 1}; RUN_GEMM(EpiStore<false>, g, e, 52); }
            SUB(3) { Gemm g{(const bf16_t*)(WS + W_WV), (const bf16_t*)(WS + A_CKV), 512, KVROWS, 256}; EpiStore<false> e{VT, KVPAD, nullptr, 0, nullptr, 0, 0}; RUN_GEMM(EpiStore<false>, g, e, 172); }
        } }
        if (lo <= 3 && 3 < hi) GSYNC(3)
        if (((PHASE_MASK >> 4) & 1) && lo <= 4 && 4 < hi) DUP(4) { ssm_pass_c(F); }
        if (lo <= 4 && 4 < hi) GSYNC(4)
        if (((PHASE_MASK >> 5) & 1) && lo <= 5 && 5 < hi) DUP(5) { {
            SUB(0) { Gemm g{YG, (const bf16_t*)(WS + W_WGLU), MTOK, 1024, 512}; EpiGlu e{MIX, STSSM}; RUN_GEMM(EpiGlu, g, e, 0); }
            SUB(1) DUP(13) for (int it = F.bid; it < 256; it += F.G) { const int y = it >> 2, h = it & 3;
                for (int pass = 0; pass < 2; ++pass) { const int x = pass ? y : 127 - y, q0 = x * 128, rg = F.wid & 3;
                    attn_unit<192, 128, 128, false>(F.lds, Q + (size_t)q0 * 768 + h * 192, 768, KN + h * 128, 512, KPE, VT + (size_t)(h * 128) * KVPAD, KVPAD,
                                                    (q0 >> 6) + 2, 64 * ((q0 >> 6) + (rg >> 1) + 1), MIX + (size_t)q0 * 1024 + 512 + h * 128, 1024, STMLA + (size_t)h * MTOK + q0, 128); } }
            SUB(2) DUP(14) for (int it = F.G - 1 - F.bid; it < 128; it += F.G) { const int b = it >> 2, h = it & 3, q0 = TP + b * 32, k0 = TP + b * KVS, rg = F.wid & 3;
                attn_unit<192, 128, 128, false>(F.lds, Q + (size_t)q0 * 768 + h * 192, 768, KN + (size_t)k0 * 512 + h * 128, 512, KPE + (size_t)k0 * 64, VT + (size_t)(h * 128) * KVPAD + k0, KVPAD,
                                                17, rg == 0 ? KVS : 0, MIX + (size_t)q0 * 1024 + 512 + h * 128, 1024, STMLA + (size_t)h * MTOK + q0, 32); }
        } }
        if (lo <= 5 && 5 < hi) GSYNC(5)
        if (((PHASE_MASK >> 6) & 1) && lo <= 6 && 6 < hi) DUP(6) { {
            { Gemm g{MIX, (const bf16_t*)(WS + W_WO), MTOK, 1024, 1024};
              LAS float* tab = (LAS float*)(F.lds + 131072);
              EpiRes<0> e{F.a->in[0], F.a->in[1], R, (bf16_t*)(WS + A_R1B), nullptr, nullptr, nullptr, nullptr, ST1, ST1 + 16 * MTOK, tab};
              StaticOrder S_; S_.init(g.M, g.N, F.G, F.bid, 0); Unit u0;
              if (S_.next(0, u0)) wo_fill_tab(u0, STSSM, STMLA, tab);
              if (S_.next(1, u0)) wo_fill_tab(u0, STSSM, STMLA, tab);
              __syncthreads();
              pg8::gemm_phase<EpiRes<0>, StaticOrder, true, true>(F.lds, g, S_, e); }
            if (F.G > 16) { if (F.bid >= 16) cvt_memcache(F, F.bid - 16, F.G - 16); } else cvt_memcache(F, F.bid, F.G);
        } }
        if (lo <= 6 && 6 < hi) GSYNC(6)
        if (((PHASE_MASK >> 7) & 1) && lo <= 7 && 7 < hi) DUP(7) { { Gemm g{(const bf16_t*)(WS + A_R1B), (const bf16_t*)(WS + W_WXQ), MTOK, 1024, 1024};
            EpiLnAct<0> e{(const LAS float*)(F.lds + 131072), (const float*)(WS + W_CSXQ), (const float*)(WS + W_BWXQ), (bf16_t*)(WS + A_XQ), 1024}; RUN_GEMM_LN(EpiLnAct<0>, g, e, ST1, ST1 + 16 * MTOK); } }
        if (lo <= 7 && 7 < hi) GSYNC(7)
        if (((PHASE_MASK >> 8) & 1) && lo <= 8 && 8 < hi) DUP(8) { {
            const bf16_t* XQ = (const bf16_t*)(WS + A_XQ); bf16_t* XO = (bf16_t*)(WS + A_XO);
            for (int it = F.bid; it < 640; it += F.G) {
                if (it < 512) { const int x = it >> 2, h = it & 3, q0 = x * 128;
                    attn_unit<256, 256, 256, true>(F.lds, XQ + (size_t)q0 * 1024 + h * 256, 1024, (const bf16_t*)(WS + W_XK0) + h * 256, 1024, nullptr, (const bf16_t*)(WS + W_XVT0) + (size_t)h * 65536, 256,
                                                   4, 256, XO + (size_t)q0 * 1024 + h * 256, 1024, nullptr, 128); }
                else { const int b = (it - 512) >> 2, h = it & 3, q0 = TP + b * 32, rg = F.wid & 3;
                    attn_unit<256, 256, 256, true>(F.lds, XQ + (size_t)q0 * 1024 + h * 256, 1024, (const bf16_t*)(WS + A_XKS) + (size_t)b * 262144 + h * 256, 1024, nullptr,
                                                   (const bf16_t*)(WS + A_XVTS) + (size_t)(b * 4 + h) * 65536, 256, 4, rg == 0 ? 256 : 0, XO + (size_t)q0 * 1024 + h * 256, 1024, nullptr, 32); } }
        } }
        if (lo <= 8 && 8 < hi) GSYNC(8)
        if (((PHASE_MASK >> 9) & 1) && lo <= 9 && 9 < hi) DUP(9) { { Gemm g{(const bf16_t*)(WS + A_XO), (const bf16_t*)(WS + W_WXO), MTOK, 1024, 1024};
            EpiRes<1> e{nullptr, nullptr, R, (bf16_t*)(WS + A_R2B), nullptr, nullptr, F.a->in[32], F.a->in[33], ST2, ST2 + 16 * MTOK, (const LAS float*)(F.lds + 131072)}; RUN_GEMM_LN(EpiRes<1>, g, e, ST1, ST1 + 16 * MTOK); } }
        if (lo <= 9 && 9 < hi) GSYNC(9)
        if (((PHASE_MASK >> 10) & 1) && lo <= 10 && 10 < hi) DUP(10) { { Gemm g{(const bf16_t*)(WS + A_R2B), (const bf16_t*)(WS + W_WFF1), MTOK, 4096, 1024};
            EpiLnAct<1> e{(const LAS float*)(F.lds + 131072), (const float*)(WS + W_CSFF1), (const float*)(WS + W_BWFF1), (bf16_t*)(WS + A_Z), 4096}; RUN_GEMM_LN(EpiLnAct<1>, g, e, ST2, ST2 + 16 * MTOK); } }
        if (lo <= 10 && 10 < hi) GSYNC(10)
        if (((PHASE_MASK >> 11) & 1) && lo <= 11 && 11 < hi) DUP(11) { { Gemm g{(const bf16_t*)(WS + A_Z), (const bf16_t*)(WS + W_WFF2), TP, 1024, 4096};
            EpiRes<1> e{nullptr, nullptr, R, nullptr, nullptr, nullptr, F.a->in[32] + 1024, F.a->in[33] + 1024, ST1, ST1 + 16 * MTOK, (const LAS float*)(F.lds + 131072)}; RUN_GEMM_LN(EpiRes<1>, g, e, ST2, ST2 + 16 * MTOK); }
          { Gemm g{(const bf16_t*)(WS + A_Z) + (size_t)TP * 4096, (const bf16_t*)(WS + W_WFF2), TS, 1024, 512, 4096};
            pg8::SplitKOrder S_{16, 4, 8, 512, F.G, F.bid}; EpiSlab e{(float*)(WS + A_R2B)}; pg8::gemm_phase<EpiSlab, pg8::SplitKOrder, true, true>(F.lds, g, S_, e); } }
        if (lo <= 11 && 11 < hi) GSYNC(11)
        if (((PHASE_MASK >> 12) & 1) && lo <= 12 && 12 < hi) DUP(12) { final_ln(F); }
}

#undef WS
#undef U
#undef YG
#undef STSSM
#undef STMLA
#undef ST1
#undef ST2
#undef KN
#undef VT
#undef Q
#undef KPE
#undef MIX
#undef R
extern "C" void kernel_launch(void* const* d_in, const int* in_sizes, int n_in, void* d_out, int out_size, void* d_ws, size_t ws_size, hipStream_t stream) {
    static int grid = 0;
    if (grid == 0) {
        int dev = 0, cus = 0, per_cu = 0;
        (void)hipGetDevice(&dev); (void)hipDeviceGetAttribute(&cus, hipDeviceAttributeMultiprocessorCount, dev);
        if (hipFuncSetAttribute((const void*)fwd_kernel, hipFuncAttributeMaxDynamicSharedMemorySize, LDS_BYTES) != hipSuccess) fprintf(stderr, "kernel_launch: hipFuncSetAttribute failed\n");
        if (hipOccupancyMaxActiveBlocksPerMultiprocessor(&per_cu, (const void*)fwd_kernel, 512, LDS_BYTES) != hipSuccess || per_cu < 1) { fprintf(stderr, "kernel_launch: occupancy query says %d\n", per_cu); per_cu = 1; }
        (void)hipGetLastError();
        grid = cus > 0 ? cus : 256;
        if (n_in != 34 || ws_size < WS_END) fprintf(stderr, "kernel_launch: unexpected n_in %d / ws_size %zu (need %zu)\n", n_in, ws_size, (size_t)WS_END);
    }
    if (hipMemsetAsync((char*)d_ws + W_BAR, 0, BAR_BYTES, stream) != hipSuccess) fprintf(stderr, "kernel_launch: memset failed\n");
    Args a{};
    for (int i = 0; i < 34; ++i) a.in[i] = (const float*)d_in[i];
    a.out = (float*)d_out; a.ws = (unsigned char*)d_ws;
#if N_LAUNCH_MODE == 1
    a.ph_lo = 0; a.ph_hi = NPHASE;
    void* args[] = {&a};
    hipError_t e = hipLaunchCooperativeKernel((const void*)fwd_kernel, dim3(grid), dim3(512), args, LDS_BYTES, stream);
    if (e != hipSuccess) fprintf(stderr, "cooperative launch failed: %s (grid %d)\n", hipGetErrorString(e), grid);
#else
    for (int ph = 0; ph < NPHASE; ++ph) { a.ph_lo = ph; a.ph_hi = ph + 1; hipLaunchKernelGGL(fwd_kernel, dim3(grid), dim3(512), LDS_BYTES, stream, a); }
#endif
}
```

```cpp
#include <hip/hip_runtime.h>
#include <hip/hip_cooperative_groups.h>
#include <cstdio>
#include <cstdint>
namespace cg = cooperative_groups;

#ifndef N_LAUNCH_MODE
#define N_LAUNCH_MODE 1
#endif

#define LAS __attribute__((address_space(3)))
#define PG8_LAS LAS
typedef unsigned short bf16_t;
typedef short bf16x8 __attribute__((ext_vector_type(8)));
typedef float f32x4 __attribute__((ext_vector_type(4)));
typedef float f32x16 __attribute__((ext_vector_type(16)));
typedef unsigned u32x4 __attribute__((ext_vector_type(4)));
typedef unsigned u32x2 __attribute__((ext_vector_type(2)));

constexpr int TP = 16384, TS = 1024, MTOK = TP + TS;
constexpr int DM = 1024, NPAST = 1024, KVS = 1056;
constexpr int KVROWS = TP + 32 * KVS;
constexpr int KVPAD = KVROWS + 64;
constexpr float EPSN = 1e-5f;
constexpr float ALPHA = 1.189207115002721f;
constexpr float LOG2E = 1.4426950408889634f;
constexpr float QSCALE = 0.07216878364870322f * LOG2E;
constexpr float XSCALE = 0.0625f * LOG2E;

constexpr size_t O_Y = 0, O_CKVP = 17825792, O_KPEP = 22020096, O_SREP = 23068672, O_SIMP = 23070720, O_MKP = 23072768,
                 O_MVP = 23334912, O_CKVS = 23597056, O_KPES = 23859200, O_SRES = 23924736, O_SIMS = 23990272;

constexpr size_t MiB = 1u << 20;
constexpr size_t al256(size_t x) { return (x + 255) & ~(size_t)255; }
constexpr size_t W_WIN = 0;
constexpr size_t W_WQ = W_WIN + al256(1280 * 1024 * 2);
constexpr size_t W_WK = W_WQ + al256(768 * 384 * 2);
constexpr size_t W_WV = W_WK + al256(512 * 256 * 2);
constexpr size_t W_WGLU = W_WV + al256(512 * 256 * 2);
constexpr size_t W_WO = W_WGLU + al256(1024 * 512 * 2);
constexpr size_t W_WXQ = W_WO + 2 * MiB;
constexpr size_t W_WXK = W_WXQ + 2 * MiB;
constexpr size_t W_WXV = W_WXK + 2 * MiB;
constexpr size_t W_WXO = W_WXV + 2 * MiB;
constexpr size_t W_WFF1 = W_WXO + 2 * MiB;
constexpr size_t W_WFF2 = W_WFF1 + 8 * MiB;
constexpr size_t W_CSXQ = W_WFF2 + 8 * MiB;
constexpr size_t W_BWXQ = W_CSXQ + 4096;
constexpr size_t W_CSFF1 = W_BWXQ + 4096;
constexpr size_t W_BWFF1 = W_CSFF1 + 16384;
constexpr size_t W_LAM = W_BWFF1 + 16384;
constexpr size_t W_LAM64 = W_LAM + 16384;
constexpr size_t W_BB = W_LAM64 + 16384;
constexpr size_t W_MEMB = W_BB + 2 * 32 * 64 * 16 * 4;
constexpr size_t W_XK0 = W_MEMB + 256 * 1024 * 2;
constexpr size_t W_XVT0 = W_XK0 + 256 * 1024 * 2;
constexpr size_t W_STSSM = W_XVT0 + 256 * 1024 * 2;
constexpr size_t W_STMLA = W_STSSM + al256(16 * MTOK * 4);
constexpr size_t W_ST1 = W_STMLA + al256(4 * MTOK * 4);
constexpr size_t W_ST2 = W_ST1 + al256(32 * MTOK * 4);
constexpr size_t W_SEND = W_ST2 + al256(32 * MTOK * 4);
constexpr size_t W_BAR = W_SEND + 256 * 2 * 2048 * 4;
constexpr size_t BAR_BYTES = 16384;
constexpr size_t W_ACT = (W_BAR + BAR_BYTES + MiB - 1) / MiB * MiB;
constexpr size_t A_KN = W_ACT, A_VT = W_ACT + 50 * MiB, A_Q = W_ACT + 100 * MiB, A_KPE = W_ACT + 126 * MiB, A_CKV = W_ACT + 133 * MiB,
                 A_CQN = W_ACT + 158 * MiB, A_MIX = W_ACT + 171 * MiB, A_PQ = W_ACT, A_XB = W_ACT + 51 * MiB, A_R1B = W_ACT,
                 A_XQ = W_ACT + 34 * MiB, A_XKS = W_ACT + 68 * MiB, A_XVTS = W_ACT + 84 * MiB, A_XO = W_ACT + 101 * MiB,
                 A_R2B = W_ACT + 140 * MiB, A_Z = W_ACT, WS_END = W_ACT + 205 * MiB;
static_assert(WS_END <= 256 * MiB, "workspace");
static_assert((size_t)KVPAD * 512 * 2 <= 50 * MiB && (size_t)MTOK * 768 * 2 <= 26 * MiB && (size_t)KVPAD * 64 * 2 <= 7 * MiB && (size_t)KVPAD * 256 * 2 <= 25 * MiB &&
              (size_t)MTOK * 384 * 2 <= 13 * MiB && (size_t)MTOK * 1024 * 2 <= 34 * MiB && (size_t)MTOK * 768 * 4 <= 51 * MiB && (size_t)MTOK * 4096 * 2 <= 136 * MiB, "regions");

constexpr int LDS_BYTES = 141312 + 64;

__constant__ double c_invrev[32] = {0.15915494309189535,0.11934937021124886,0.089499401608891013,0.067115083005227255,0.050329212104487035,0.037741584717419771,0.028302195830623399,0.02122365276477766,0.015915494309189534,0.011934937021124886,0.0089499401608891024,0.0067115083005227253,0.0050329212104487037,0.0037741584717419772,0.0028302195830623399,0.0021223652764777662,0.0015915494309189536,0.0011934937021124885,0.00089499401608891024,0.0006711508300522726,0.00050329212104487033,0.00037741584717419774,0.00028302195830623395,0.00021223652764777661,0.00015915494309189535,0.00011934937021124886,8.9499401608891018e-05,6.7115083005227254e-05,5.0329212104487035e-05,3.7741584717419777e-05,2.8302195830623396e-05,2.1223652764777659e-05};

__device__ __forceinline__ unsigned cvt_pk_bf16(float lo, float hi) { unsigned r; asm volatile("v_cvt_pk_bf16_f32 %0, %1, %2" : "=v"(r) : "v"(lo), "v"(hi)); return r; }
__device__ __forceinline__ u32x2 pack4(f32x4 v) { u32x2 w; w.x = cvt_pk_bf16(v[0], v[1]); w.y = cvt_pk_bf16(v[2], v[3]); return w; }
__device__ __forceinline__ float bf16_round(float x) { return __uint_as_float(cvt_pk_bf16(x, 0.f) << 16); }
__device__ __forceinline__ void rope_cs(int pos, int i, float& c, float& s) {
    double rev = (double)pos * c_invrev[i]; rev -= __builtin_floor(rev); const float r = (float)rev;
    s = __builtin_amdgcn_sinf(r); c = __builtin_amdgcn_cosf(r);
}
__device__ __forceinline__ int tok_pos(int row) { return row < TP ? row : NPAST + ((row - TP) & 31); }
__device__ __forceinline__ int swap23(int r) { return (r & ~12) | ((r & 4) << 1) | ((r & 8) >> 1); }
__device__ __forceinline__ int tok_kvrow(int row) { return row < TP ? row : TP + ((row - TP) >> 5) * KVS + NPAST + ((row - TP) & 31); }

struct Args { const float* in[34]; float* out; unsigned char* ws; int ph_lo, ph_hi; };
struct Frame {
    const Args* a; float* out; unsigned char* ws; LAS unsigned char* lds;
    int tid, lane, wid, G, bid;
};

namespace pg8 {
constexpr int BM = 256, BK = 64, HALF = 128, HTB = HALF * BK * 2, STAGE_BYTES = 8 * HTB, NXCD = 8, WGM = 8;
__host__ __device__ __forceinline__ int lds_byte(int r, int c) { const int st = (r >> 4) * 2 + (c >> 5), rr = r & 15, cc = c & 31, ob = rr * 64 + cc * 2; return st * 1024 + (ob ^ (((ob >> 9) & 1) << 5)); }
__host__ __device__ __forceinline__ void stage_rc(int b, int& R, int& C) { const int st = b / 1024, sb = b % 1024, swz = sb ^ (((sb >> 9) & 1) << 5); R = (st >> 1) * 16 + swz / 64; C = (st & 1) * 32 + (swz % 64) / 2; }
__host__ __device__ __forceinline__ int perm32(int rho) { const int n = rho >> 4, i = rho & 15; return 8 * (i >> 2) + 4 * n + (i & 3); }
struct Unit { int pm, pn, idx, ko; };
struct Gemm { const bf16_t* A; const bf16_t* Bt; int M, N, K, LD; };
struct StaticOrder {
    int nM, nN, nwg, G, c;
    __device__ __forceinline__ void init(int M, int N, int G_, int c_, int rot) { nM = M / BM; nN = N / BM; nwg = nM * nN; G = G_; c = (c_ + rot) % G_; }
    __device__ __forceinline__ bool next(int i, Unit& u) const {
        const long L = (long)i * G + c; if (L >= nwg) return false;
        int wgid = (int)L; { const int q = nwg / NXCD, r = nwg % NXCD, xcd = wgid % NXCD, off = wgid / NXCD; wgid = (xcd < r ? xcd * (q + 1) : r * (q + 1) + (xcd - r) * q) + off; }
        const int nig = WGM * nN, gid = wgid / nig, fm = gid * WGM, gsz = (nM - fm) < WGM ? (nM - fm) : WGM;
        u.pm = fm + ((wgid % nig) % gsz); u.pn = (wgid % nig) / gsz; u.idx = i; u.ko = 0; return true;
    }
    __device__ __forceinline__ void a_ready(const Unit&) const {}
    __device__ __forceinline__ void done(const Unit&) const {}
};
struct OneUnitOrder {
    int pm, pn;
    __device__ __forceinline__ bool next(int i, Unit& u) const { if (i > 0) return false; u.pm = pm; u.pn = pn; u.idx = 0; u.ko = 0; return true; }
    __device__ __forceinline__ void a_ready(const Unit&) const {}
    __device__ __forceinline__ void done(const Unit&) const {}
};
struct SplitKOrder {
    int nt, nN, ns, ks, G, c;
    __device__ __forceinline__ bool next(int i, Unit& u) const { const int L = i * G + c; if (L >= nt * ns) return false; const int t = L % nt, s = L / nt; u.pm = t / nN; u.pn = t % nN; u.idx = i; u.ko = s * ks; return true; }
    __device__ __forceinline__ void a_ready(const Unit&) const {}
    __device__ __forceinline__ void done(const Unit&) const {}
};
template <class Epi, class Sched, bool ALIGN_EPI = false, bool SP2 = false>
__device__ __forceinline__ void gemm_phase(PG8_LAS unsigned char* lds, const Gemm g, const Sched& S, const Epi& E) {
    const int tid = threadIdx.x, wid = __builtin_amdgcn_readfirstlane(tid >> 6), lane = tid & 63, wr = wid >> 2, wc = wid & 3, fr = lane & 15, fq = lane >> 4;
    int K_ = g.K; asm volatile("" : "+s"(K_)); const int K = K_, nt = K / BK, LD = g.LD ? g.LD : K;
    unsigned voffA[2], voffB[2];
#pragma unroll
    for (int i = 0; i < 2; ++i) { int R, C; stage_rc(tid * 16 + i * 8192, R, C); const int Rb = Epi::PERM ? ((R & ~31) + perm32(R & 31)) : R;
        voffA[i] = (unsigned)(R * LD + C) * 2u; voffB[i] = (unsigned)(Rb * LD + C) * 2u; }
    const size_t kstep = (size_t)(BK * 2);
    const size_t hstep = (size_t)HALF * LD * 2;
    const size_t tstep = 2 * hstep;
    const unsigned ldsw = (unsigned)wid * 1024u;
    const int aoff = lds_byte(wr * 64 + fr, fq * 8), boff = lds_byte(wc * 32 + fr, fq * 8);
#define PG8_SA(b, h) (((b) * 2 + (h)) * HTB)
#define PG8_SB(b, h) ((4 + (b) * 2 + (h)) * HTB)
#define PG8_STAGE(bufoff, gbase, voff) do { _Pragma("unroll") for (int _i = 0; _i < 2; ++_i) \
        __builtin_amdgcn_global_load_lds((const unsigned*)((const char*)(gbase) + (voff)[_i]), (PG8_LAS unsigned*)(lds + (bufoff) + ldsw + _i * 8192), 16, 0, 0); } while (0)
#define PG8_LDA(dst, b, h) do { _Pragma("unroll") for (int m = 0; m < 4; ++m) _Pragma("unroll") for (int k = 0; k < 2; ++k) dst[m][k] = *(const PG8_LAS bf16x8*)(lds + PG8_SA(b, h) + aoff + m * 2048 + k * 1024); } while (0)
#define PG8_LDB(dst, b, h) do { _Pragma("unroll") for (int n = 0; n < 2; ++n) _Pragma("unroll") for (int k = 0; k < 2; ++k) dst[n][k] = *(const PG8_LAS bf16x8*)(lds + PG8_SB(b, h) + boff + n * 2048 + k * 1024); } while (0)
#define PG8_MMA(ai, bj, At, Bt) do { __builtin_amdgcn_s_setprio(1); _Pragma("unroll") for (int m = 0; m < 4; ++m) _Pragma("unroll") for (int n = 0; n < 2; ++n) _Pragma("unroll") for (int k = 0; k < 2; ++k) \
        acc[ai][bj][m][n] = __builtin_amdgcn_mfma_f32_16x16x32_bf16(Bt[n][k], At[m][k], acc[ai][bj][m][n], 0, 0, 0); __builtin_amdgcn_s_setprio(0); } while (0)
#define PG8_WAIT_V(n) asm volatile("s_waitcnt vmcnt(" #n ")" ::: "memory")
#define PG8_WAIT_L(n) asm volatile("s_waitcnt lgkmcnt(" #n ")" ::: "memory")
#define PG8_BAR __builtin_amdgcn_s_barrier()
#define PG8_SCHED __builtin_amdgcn_sched_barrier(0)
    Unit cur, nxt; int ui = 0;
    if (!S.next(0, cur)) return;
    f32x4 acc[2][2][4][2];
#pragma unroll
    for (int a = 0; a < 2; ++a)
#pragma unroll
        for (int b = 0; b < 2; ++b)
#pragma unroll
            for (int m = 0; m < 4; ++m)
#pragma unroll
                for (int n = 0; n < 2; ++n) acc[a][b][m][n] = (f32x4){0.f, 0.f, 0.f, 0.f};
    bf16x8 At[4][2], B0[2][2], B1[2][2];
    const char* cA = (const char*)g.A + (size_t)cur.pm * tstep + (size_t)cur.ko * 2; const char* cB = (const char*)g.Bt + (size_t)cur.pn * tstep + (size_t)cur.ko * 2;
    S.a_ready(cur);
    if constexpr (SP2) {
        PG8_STAGE(PG8_SB(0, 0), cB, voffB); PG8_STAGE(PG8_SB(0, 1), cB + hstep, voffB); PG8_STAGE(PG8_SA(0, 0), cA, voffA); PG8_STAGE(PG8_SA(0, 1), cA + hstep, voffA);
        if (wr == 1) PG8_BAR;
        PG8_WAIT_V(2); PG8_BAR;
        PG8_STAGE(PG8_SB(1, 0), cB + kstep, voffB); PG8_STAGE(PG8_SA(1, 0), cA + kstep, voffA); PG8_STAGE(PG8_SB(1, 1), cB + hstep + kstep, voffB);
        PG8_WAIT_V(6); PG8_BAR;
    } else {
        PG8_STAGE(PG8_SB(0, 0), cB, voffB); PG8_STAGE(PG8_SA(0, 0), cA, voffA); PG8_STAGE(PG8_SB(0, 1), cB + hstep, voffB); PG8_STAGE(PG8_SA(0, 1), cA + hstep, voffA);
        if (wr == 1) PG8_BAR;
        PG8_WAIT_V(4); PG8_BAR;
        PG8_STAGE(PG8_SB(1, 0), cB + kstep, voffB); PG8_STAGE(PG8_SA(1, 0), cA + kstep, voffA); PG8_STAGE(PG8_SB(1, 1), cB + hstep + kstep, voffB);
        PG8_WAIT_V(6); PG8_BAR;
    }
    for (;;) {
        const bool has_next = S.next(ui + 1, nxt);
        const char* nA = has_next ? (const char*)g.A + (size_t)nxt.pm * tstep + (size_t)nxt.ko * 2 : cA; const char* nB = has_next ? (const char*)g.Bt + (size_t)nxt.pn * tstep + (size_t)nxt.ko * 2 : cB;
        for (int t = 0; t < nt; t += 2) {
            const bool last = (t == nt - 2);
            if constexpr (Epi::MIDK) { if (t == (nt >> 1)) E.mid(acc, cur, wr, fr); }
            const char* a1 = cA + (size_t)(t + 1) * kstep;
            const char* a2 = last ? nA : cA + (size_t)(t + 2) * kstep; const char* b2 = last ? nB : cB + (size_t)(t + 2) * kstep;
            const char* a3 = a2 + kstep; const char* b3 = b2 + kstep;
            if (last && has_next) S.a_ready(nxt);
            if constexpr (SP2) {
            PG8_LDB(B0, 0, 0); PG8_LDB(B1, 0, 1); PG8_SCHED; PG8_LDA(At, 0, 0); PG8_STAGE(PG8_SA(1, 1), a1 + hstep, voffA);
            PG8_WAIT_V(8); PG8_WAIT_L(0); PG8_BAR; PG8_MMA(0, 0, At, B0); PG8_MMA(0, 1, At, B1); PG8_BAR; PG8_SCHED;
            PG8_LDA(At, 0, 1); PG8_STAGE(PG8_SB(0, 0), b2, voffB); PG8_STAGE(PG8_SB(0, 1), b2 + hstep, voffB); PG8_STAGE(PG8_SA(0, 0), a2, voffA);
            PG8_WAIT_V(8); PG8_WAIT_L(0); PG8_BAR; PG8_MMA(1, 0, At, B0); PG8_MMA(1, 1, At, B1); PG8_BAR; PG8_SCHED;
            PG8_LDB(B0, 1, 0); PG8_LDB(B1, 1, 1); PG8_SCHED; PG8_LDA(At, 1, 0); PG8_STAGE(PG8_SA(0, 1), a2 + hstep, voffA);
            PG8_WAIT_V(8); PG8_WAIT_L(0); PG8_BAR; PG8_MMA(0, 0, At, B0); PG8_MMA(0, 1, At, B1); PG8_BAR; PG8_SCHED;
            PG8_LDA(At, 1, 1); PG8_STAGE(PG8_SB(1, 0), b3, voffB); PG8_STAGE(PG8_SB(1, 1), b3 + hstep, voffB); PG8_STAGE(PG8_SA(1, 0), a3, voffA);
            PG8_WAIT_V(8); PG8_WAIT_L(0); PG8_BAR; PG8_MMA(1, 0, At, B0); PG8_MMA(1, 1, At, B1); PG8_BAR; PG8_SCHED;
            } else {
            PG8_LDB(B0, 0, 0); PG8_SCHED; PG8_LDA(At, 0, 0); PG8_STAGE(PG8_SA(1, 1), a1 + hstep, voffA);
            PG8_WAIT_L(8); PG8_BAR; PG8_WAIT_L(0); PG8_MMA(0, 0, At, B0); PG8_BAR; PG8_SCHED;
            PG8_LDB(B1, 0, 1); PG8_STAGE(PG8_SB(0, 0), b2, voffB);
            PG8_BAR; PG8_WAIT_L(0); PG8_MMA(0, 1, At, B1); PG8_BAR;
            PG8_LDA(At, 0, 1); PG8_STAGE(PG8_SA(0, 0), a2, voffA);
            PG8_BAR; PG8_WAIT_L(0); PG8_MMA(1, 0, At, B0); PG8_BAR; PG8_SCHED;
            PG8_STAGE(PG8_SB(0, 1), b2 + hstep, voffB);
            PG8_WAIT_V(6); PG8_BAR; PG8_MMA(1, 1, At, B1); PG8_BAR;
            PG8_LDB(B0, 1, 0); PG8_SCHED; PG8_LDA(At, 1, 0); PG8_STAGE(PG8_SA(0, 1), a2 + hstep, voffA);
            PG8_WAIT_L(8); PG8_BAR; PG8_WAIT_L(0); PG8_MMA(0, 0, At, B0); PG8_BAR; PG8_SCHED;
            PG8_LDB(B1, 1, 1); PG8_STAGE(PG8_SB(1, 0), b3, voffB);
            PG8_BAR; PG8_WAIT_L(0); PG8_MMA(0, 1, At, B1); PG8_BAR;
            PG8_LDA(At, 1, 1); PG8_STAGE(PG8_SA(1, 0), a3, voffA);
            PG8_BAR; PG8_WAIT_L(0); PG8_MMA(1, 0, At, B0); PG8_BAR; PG8_SCHED;
            PG8_STAGE(PG8_SB(1, 1), b3 + hstep, voffB);
            PG8_WAIT_V(6); PG8_BAR; PG8_MMA(1, 1, At, B1); PG8_BAR;
            }
        }
        if constexpr (ALIGN_EPI) { if (wr == 0) PG8_BAR; }
        if constexpr (!Epi::AFTER_DRAIN) { E(acc, cur, wr, wc, fr, fq); S.done(cur); }
        if (!has_next) break;
#pragma unroll
        for (int a = 0; a < 2; ++a)
#pragma unroll
            for (int b = 0; b < 2; ++b)
#pragma unroll
                for (int m = 0; m < 4; ++m)
#pragma unroll
                    for (int n = 0; n < 2; ++n) acc[a][b][m][n] = (f32x4){0.f, 0.f, 0.f, 0.f};
        cur = nxt; cA = nA; cB = nB; ++ui;
        if constexpr (ALIGN_EPI) { if (wr == 1) PG8_BAR; }
    }
    PG8_WAIT_V(0);
    if constexpr (!ALIGN_EPI) { if (wr == 0) PG8_BAR; }
    PG8_BAR;
    if constexpr (Epi::AFTER_DRAIN) { E.fused(acc, cur, wr, wc, fr, fq, lds, wid, lane); S.done(cur); }
#undef PG8_SA
#undef PG8_SB
#undef PG8_STAGE
#undef PG8_LDA
#undef PG8_LDB
#undef PG8_MMA
#undef PG8_WAIT_V
#undef PG8_WAIT_L
#undef PG8_BAR
#undef PG8_SCHED
}
}
using pg8::Unit;
typedef f32x4 Acc[2][2][4][2];
#define EPI_ROWS _Pragma("unroll") for (int ai = 0; ai < 2; ++ai) _Pragma("unroll") for (int m = 0; m < 4; ++m)
#define EPI_COLS _Pragma("unroll") for (int bj = 0; bj < 2; ++bj) _Pragma("unroll") for (int n = 0; n < 2; ++n)

struct EpiProj {
    static constexpr bool PERM = false, AFTER_DRAIN = false, MIDK = false;
    float* U; float* PQ;
    __device__ __forceinline__ void operator()(const Acc& acc, const Unit& u, int wr, int wc, int fr, int fq) const {
        const bool isu = u.pn < 2; float* base = isu ? U : PQ; const int ld = isu ? 512 : 768; const int c0 = (isu ? u.pn : u.pn - 2) * 256 + wc * 32 + 4 * fq;
        EPI_ROWS { const int row = u.pm * 256 + ai * 128 + wr * 64 + m * 16 + fr; float* rp = base + (size_t)row * ld + c0;
            EPI_COLS *(f32x4*)(rp + bj * 128 + n * 16) = acc[ai][bj][m][n]; }
    }
};
struct EpiSlab {
    static constexpr bool PERM = false, AFTER_DRAIN = false, MIDK = false;
    float* S;
    __device__ __forceinline__ void operator()(const Acc& acc, const Unit& u, int wr, int wc, int fr, int fq) const {
        float* base = S + (size_t)(u.ko >> 9) * 1024 * 1024 + u.pn * 256 + wc * 32 + 4 * fq;
        EPI_ROWS { const int row = u.pm * 256 + ai * 128 + wr * 64 + m * 16 + fr;
            EPI_COLS *(f32x4*)(base + (size_t)row * 1024 + bj * 128 + n * 16) = acc[ai][bj][m][n]; }
    }
};
template <bool VT> struct EpiStore {
    static constexpr bool PERM = !VT, AFTER_DRAIN = false, MIDK = false;
    bf16_t* O; int ldc; float* F32; int ldf; float* F32T; int ldt; int rowswap;
    __device__ __forceinline__ void operator()(const Acc& acc, const Unit& u, int wr, int wc, int fr, int fq) const {
        if constexpr (VT) { const int sw = ((fq & 1) << 1) | (fq >> 1);
            EPI_ROWS { const int row = u.pm * 256 + ai * 128 + wr * 64 + m * 16 + fr;
                EPI_COLS { const int cb = u.pn * 256 + bj * 128 + wc * 32 + n * 16; const f32x4 v = acc[ai][bj][m][n];
                    *(u32x2*)(O + (size_t)row * ldc + cb + 4 * sw) = pack4(v);
                    if (F32) *(f32x4*)(F32 + (size_t)row * ldf + cb + 4 * fq) = v;
                    if (F32T) { _Pragma("unroll") for (int j = 0; j < 4; ++j) F32T[(size_t)(cb + 4 * fq + j) * ldt + row] = v[j]; } } }
        } else {
            EPI_ROWS { const int row = u.pm * 256 + ai * 128 + wr * 64 + m * 16 + fr;
                _Pragma("unroll") for (int bj = 0; bj < 2; ++bj) { const int cb = u.pn * 256 + bj * 128 + wc * 32 + 8 * fq; const f32x4 v0 = acc[ai][bj][m][0], v1 = acc[ai][bj][m][1];
                    const u32x2 h0 = pack4(v0), h1 = pack4(v1); u32x4 w; w.x = h0.x; w.y = h0.y; w.z = h1.x; w.w = h1.y;
                    *(u32x4*)(O + (size_t)(rowswap ? swap23(row) : row) * ldc + cb) = w;
                    if (F32) { *(f32x4*)(F32 + (size_t)row * ldf + cb) = v0; *(f32x4*)(F32 + (size_t)row * ldf + cb + 4) = v1; }
                    if (F32T) { _Pragma("unroll") for (int j = 0; j < 4; ++j) { F32T[(size_t)(cb + j) * ldt + row] = v0[j]; F32T[(size_t)(cb + 4 + j) * ldt + row] = v1[j]; } } } }
        }
    }
};
struct EpiQ {
    static constexpr bool PERM = false, AFTER_DRAIN = false, MIDK = false;
    bf16_t* Q;
    __device__ __forceinline__ void operator()(const Acc& acc, const Unit& u, int wr, int wc, int fr, int fq) const {
        EPI_ROWS { const int row = u.pm * 256 + ai * 128 + wr * 64 + m * 16 + fr; bf16_t* qp = Q + (size_t)row * 768;
            if (u.pn < 2) { EPI_COLS { const int h = 2 * u.pn + bj, d = wc * 32 + n * 16 + 4 * fq; *(u32x2*)(qp + h * 192 + d) = pack4(acc[ai][bj][m][n] * QSCALE); } }
            else { const int pos = tok_pos(row);
                _Pragma("unroll") for (int n = 0; n < 2; ++n) { f32x4 o1, o2;
                    _Pragma("unroll") for (int j = 0; j < 4; ++j) { float c, s; rope_cs(pos, n * 16 + 4 * fq + j, c, s); const float x1 = acc[ai][0][m][n][j], x2 = acc[ai][1][m][n][j];
                        o1[j] = (x1 * c - x2 * s) * QSCALE; o2[j] = (x2 * c + x1 * s) * QSCALE; }
                    *(u32x2*)(qp + wc * 192 + 128 + n * 16 + 4 * fq) = pack4(o1); *(u32x2*)(qp + wc * 192 + 160 + n * 16 + 4 * fq) = pack4(o2); } }
        }
    }
};
struct EpiGlu {
    static constexpr bool PERM = true, AFTER_DRAIN = false, MIDK = false;
    bf16_t* MIX; float* ST;
    __device__ __forceinline__ void operator()(const Acc& acc, const Unit& u, int wr, int wc, int fr, int fq) const {
        EPI_ROWS { const int row = u.pm * 256 + ai * 128 + wr * 64 + m * 16 + fr; float q = 0.f; u32x2 h[2];
            _Pragma("unroll") for (int n = 0; n < 2; ++n) { const f32x4 v = acc[ai][0][m][n], g = acc[ai][1][m][n]; f32x4 o;
                _Pragma("unroll") for (int j = 0; j < 4; ++j) { o[j] = v[j] * __builtin_amdgcn_rcpf(1.f + __builtin_amdgcn_exp2f(-g[j] * LOG2E)); q += o[j] * o[j]; }
                h[n] = pack4(o); }
            u32x4 w; w.x = h[0].x; w.y = h[0].y; w.z = h[1].x; w.w = h[1].y;
            *(u32x4*)(MIX + (size_t)row * 1024 + u.pn * 128 + wc * 32 + 8 * fq) = w;
            q += __shfl_xor(q, 16); q += __shfl_xor(q, 32);
            if (fq == 0) ST[(size_t)(u.pn * 4 + wc) * MTOK + row] = q; }
    }
};
__device__ __forceinline__ void ln_stats16(const float* PS, const float* PQ, int row, float& mu, float& rstd) {
    float s = 0.f, q = 0.f;
#pragma unroll
    for (int i = 0; i < 16; ++i) { s += PS[(size_t)i * MTOK + row]; q += PQ[(size_t)i * MTOK + row]; }
    mu = s * (1.f / 1024.f); const float var = q * (1.f / 1024.f) - mu * mu; rstd = rsqrtf(var + EPSN);
}
template <int MODE> struct EpiRes {
    static constexpr bool PERM = true, AFTER_DRAIN = false, MIDK = (MODE == 0);
    const float* xp; const float* xs; float* R; bf16_t* Rb; const float* PSin; const float* PQin; const float* g; const float* b; float* PSout; float* PQout; const LAS float* tab;
    __device__ __forceinline__ void mid(Acc& acc, const Unit& u, int wr, int fr) const {
        EPI_ROWS { const float ratio = tab[(u.idx & 1) * 512 + ai * 128 + wr * 64 + m * 16 + fr];
            EPI_COLS acc[ai][bj][m][n] *= ratio; }
    }
    __device__ __forceinline__ void operator()(const Acc& acc, const Unit& u, int wr, int wc, int fr, int fq) const {
        const int c0 = u.pn * 256 + wc * 32 + 8 * fq;
        EPI_ROWS { const int row = u.pm * 256 + ai * 128 + wr * 64 + m * 16 + fr; float rowscale = 1.f, mu = 0.f, rstd = 1.f;
            if (MODE == 0) rowscale = tab[(u.idx & 1) * 512 + 256 + ai * 128 + wr * 64 + m * 16 + fr]; else { mu = tab[u.idx * 512 + ai * 128 + wr * 64 + m * 16 + fr]; rstd = tab[u.idx * 512 + 256 + ai * 128 + wr * 64 + m * 16 + fr]; }
            const float* rsrc = MODE == 0 ? (row < TP ? xp + (size_t)row * 1024 : xs + (size_t)(row - TP) * 1024) : R + (size_t)row * 1024;
            float s = 0.f, q = 0.f;
            EPI_COLS { const int col = c0 + bj * 128 + n * 4; f32x4 res = *(const f32x4*)(rsrc + col);
                if (MODE == 1) { const f32x4 g4 = *(const f32x4*)(g + col), b4 = *(const f32x4*)(b + col); res = (res - mu) * rstd * g4 + b4; }
                const f32x4 v = res * ALPHA + acc[ai][bj][m][n] * rowscale;
                s += (v[0] + v[1]) + (v[2] + v[3]); q += (v[0] * v[0] + v[1] * v[1]) + (v[2] * v[2] + v[3] * v[3]);
                *(f32x4*)(R + (size_t)row * 1024 + col) = v;
                if (Rb) *(u32x2*)(Rb + (size_t)row * 1024 + col) = pack4(v); }
            s += __shfl_xor(s, 16); s += __shfl_xor(s, 32); q += __shfl_xor(q, 16); q += __shfl_xor(q, 32);
            if (fq == 0) { PSout[(size_t)(u.pn * 4 + wc) * MTOK + row] = s; PQout[(size_t)(u.pn * 4 + wc) * MTOK + row] = q; } }
    }
};
template <int ACT> struct EpiLnAct {
    static constexpr bool PERM = true, AFTER_DRAIN = false, MIDK = false;
    const LAS float* tab; const float* cs; const float* bw; bf16_t* O; int ldc;
    __device__ __forceinline__ void operator()(const Acc& acc, const Unit& u, int wr, int wc, int fr, int fq) const {
        const int c0 = u.pn * 256 + wc * 32 + 8 * fq; f32x4 cs4[2][2], bw4[2][2];
        EPI_COLS { cs4[bj][n] = *(const f32x4*)(cs + c0 + bj * 128 + n * 4); bw4[bj][n] = *(const f32x4*)(bw + c0 + bj * 128 + n * 4); }
        EPI_ROWS { const int row = u.pm * 256 + ai * 128 + wr * 64 + m * 16 + fr; const float mu = tab[u.idx * 512 + ai * 128 + wr * 64 + m * 16 + fr], rstd = tab[u.idx * 512 + 256 + ai * 128 + wr * 64 + m * 16 + fr];
            _Pragma("unroll") for (int bj = 0; bj < 2; ++bj) { u32x2 h[2];
                _Pragma("unroll") for (int n = 0; n < 2; ++n) { f32x4 v = (acc[ai][bj][m][n] - cs4[bj][n] * mu) * rstd + bw4[bj][n];
                    if (ACT == 0) v = v * XSCALE; else { _Pragma("unroll") for (int j = 0; j < 4; ++j) { const float r = fmaxf(v[j], 0.f); v[j] = r * r; } }
                    h[n] = pack4(v); }
                u32x4 w; w.x = h[0].x; w.y = h[0].y; w.z = h[1].x; w.w = h[1].y;
                *(u32x4*)(O + (size_t)row * ldc + c0 + bj * 128) = w; } }
    }
};

__device__ __forceinline__ void wo_fill_tab(const Unit& u, const float* STssm, const float* STmla, LAS float* tab) {
    const int t = threadIdx.x;
    if (t < 256) { const int row = u.pm * 256 + t; float s1 = 0.f, s2 = 0.f;
#pragma unroll
        for (int i = 0; i < 16; ++i) s1 += STssm[(size_t)i * MTOK + row];
#pragma unroll
        for (int i = 0; i < 4; ++i) s2 += STmla[(size_t)i * MTOK + row];
        const float r1 = rsqrtf(s1 * (1.f / 512.f) + EPSN), r2 = rsqrtf(s2 * (1.f / 512.f) + EPSN);
        tab[(u.idx & 1) * 512 + t] = r1 / r2; tab[(u.idx & 1) * 512 + 256 + t] = r2; }
}

__device__ __forceinline__ void ln_fill_tab(const pg8::StaticOrder& S, const float* PS, const float* PQ, LAS float* tab) {
    const int t = threadIdx.x; Unit u;
    if (t < 256) {
#pragma unroll 1
        for (int i = 0; i < 5; ++i) if (S.next(i, u)) { float mu, rstd; ln_stats16(PS, PQ, u.pm * 256 + t, mu, rstd); tab[i * 512 + t] = mu; tab[i * 512 + 256 + t] = rstd; } }
    __syncthreads();
}

template <int DQK, int DKN, int DV, bool SPLITDV>
__device__ __forceinline__ void attn_unit(LAS unsigned char* lds, const bf16_t* Qp, int ldq, const bf16_t* Kn, int ldkn, const bf16_t* Kpe, const bf16_t* Vt, int ldvt,
                                          int ntiles, int kvlim, bf16_t* Op, int ldo, float* statp, int nrows) {
    constexpr int NS = DQK / 16, KROWB = DQK * 2 + 16, VROWB = 144, KTILE = 64 * KROWB, VTILE = DV * VROWB, STAGE = KTILE + VTILE;
    constexpr int CPR = DQK / 8, KCH = 64 * CPR / 512, VCH = DV * 8 / 512, NKH = SPLITDV ? 2 : 1, NDB = 4;
    static_assert((SPLITDV ? DV / 64 : DV / 32) == NDB, "value tiling");
    int tid_ = threadIdx.x; asm volatile("" : "+v"(tid_));
    const int tid = tid_, wid = __builtin_amdgcn_readfirstlane(tid >> 6), lane = tid & 63, r32 = lane & 31, hi = lane >> 5, rg = wid & 3, grp = wid >> 2;
    const int keyoff = SPLITDV ? 0 : 32 * grp, dbase = SPLITDV ? grp * (DV / 2) : 0;
    const bool wact = kvlim > 0;
    bf16x8 qf[NS];
    { const bf16_t* qrow = Qp + (size_t)(rg * 32 + r32) * ldq + hi * 8;
#pragma unroll
      for (int s = 0; s < NS; ++s) qf[s] = wact ? *(const bf16x8*)(qrow + 16 * s) : (bf16x8){0, 0, 0, 0, 0, 0, 0, 0}; }
    constexpr bool KREG = (CPR == 32) && (DKN == DQK);
    const bf16_t* kp[KREG ? 1 : KCH]; int kst[KREG ? 1 : KCH], kld[KREG ? 1 : KCH];
    if constexpr (KREG) { const int row = tid >> 5, cc = tid & 31; kp[0] = Kn + (size_t)row * ldkn + cc * 8; kst[0] = 64 * ldkn; kld[0] = row * KROWB + cc * 16; }
    else {
#pragma unroll
        for (int i = 0; i < KCH; ++i) { const int c = tid + 512 * i, row = c / CPR, cc = c - row * CPR;
            if (cc < DKN / 8) { kp[i] = Kn + (size_t)row * ldkn + cc * 8; kst[i] = 64 * ldkn; } else { kp[i] = Kpe + (size_t)row * 64 + (cc - DKN / 8) * 8; kst[i] = 64 * 64; }
            kld[i] = row * KROWB + cc * 16; } }
    const bf16_t* vp0 = Vt + (size_t)(tid >> 3) * ldvt + (tid & 7) * 8; const int vld0 = KTILE + (tid >> 3) * VROWB + (tid & 7) * 16;
#define KP(i) (KREG ? kp[0] + (size_t)(i) * 16 * ldkn : kp[KREG ? 0 : (i)])
#define KST(i) kst[KREG ? 0 : (i)]
#define KLD(i) (KREG ? kld[0] + (i) * 16 * KROWB : kld[KREG ? 0 : (i)])
    u32x4 sk[KCH], sv[VCH];
#define AT_ISSUE_K(t) do { _Pragma("unroll") for (int i = 0; i < KCH; ++i) sk[i] = *(const u32x4*)(KP(i) + (size_t)(t) * KST(i)); } while (0)
#define AT_ISSUE_V(t) do { _Pragma("unroll") for (int i = 0; i < VCH; ++i) sv[i] = *(const u32x4*)(vp0 + (size_t)(i) * 64 * ldvt + (size_t)(t) * 64); } while (0)
#define AT_ISSUE(t) do { AT_ISSUE_K(t); AT_ISSUE_V(t); } while (0)
#define AT_WRITE(st) do { _Pragma("unroll") for (int i = 0; i < KCH; ++i) *(LAS u32x4*)(lds + (st) * STAGE + KLD(i)) = sk[i]; \
                          _Pragma("unroll") for (int i = 0; i < VCH; ++i) *(LAS u32x4*)(lds + (st) * STAGE + vld0 + (i) * 64 * VROWB) = sv[i]; } while (0)
    f32x16 o[NDB];
#pragma unroll
    for (int d = 0; d < NDB; ++d)
#pragma unroll
        for (int r = 0; r < 16; ++r) o[d][r] = 0.f;
    float mrun = -1e30f, lrun = 0.f;
    const int kboff = (keyoff + r32) * KROWB + hi * 16, vboff = KTILE + (dbase + r32) * VROWB + keyoff * 2 + hi * 16;
    AT_ISSUE(0); AT_WRITE(0); __syncthreads();
    if (!SPLITDV && ntiles > 1) AT_ISSUE(1);
    for (int t = 0; t < ntiles; ++t) {
        const int st = t & 1;
        if (SPLITDV) { if (t + 1 < ntiles) AT_ISSUE_K(t + 1); }
        else if (grp == 1) { if (t + 1 < ntiles) AT_WRITE(st ^ 1); if (t + 2 < ntiles) AT_ISSUE(t + 2); }
        if (t * 64 + keyoff < kvlim) {
            f32x16 p[NKH];
            const LAS unsigned char* kb = lds + st * STAGE + kboff;
#pragma unroll
            for (int kh = 0; kh < NKH; ++kh) {
#pragma unroll
                for (int r = 0; r < 16; ++r) p[kh][r] = 0.f;
#pragma unroll
                for (int s = 0; s < NS; ++s) { const bf16x8 kf = *(const LAS bf16x8*)(kb + kh * 32 * KROWB + s * 32); p[kh] = __builtin_amdgcn_mfma_f32_32x32x16_bf16(kf, qf[s], p[kh], 0, 0, 0); }
            }
            float tmax = p[0][0];
#pragma unroll
            for (int kh = 0; kh < NKH; ++kh)
#pragma unroll
                for (int r = 0; r < 16; ++r) tmax = fmaxf(tmax, p[kh][r]);
            { auto rr = __builtin_amdgcn_permlane32_swap(__float_as_uint(tmax), __float_as_uint(tmax), false, false); tmax = fmaxf(__uint_as_float(rr[0]), __uint_as_float(rr[1])); }
            const float mnew = fmaxf(mrun, tmax);
            if (__any(mnew > mrun)) { const float alpha = __builtin_amdgcn_exp2f(mrun - mnew); lrun *= alpha; mrun = mnew;
#pragma unroll
                for (int d = 0; d < NDB; ++d)
#pragma unroll
                    for (int r = 0; r < 16; ++r) o[d][r] *= alpha; }
            float ls = 0.f;
#pragma unroll
            for (int kh = 0; kh < NKH; ++kh)
#pragma unroll
                for (int r = 0; r < 16; ++r) { p[kh][r] = __builtin_amdgcn_exp2f(p[kh][r] - mrun); ls += p[kh][r]; }
            lrun += ls;
            bf16x8 pf[NKH * 2];
#pragma unroll
            for (int kh = 0; kh < NKH; ++kh)
#pragma unroll
                for (int s2 = 0; s2 < 2; ++s2) { u32x4 w; w.x = cvt_pk_bf16(p[kh][8 * s2 + 0], p[kh][8 * s2 + 1]); w.y = cvt_pk_bf16(p[kh][8 * s2 + 2], p[kh][8 * s2 + 3]);
                    w.z = cvt_pk_bf16(p[kh][8 * s2 + 4], p[kh][8 * s2 + 5]); w.w = cvt_pk_bf16(p[kh][8 * s2 + 6], p[kh][8 * s2 + 7]); pf[kh * 2 + s2] = *(bf16x8*)&w; }
            if (SPLITDV && t + 1 < ntiles) AT_ISSUE_V(t + 1);
            const LAS unsigned char* vb = lds + st * STAGE + vboff;
#pragma unroll
            for (int d = 0; d < NDB; ++d)
#pragma unroll
                for (int ks = 0; ks < NKH * 2; ++ks) { const bf16x8 vf = *(const LAS bf16x8*)(vb + d * 32 * VROWB + ks * 32); o[d] = __builtin_amdgcn_mfma_f32_32x32x16_bf16(vf, pf[ks], o[d], 0, 0, 0); }
        } else if (SPLITDV && t + 1 < ntiles) AT_ISSUE_V(t + 1);
        if (SPLITDV && t + 1 < ntiles) AT_WRITE(st ^ 1);
        if (!SPLITDV && grp == 0) { if (t + 1 < ntiles) AT_WRITE(st ^ 1); if (t + 2 < ntiles) AT_ISSUE(t + 2); }
        __syncthreads();
    }
#undef AT_ISSUE
#undef AT_ISSUE_K
#undef AT_ISSUE_V
#undef KP
#undef KST
#undef KLD
#undef AT_WRITE
    lrun += __shfl_xor(lrun, 32);
    if (!SPLITDV) {
        LAS float* MO = (LAS float*)lds; LAS float* MM = (LAS float*)(lds + 65536); LAS float* ML = (LAS float*)(lds + 65536 + 1024);
        if (grp == 1) {
#pragma unroll
            for (int d = 0; d < NDB; ++d)
#pragma unroll
                for (int r = 0; r < 16; ++r) MO[(rg * 64 + d * 16 + r) * 64 + lane] = o[d][r];
            MM[rg * 64 + lane] = mrun; ML[rg * 64 + lane] = lrun;
        }
        __syncthreads();
        if (grp == 0) {
            const float m1 = MM[rg * 64 + lane], l1 = ML[rg * 64 + lane], ms = fmaxf(mrun, m1);
            const float a0 = __builtin_amdgcn_exp2f(mrun - ms), a1 = __builtin_amdgcn_exp2f(m1 - ms);
            lrun = lrun * a0 + l1 * a1;
#pragma unroll
            for (int d = 0; d < NDB; ++d)
#pragma unroll
                for (int r = 0; r < 16; ++r) o[d][r] = o[d][r] * a0 + MO[(rg * 64 + d * 16 + r) * 64 + lane] * a1;
        }
    }
    if (SPLITDV || grp == 0) {
        const float inv = __builtin_amdgcn_rcpf(lrun); const int row = rg * 32 + r32; const bool ok = wact && row < nrows; float ss = 0.f;
        bf16_t* orow = Op + (size_t)row * ldo + dbase + 4 * hi;
#pragma unroll
        for (int d = 0; d < NDB; ++d)
#pragma unroll
            for (int g4 = 0; g4 < 4; ++g4) { f32x4 v; v[0] = o[d][4 * g4] * inv; v[1] = o[d][4 * g4 + 1] * inv; v[2] = o[d][4 * g4 + 2] * inv; v[3] = o[d][4 * g4 + 3] * inv;
                ss += (v[0] * v[0] + v[1] * v[1]) + (v[2] * v[2] + v[3] * v[3]);
                if (ok) *(u32x2*)(orow + 32 * d + 8 * g4) = pack4(v); }
        ss += __shfl_xor(ss, 32);
        if (statp && ok && hi == 0) statp[row] = ss;
    }
    __syncthreads();
}


__device__ __forceinline__ float gelu_tanh(float x) { const float z2 = 1.5957691216057308f * (x + 0.044715f * x * x * x); return x * __builtin_amdgcn_rcpf(1.f + __builtin_amdgcn_exp2f(-z2 * LOG2E)); }
struct SsmU { bf16x8 hi, lo; };
__device__ __forceinline__ void split_hilo(f32x4 a, f32x4 b, u32x4& hi, u32x4& lo) {
    hi.x = cvt_pk_bf16(a[0], a[1]); hi.y = cvt_pk_bf16(a[2], a[3]); hi.z = cvt_pk_bf16(b[0], b[1]); hi.w = cvt_pk_bf16(b[2], b[3]);
    lo.x = cvt_pk_bf16(a[0] - __uint_as_float(hi.x << 16), a[1] - __uint_as_float(hi.x & 0xffff0000u)); lo.y = cvt_pk_bf16(a[2] - __uint_as_float(hi.y << 16), a[3] - __uint_as_float(hi.y & 0xffff0000u));
    lo.z = cvt_pk_bf16(b[0] - __uint_as_float(hi.z << 16), b[1] - __uint_as_float(hi.z & 0xffff0000u)); lo.w = cvt_pk_bf16(b[2] - __uint_as_float(hi.w << 16), b[3] - __uint_as_float(hi.w & 0xffff0000u));
}
struct SsmW { float lr, li; bf16x8 ab[8]; };
__device__ __forceinline__ void ssm_load_w(const Frame& F, int g, int lane, SsmW& w) {
    const float* LAM = (const float*)(F.ws + W_LAM); const float* BB = (const float*)(F.ws + W_BB);
    w.lr = LAM[g * 64 + lane]; w.li = LAM[2048 + g * 64 + lane];
    const int q = lane >> 4;
#pragma unroll
    for (int blk = 0; blk < 8; ++blk) { const int row = 16 * blk + (lane & 15);
        const float* bp = (row < 64 ? BB + (size_t)(g * 64 + row) * 16 : BB + 32768 + (size_t)(g * 64 + row - 64) * 16) + 8 * (q & 1);
        u32x4 hi, lo; split_hilo(*(const f32x4*)bp, *(const f32x4*)(bp + 4), hi, lo); const u32x4 sel = q < 2 ? hi : lo; w.ab[blk] = *(const bf16x8*)&sel; }
}
__device__ __forceinline__ void ssm_load_u(const float* U, int tb, int g, int lane, SsmU& ub) {
    const int q = lane >> 4; const float* up = U + (size_t)(tb + (lane & 15)) * 512 + g * 16 + 8 * (q & 1);
    u32x4 hi, lo; split_hilo(*(const f32x4*)up, *(const f32x4*)(up + 4), hi, lo); if (q >= 2) lo = (u32x4){0u, 0u, 0u, 0u};
    ub.hi = *(const bf16x8*)&hi; ub.lo = *(const bf16x8*)&lo;
}
template <bool WR> __device__ __forceinline__ void ssm_block16(const SsmW& w, const SsmU& ub, int lane, float& xr, float& xi, LAS float* XW) {
#pragma unroll
    for (int blk = 0; blk < 8; ++blk) { f32x4 d = {0.f, 0.f, 0.f, 0.f};
        d = __builtin_amdgcn_mfma_f32_16x16x32_bf16(w.ab[blk], ub.hi, d, 0, 0, 0); d = __builtin_amdgcn_mfma_f32_16x16x32_bf16(w.ab[blk], ub.lo, d, 0, 0, 0);
        *(LAS f32x4*)(XW + (lane & 15) * 132 + 16 * blk + 4 * (lane >> 4)) = d; }
    float br[16], bi[16];
#pragma unroll
    for (int t = 0; t < 16; ++t) { br[t] = XW[t * 132 + lane]; bi[t] = XW[t * 132 + 64 + lane]; }
#pragma unroll
    for (int t = 0; t < 16; ++t) { const float nr = fmaf(w.lr, xr, fmaf(-w.li, xi, br[t])), ni = fmaf(w.lr, xi, fmaf(w.li, xr, bi[t])); xr = nr; xi = ni;
        if (WR) { XW[t * 132 + lane] = xr; XW[t * 132 + 64 + lane] = xi; } }
}
__device__ __forceinline__ void ssm_pass_a(const Frame& F) {
    const float* U = F.out; float* SEND = (float*)(F.ws + W_SEND); LAS float* XW = (LAS float*)(F.lds + F.wid * 8448);
    const int g = (F.bid * 8 + F.wid) & 31, p = F.lane; SsmW w; ssm_load_w(F, g, p, w);
    for (int it = F.bid * 8 + F.wid; it < 256 * 32; it += F.G * 8) { const int c = it >> 5;
        float xr = 0.f, xi = 0.f;
        SsmU ub[4];
#pragma unroll
        for (int sb = 0; sb < 4; ++sb) ssm_load_u(U, c * 64 + sb * 16, g, p, ub[sb]);
#pragma unroll
        for (int sb = 0; sb < 4; ++sb) ssm_block16<false>(w, ub[sb], p, xr, xi, XW);
        SEND[(size_t)c * 4096 + g * 64 + p] = xr; SEND[(size_t)c * 4096 + 2048 + g * 64 + p] = xi; }
}
__device__ __forceinline__ void ssm_pass_b(const Frame& F, int b0) {
    float* SEND = (float*)(F.ws + W_SEND); const float* LAM64 = (const float*)(F.ws + W_LAM64);
    const int i = b0 * 512 + F.tid; if (i < 0 || i >= 2048) return;
    const float l6r = LAM64[i], l6i = LAM64[2048 + i]; float xr = 0.f, xi = 0.f;
    float nr_[16], ni_[16];
#pragma unroll
    for (int j = 0; j < 16; ++j) { nr_[j] = SEND[(size_t)j * 4096 + i]; ni_[j] = SEND[(size_t)j * 4096 + 2048 + i]; }
    for (int c0 = 0; c0 < 256; c0 += 16) { float sr[16], si[16];
#pragma unroll
        for (int j = 0; j < 16; ++j) { sr[j] = nr_[j]; si[j] = ni_[j]; }
        if (c0 + 16 < 256) {
#pragma unroll
            for (int j = 0; j < 16; ++j) { nr_[j] = SEND[(size_t)(c0 + 16 + j) * 4096 + i]; ni_[j] = SEND[(size_t)(c0 + 16 + j) * 4096 + 2048 + i]; } }
#pragma unroll
        for (int j = 0; j < 16; ++j) { SEND[(size_t)(c0 + j) * 4096 + i] = xr; SEND[(size_t)(c0 + j) * 4096 + 2048 + i] = xi;
            const float nr = fmaf(l6r, xr, fmaf(-l6i, xi, sr[j])), ni = fmaf(l6r, xi, fmaf(l6i, xr, si[j])); xr = nr; xi = ni; } }
}
__device__ __forceinline__ void ssm_pass_c(const Frame& F) {
    const float* U = F.out; bf16_t* YG = (bf16_t*)((unsigned char*)F.out + 36 * MiB); const float* SEND = (const float*)(F.ws + W_SEND);
    const float* c_re = F.a->in[18]; const float* c_im = F.a->in[19]; const float* dsk = F.a->in[20];
    LAS float* XW = (LAS float*)(F.lds + F.wid * 8448);
    const int p = F.lane, hq = 4 * (F.lane >> 4), tl = F.lane & 15;
    const int g = (F.bid * 8 + F.wid) & 31; SsmW w; ssm_load_w(F, g, p, w);
    bf16x8 cab[4];
#pragma unroll
    for (int ks = 0; ks < 4; ++ks) { const int k = 32 * ks + 8 * (F.lane >> 4); const float* cp = ks < 2 ? c_re + (size_t)(g * 16 + tl) * 64 + k : c_im + (size_t)(g * 16 + tl) * 64 + (k - 64);
        f32x4 a = *(const f32x4*)cp, b = *(const f32x4*)(cp + 4); if (ks >= 2) { a = -a; b = -b; }
        u32x4 w; w.x = cvt_pk_bf16(a[0], a[1]); w.y = cvt_pk_bf16(a[2], a[3]); w.z = cvt_pk_bf16(b[0], b[1]); w.w = cvt_pk_bf16(b[2], b[3]); cab[ks] = *(bf16x8*)&w; }
    const f32x4 ds4 = *(const f32x4*)(dsk + g * 16 + hq);
    for (int it = F.bid * 8 + F.wid; it < 9216; it += F.G * 8) {
        const bool prompt = it < 8192; const int c = prompt ? (it >> 5) : ((it - 8192) >> 5);
        float xr, xi; int tok0, nsb;
        if (prompt) { xr = SEND[(size_t)c * 4096 + g * 64 + p]; xi = SEND[(size_t)c * 4096 + 2048 + g * 64 + p];
            tok0 = c * 64; nsb = 4;
        } else { xr = F.a->in[5][(size_t)(c * 32 + g) * 64 + p]; xi = F.a->in[6][(size_t)(c * 32 + g) * 64 + p]; tok0 = TP + c * 32; nsb = 2; }
        SsmU ub[4]; f32x4 u4a[4];
#pragma unroll
        for (int sb = 0; sb < 4; ++sb) { ssm_load_u(U, tok0 + sb * 16, g, p, ub[sb]); u4a[sb] = *(const f32x4*)(U + (size_t)(tok0 + sb * 16 + tl) * 512 + g * 16 + hq); }
#pragma unroll
        for (int sb = 0; sb < 4; ++sb) { if (sb >= nsb) break; const int tb = tok0 + sb * 16;
            ssm_block16<true>(w, ub[sb], p, xr, xi, XW);
            f32x4 y0 = {0.f, 0.f, 0.f, 0.f}, y1 = {0.f, 0.f, 0.f, 0.f};
#pragma unroll
            for (int ks = 0; ks < 4; ++ks) { const LAS float* xp = XW + tl * 132 + 32 * ks + 8 * (F.lane >> 4); const f32x4 xa = *(const LAS f32x4*)xp, xb = *(const LAS f32x4*)(xp + 4);
                u32x4 w; w.x = cvt_pk_bf16(xa[0], xa[1]); w.y = cvt_pk_bf16(xa[2], xa[3]); w.z = cvt_pk_bf16(xb[0], xb[1]); w.w = cvt_pk_bf16(xb[2], xb[3]); const bf16x8 xf = *(bf16x8*)&w;
                if (ks & 1) y1 = __builtin_amdgcn_mfma_f32_16x16x32_bf16(cab[ks], xf, y1, 0, 0, 0); else y0 = __builtin_amdgcn_mfma_f32_16x16x32_bf16(cab[ks], xf, y0, 0, 0, 0); }
            f32x4 y = y0 + y1 + ds4 * u4a[sb];
#pragma unroll
            for (int j = 0; j < 4; ++j) y[j] = gelu_tanh(y[j]);
            *(u32x2*)(YG + (size_t)(tb + tl) * 512 + g * 16 + hq) = pack4(y);
        }
        if (prompt) { if (c == 255) { F.out[O_SREP + g * 64 + p] = xr; F.out[O_SIMP + g * 64 + p] = xi; } }
        else { F.out[O_SRES + (size_t)(c * 32 + g) * 64 + p] = xr; F.out[O_SIMS + (size_t)(c * 32 + g) * 64 + p] = xi; }
    }
}

__device__ __forceinline__ float wave_sum(float v) {
#pragma unroll
    for (int o = 32; o > 0; o >>= 1) v += __shfl_xor(v, o);
    return v;
}
__device__ __forceinline__ void post_rows(const Frame& F) {
    const float* PQ = (const float*)(F.ws + A_PQ); bf16_t* CQN = (bf16_t*)(F.ws + A_CQN); bf16_t* CKV = (bf16_t*)(F.ws + A_CKV); bf16_t* KPE = (bf16_t*)(F.ws + A_KPE);
    const float* gkv = F.a->in[12];
    const int l = F.lane, rstep = F.G * 8; int row = F.bid * 8 + F.wid;
    f32x4 nq0 = {0.f, 0.f, 0.f, 0.f}, nkv = nq0; u32x2 nq1 = {0u, 0u}; float npe = 0.f;
    if (row < MTOK) { const float* pr = PQ + (size_t)row * 768; nq0 = *(const f32x4*)(pr + 4 * l); nq1 = *(const u32x2*)(pr + 256 + 2 * l); nkv = *(const f32x4*)(pr + 384 + 4 * l); npe = pr[640 + l]; }
    for (; row < MTOK; row += rstep) {
        const f32x4 q0 = nq0, kv = nkv; const u32x2 q1r = nq1; const float pe = npe; const float q10 = __uint_as_float(q1r.x), q11 = __uint_as_float(q1r.y);
        if (row + rstep < MTOK) { const float* pr = PQ + (size_t)(row + rstep) * 768; nq0 = *(const f32x4*)(pr + 4 * l); nq1 = *(const u32x2*)(pr + 256 + 2 * l); nkv = *(const f32x4*)(pr + 384 + 4 * l); npe = pr[640 + l]; }
        const float sq = wave_sum((q0[0] * q0[0] + q0[1] * q0[1]) + (q0[2] * q0[2] + q0[3] * q0[3]) + q10 * q10 + q11 * q11);
        const float skv = wave_sum((kv[0] * kv[0] + kv[1] * kv[1]) + (kv[2] * kv[2] + kv[3] * kv[3]));
        const float rq = rsqrtf(sq * (1.f / 384.f) + EPSN), rkv = rsqrtf(skv * (1.f / 256.f) + EPSN);
        *(u32x2*)(CQN + (size_t)row * 384 + 4 * l) = pack4(q0 * rq); *(unsigned*)(CQN + (size_t)row * 384 + 256 + 2 * l) = cvt_pk_bf16(q10 * rq, q11 * rq);
        const f32x4 g4 = *(const f32x4*)(gkv + 4 * l); const f32x4 kvn = kv * rkv * g4; const int kr = tok_kvrow(row);
        float* oc = row < TP ? F.out + O_CKVP + (size_t)row * 256 : F.out + O_CKVS + (size_t)(row - TP) * 256; float* ok = row < TP ? F.out + O_KPEP + (size_t)row * 64 : F.out + O_KPES + (size_t)(row - TP) * 64;
        *(f32x4*)(oc + 4 * l) = kvn; *(u32x2*)(CKV + (size_t)kr * 256 + 4 * l) = pack4(kvn);
        float c, s; rope_cs(tok_pos(row), l & 31, c, s); const float other = __shfl_xor(pe, 32);
        const float ro = l < 32 ? pe * c - other * s : pe * c + other * s;
        ok[l] = ro; const float ron = __shfl_xor(ro, 1); if ((l & 1) == 0) *(unsigned*)(KPE + (size_t)swap23(kr) * 64 + l) = cvt_pk_bf16(ro, ron); }
}
__device__ __forceinline__ void final_ln(const Frame& F) {
    const float* g = F.a->in[32] + 2048; const float* b = F.a->in[33] + 2048;
    const int rstep = F.G * 8; int row = F.bid * 8 + F.wid; f32x4 nv[4];
#pragma unroll
    for (int i = 0; i < 4; ++i) nv[i] = row < MTOK ? *(const f32x4*)(F.out + O_Y + (size_t)row * 1024 + i * 256 + 4 * F.lane) : (f32x4){0.f, 0.f, 0.f, 0.f};
    for (; row < MTOK; row += rstep) { float* pr = F.out + O_Y + (size_t)row * 1024; f32x4 v[4]; float s = 0.f;
#pragma unroll
        for (int i = 0; i < 4; ++i) { v[i] = nv[i]; s += (v[i][0] + v[i][1]) + (v[i][2] + v[i][3]); }
        if (row + rstep < MTOK) {
#pragma unroll
            for (int i = 0; i < 4; ++i) nv[i] = *(const f32x4*)(pr + (size_t)rstep * 1024 + i * 256 + 4 * F.lane); }
        if (row >= TP) {
            const float* ST2 = (const float*)(F.ws + W_ST2); float mu2, rstd2; ln_stats16(ST2, ST2 + 16 * MTOK, row, mu2, rstd2);
            const float* SL = (const float*)(F.ws + A_R2B) + (size_t)(row - TP) * 1024; s = 0.f;
#pragma unroll
            for (int i = 0; i < 4; ++i) { const int c = i * 256 + 4 * F.lane; const f32x4 g1 = *(const f32x4*)(F.a->in[32] + 1024 + c), b1 = *(const f32x4*)(F.a->in[33] + 1024 + c);
                f32x4 a = (v[i] - mu2) * rstd2 * g1 + b1; a = a * ALPHA;
#pragma unroll
                for (int k = 0; k < 8; ++k) a = a + *(const f32x4*)(SL + (size_t)k * 1024 * 1024 + c);
                v[i] = a; s += (a[0] + a[1]) + (a[2] + a[3]); } }
        const float mu = wave_sum(s) * (1.f / 1024.f); float q = 0.f;
#pragma unroll
        for (int i = 0; i < 4; ++i) { const f32x4 d = v[i] - mu; q += (d[0] * d[0] + d[1] * d[1]) + (d[2] * d[2] + d[3] * d[3]); }
        const float rstd = rsqrtf(wave_sum(q) * (1.f / 1024.f) + EPSN);
#pragma unroll
        for (int i = 0; i < 4; ++i) { const f32x4 g4 = *(const f32x4*)(g + i * 256 + 4 * F.lane), b4 = *(const f32x4*)(b + i * 256 + 4 * F.lane); *(f32x4*)(pr + i * 256 + 4 * F.lane) = (v[i] - mu) * rstd * g4 + b4; } }
}

struct MapId { __device__ __forceinline__ int operator()(int n) const { return n; } };
struct MapWin { __device__ __forceinline__ int operator()(int n) const { return n < 1216 ? n : -1; } };
struct MapWq { __device__ __forceinline__ int operator()(int n) const { if (n < 512) return (n >> 7) * 192 + (n & 127); const int x = n - 512, part = x >> 7, h = (x >> 5) & 3, i = x & 31; return h * 192 + 128 + part * 32 + i; } };
struct MapWk { __device__ __forceinline__ int operator()(int n) const { return (n >> 7) * 256 + (n & 127); } };
struct MapWv { __device__ __forceinline__ int operator()(int n) const { return (n >> 7) * 256 + 128 + (n & 127); } };
struct MapGlu { __device__ __forceinline__ int operator()(int n) const { const int pn = n >> 8, bj = (n >> 7) & 1, x = n & 127; return bj * 512 + pn * 128 + x; } };
template <class CM, bool PERMK = false> __device__ __forceinline__ void wconv(const Frame& F, bf16_t* __restrict__ dst, const float* __restrict__ src, int ld, int K, int N, CM cm, const float* sc0, const float* sc1, int ksplit, int& rot) {
    const int ntn = N >> 5, ntiles = ntn * (K >> 6), tid = F.tid, kr = tid >> 3, nq = tid & 7;
    LAS float* T = (LAS float*)F.lds;
    for (int base = ((F.bid + F.G - rot % F.G) % F.G) * 4; base < ntiles; base += F.G * 4) { f32x4 v[4];
#pragma unroll
        for (int u = 0; u < 4; ++u) { const int tile = base + u; v[u] = (f32x4){0.f, 0.f, 0.f, 0.f};
            if (tile < ntiles) { const int tn = tile % ntn, tk = tile / ntn, col = cm(tn * 32), k = tk * 64 + kr;
                if (col >= 0) { v[u] = *(const f32x4*)(src + (size_t)k * ld + col + 4 * nq); if (sc0) v[u] = v[u] * (k < ksplit ? sc0[k] : sc1[k - ksplit]); } } }
#pragma unroll
        for (int u = 0; u < 4; ++u) {
#pragma unroll
            for (int j = 0; j < 4; ++j) T[u * 2112 + kr * 33 + 4 * nq + j] = v[u][j]; }
        __syncthreads();
        { const int half = tid >> 8, tt = tid & 255, n = tt >> 3, kq = tt & 7;
#pragma unroll
          for (int uu = 0; uu < 2; ++uu) { const int u = half * 2 + uu, tile = base + u;
              if (tile < ntiles) { const int tn = tile % ntn, tk = tile / ntn; float x[8];
#pragma unroll
                  for (int j = 0; j < 8; ++j) { const int pos = 8 * kq + j, kk = PERMK ? ((pos & ~12) | ((pos & 4) << 1) | ((pos & 8) >> 1)) : pos; x[j] = T[u * 2112 + kk * 33 + n]; }
                  u32x4 w; w.x = cvt_pk_bf16(x[0], x[1]); w.y = cvt_pk_bf16(x[2], x[3]); w.z = cvt_pk_bf16(x[4], x[5]); w.w = cvt_pk_bf16(x[6], x[7]);
                  *(u32x4*)(dst + (size_t)(tn * 32 + n) * K + tk * 64 + 8 * kq) = w; } } }
        __syncthreads(); }
    rot += (ntiles + 3) >> 2;
}
__device__ __forceinline__ void cvt_flat(const Frame& F, bf16_t* __restrict__ dst, const float* __restrict__ src, long n8) {
    const long gs = (long)F.G * 512;
    for (long base = (long)F.bid * 512 + F.tid; base < n8; base += 4 * gs) { f32x4 a[4], b[4];
#pragma unroll
        for (int u = 0; u < 4; ++u) { const long i = base + u * gs; const long ii = i < n8 ? i : 0; a[u] = *(const f32x4*)(src + ii * 8); b[u] = *(const f32x4*)(src + ii * 8 + 4); }
#pragma unroll
        for (int u = 0; u < 4; ++u) { const long i = base + u * gs; if (i < n8) { u32x4 w; w.x = cvt_pk_bf16(a[u][0], a[u][1]); w.y = cvt_pk_bf16(a[u][2], a[u][3]); w.z = cvt_pk_bf16(b[u][0], b[u][1]); w.w = cvt_pk_bf16(b[u][2], b[u][3]); *(u32x4*)(dst + i * 8) = w; } } }
}
__device__ __forceinline__ void colsum_job(const Frame& F, const float* W, int N, const float* g, const float* b, float* cs, float* bw, int rotb) {
    LAS float* red = (LAS float*)F.lds;
    const int seg = F.tid >> 4, col = F.tid & 15;
    for (int task = (F.bid + F.G - rotb % F.G) % F.G; task < N / 16; task += F.G) { const int n = task * 16 + col; float s = 0.f, t = 0.f;
#pragma unroll
        for (int j = 0; j < 32; ++j) { const int k = seg * 32 + j; const float w = W[(size_t)k * N + n]; s += bf16_round(w * g[k]); t = fmaf(b[k], w, t); }
        red[F.tid] = s; red[512 + F.tid] = t; __syncthreads();
        if (F.tid < 16) { float a = 0.f, c = 0.f;
#pragma unroll
            for (int i = 0; i < 32; ++i) { a += red[i * 16 + F.tid]; c += red[512 + i * 16 + F.tid]; }
            cs[n] = a; bw[n] = c; }
        __syncthreads(); }
}
__device__ __forceinline__ void ssm_consts(const Frame& F) {
    const int i = F.bid * 512 + F.tid; if (i >= 2048) return;
    const int g = i >> 6; float* LAM = (float*)(F.ws + W_LAM); float* LAM64 = (float*)(F.ws + W_LAM64); float* BB = (float*)(F.ws + W_BB);
    const double ar = F.a->in[14][i], ai = F.a->in[15][i], dt = exp((double)F.a->in[21][g]);
    const double mag = exp(ar * dt), lr = mag * cos(ai * dt), li = mag * sin(ai * dt);
    LAM[i] = (float)lr; LAM[2048 + i] = (float)li;
    double pr = lr, pi = li;
#pragma unroll
    for (int k = 0; k < 6; ++k) { const double nr = pr * pr - pi * pi, ni = 2.0 * pr * pi; pr = nr; pi = ni; }
    LAM64[i] = (float)pr; LAM64[2048 + i] = (float)pi;
    const double nr = lr - 1.0, ni = li, den = ar * ar + ai * ai, fr = (nr * ar + ni * ai) / den, fi = (ni * ar - nr * ai) / den;
#pragma unroll
    for (int h = 0; h < 16; ++h) { const double br = F.a->in[16][(size_t)i * 16 + h], bi = F.a->in[17][(size_t)i * 16 + h];
        BB[(size_t)i * 16 + h] = (float)(fr * br - fi * bi); BB[32768 + (size_t)i * 16 + h] = (float)(fr * bi + fi * br); }
}
__device__ __forceinline__ void cvt_caches(const Frame& F, int b0, int nb) {
    unsigned char* ws = F.ws; { bf16_t* CKV = (bf16_t*)(ws + A_CKV); bf16_t* KPE = (bf16_t*)(ws + A_KPE); const long gs = (long)nb * 512;
#pragma unroll 4
      for (long i = (long)b0 * 512 + F.tid; i < 32L * 1024 * 32; i += gs) { const int c8 = (int)(i & 31), j = (int)((i >> 5) & 1023), bb = (int)(i >> 15);
          const float* s = F.a->in[3] + ((size_t)(bb * 1024 + j) * 256 + c8 * 8); const f32x4 a = *(const f32x4*)s, b = *(const f32x4*)(s + 4);
          u32x4 w; w.x = cvt_pk_bf16(a[0], a[1]); w.y = cvt_pk_bf16(a[2], a[3]); w.z = cvt_pk_bf16(b[0], b[1]); w.w = cvt_pk_bf16(b[2], b[3]);
          *(u32x4*)(CKV + (size_t)(TP + bb * KVS + j) * 256 + c8 * 8) = w; }
#pragma unroll 2
      for (long i = (long)b0 * 512 + F.tid; i < 32L * 1024 * 8; i += gs) { const int c8 = (int)(i & 7), j = (int)((i >> 3) & 1023), bb = (int)(i >> 13);
          const float* s = F.a->in[4] + ((size_t)(bb * 1024 + j) * 64 + c8 * 8); const f32x4 a = *(const f32x4*)s, b = *(const f32x4*)(s + 4);
          u32x4 w; w.x = cvt_pk_bf16(a[0], a[1]); w.y = cvt_pk_bf16(a[2], a[3]); w.z = cvt_pk_bf16(b[0], b[1]); w.w = cvt_pk_bf16(b[2], b[3]);
          *(u32x4*)(KPE + (size_t)swap23(TP + bb * KVS + j) * 64 + c8 * 8) = w; } }
}
#ifndef PRO_DUP
#define PRO_DUP 0
#endif
#define DUPP(j) _Pragma("unroll") for (int rp_ = 0; rp_ < (((PRO_DUP >> (j)) & 1) ? 2 : 1); ++rp_)
__device__ __forceinline__ void prologue(const Frame& F) {
    unsigned char* ws = F.ws;
    DUPP(0) ssm_consts(F);
    int rot = 8;
    DUPP(1) {
    wconv(F, (bf16_t*)(ws + W_WIN), F.a->in[9], 1216, 1024, 1280, MapWin(), nullptr, nullptr, 0, rot);
    }
    DUPP(2) {
    if (F.G > 8) { if (F.bid >= 4) { Frame F2 = F; F2.bid = F.bid - 4; F2.G = F.G - 4; cvt_flat(F2, (bf16_t*)(ws + A_XB), F.a->in[0], (long)TP * 128); } }
    else cvt_flat(F, (bf16_t*)(ws + A_XB), F.a->in[0], (long)TP * 128);
    cvt_flat(F, (bf16_t*)(ws + A_XB) + (size_t)TP * 1024, F.a->in[1], (long)TS * 128);
    cvt_flat(F, (bf16_t*)(ws + W_MEMB), F.a->in[2], 256 * 128);
    }
    DUPP(1) {
    wconv(F, (bf16_t*)(ws + W_WXK), F.a->in[27], 1024, 1024, 1024, MapId(), nullptr, nullptr, 0, rot);
    wconv(F, (bf16_t*)(ws + W_WXV), F.a->in[28], 1024, 1024, 1024, MapId(), nullptr, nullptr, 0, rot);
    wconv(F, (bf16_t*)(ws + W_WQ), F.a->in[11], 768, 384, 768, MapWq(), F.a->in[10], F.a->in[10], 384, rot);
    wconv(F, (bf16_t*)(ws + W_WK), F.a->in[13], 1024, 256, 512, MapWk(), nullptr, nullptr, 0, rot);
    wconv(F, (bf16_t*)(ws + W_WV), F.a->in[13], 1024, 256, 512, MapWv(), nullptr, nullptr, 0, rot);
    wconv(F, (bf16_t*)(ws + W_WGLU), F.a->in[22], 1024, 512, 1024, MapGlu(), nullptr, nullptr, 0, rot);
    wconv(F, (bf16_t*)(ws + W_WO), F.a->in[25], 1024, 1024, 1024, MapId(), F.a->in[23], F.a->in[24], 512, rot);
    wconv(F, (bf16_t*)(ws + W_WXQ), F.a->in[26], 1024, 1024, 1024, MapId(), F.a->in[32], F.a->in[32], 1024, rot);
    wconv(F, (bf16_t*)(ws + W_WXO), F.a->in[29], 1024, 1024, 1024, MapId(), nullptr, nullptr, 0, rot);
    wconv(F, (bf16_t*)(ws + W_WFF1), F.a->in[30], 4096, 1024, 4096, MapId(), F.a->in[32] + 1024, F.a->in[32] + 1024, 1024, rot);
    wconv(F, (bf16_t*)(ws + W_WFF2), F.a->in[31], 1024, 4096, 1024, MapId(), nullptr, nullptr, 0, rot);
    }
    DUPP(4) {
    colsum_job(F, F.a->in[26], 1024, F.a->in[32], F.a->in[33], (float*)(ws + W_CSXQ), (float*)(ws + W_BWXQ), 0);
    colsum_job(F, F.a->in[30], 4096, F.a->in[32] + 1024, F.a->in[33] + 1024, (float*)(ws + W_CSFF1), (float*)(ws + W_BWFF1), 64);
    }
}
__device__ __forceinline__ void cvt_memcache(const Frame& F, int b0, int bstride) {
    bf16_t* XKS = (bf16_t*)(F.ws + A_XKS); bf16_t* XVTS = (bf16_t*)(F.ws + A_XVTS); const float* ck = F.a->in[7]; const float* cv = F.a->in[8];
    const long gs = (long)bstride * 512;
    for (long i = (long)b0 * 512 + F.tid; i < 32L * 256 * 128; i += gs) { const f32x4 a = *(const f32x4*)(ck + i * 8), b = *(const f32x4*)(ck + i * 8 + 4);
        const long rowi = i >> 7, c8 = i & 127; const long drow = (rowi & ~255L) | swap23((int)(rowi & 255));
        u32x4 w; w.x = cvt_pk_bf16(a[0], a[1]); w.y = cvt_pk_bf16(a[2], a[3]); w.z = cvt_pk_bf16(b[0], b[1]); w.w = cvt_pk_bf16(b[2], b[3]); *(u32x4*)(XKS + drow * 1024 + c8 * 8) = w; }
    { Frame F2 = F; F2.bid = b0; F2.G = bstride; int rot = 0;
      for (int bb = 0; bb < 32; ++bb) wconv<MapId, false>(F2, XVTS + (size_t)bb * 262144, cv + (size_t)bb * 262144, 1024, 256, 1024, MapId(), nullptr, nullptr, 0, rot); }
}

#define XB_TMO      128
#define XB_XCNT(j)  (256  + 64 * (j))
#define XB_XSUB(j)  (1280 + 64 * (j))
#define XB_XGEN(j)  (2304 + 64 * (j))
#define XB_TOP      3328
#define XB_TOPGEN   3392
#define XCD_BAR_WORDS 3456
#define XB_SPIN_CAP (1u << 18)

__device__ __forceinline__ unsigned xb_ld(unsigned* p)              { return __hip_atomic_load(p, __ATOMIC_RELAXED, __HIP_MEMORY_SCOPE_AGENT); }
__device__ __forceinline__ unsigned xb_add(unsigned* p, unsigned v) { return __hip_atomic_fetch_add(p, v, __ATOMIC_RELAXED, __HIP_MEMORY_SCOPE_AGENT); }
__device__ __forceinline__ unsigned xb_xcc_id() { return (unsigned)__builtin_amdgcn_s_getreg((3 << 11) | 20) & 0xFu; }
#define XB_SPIN(cond, bar) do { unsigned _sp = 0; while (cond) { __builtin_amdgcn_s_sleep(1); \
    if ((++_sp & 255u) == 0u) { if (xb_ld(&(bar)[XB_TMO])) break; if (_sp > XB_SPIN_CAP) { atomicAdd(&(bar)[XB_TMO], 1u); break; } } } } while (0)

struct XcdBarrier {
    unsigned* bar; unsigned x;
    volatile LAS unsigned* st;
};

__device__ __forceinline__ XcdBarrier xcd_barrier_post(unsigned* bar, volatile LAS unsigned* st) {
    XcdBarrier b; b.bar = bar; b.x = xb_xcc_id(); b.st = st;
    if (threadIdx.x == 0) (void)xb_add(&bar[XB_XCNT(b.x)], 1u);
    return b;
}
__device__ __forceinline__ void xcd_barrier_complete(unsigned* bar, unsigned x, unsigned& nloc, unsigned& nx) {
    const unsigned G = gridDim.x * gridDim.y * gridDim.z;
    unsigned sum, cnt, mine, sp = 0u;
    for (;;) {
        sum = 0u; cnt = 0u; mine = 0u;
#pragma unroll
        for (unsigned j = 0; j < 16; ++j) { const unsigned c = xb_ld(&bar[XB_XCNT(j)]); sum += c; cnt += (c > 0u) ? 1u : 0u; mine = (j == x) ? c : mine; }
        if (sum == G) break;
        __builtin_amdgcn_s_sleep(1);
        if ((++sp & 255u) == 0u) { if (xb_ld(&bar[XB_TMO])) break; if (sp > XB_SPIN_CAP) { atomicAdd(&bar[XB_TMO], 1u); break; } }
    }
    nloc = mine > 0u ? mine : 1u; nx = cnt > 0u ? cnt : 1u;
}

__device__ __forceinline__ void xcd_barrier(const XcdBarrier& b) {
    asm volatile("s_waitcnt vmcnt(0)" ::: "memory");
    __syncthreads();
    if (threadIdx.x == 0) {
        unsigned* bar = b.bar;
        __builtin_amdgcn_s_waitcnt(0);
        unsigned nloc = b.st[0], nx = b.st[1];
        if (nloc == 0u) { xcd_barrier_complete(bar, b.x, nloc, nx); b.st[0] = nloc; b.st[1] = nx; }
        const unsigned old = xb_add(&bar[XB_XSUB(b.x)], 1u);
        const unsigned gen = old / nloc;
        if (old + 1u == (gen + 1u) * nloc) {
            __builtin_amdgcn_fence(__ATOMIC_RELEASE, "agent");
            asm volatile("s_waitcnt vmcnt(0)" ::: "memory");
            const unsigned og = xb_add(&bar[XB_TOP], 1u);
            const unsigned tg = og / nx;
            if (og + 1u == (tg + 1u) * nx) xb_add(&bar[XB_TOPGEN], 1u);
            else XB_SPIN(xb_ld(&bar[XB_TOPGEN]) == tg, bar);
            __builtin_amdgcn_fence(__ATOMIC_ACQUIRE, "agent");
            xb_add(&bar[XB_XGEN(b.x)], 1u);
            asm volatile("s_waitcnt vmcnt(0)" ::: "memory");
        } else {
            XB_SPIN(xb_ld(&bar[XB_XGEN(b.x)]) == gen, bar);
            __builtin_amdgcn_fence(__ATOMIC_ACQUIRE, "agent");
            asm volatile("s_waitcnt vmcnt(0)" ::: "memory");
        }
    }
    __syncthreads();
}

constexpr int NPHASE = 13;
#ifndef PHASE_MASK
#define PHASE_MASK 0x1FFF
#endif
#ifndef SUBMASK
#define SUBMASK 0xFF
#endif
#define SUB(j) if ((SUBMASK >> (j)) & 1)
#ifndef DUP_MASK
#define DUP_MASK 0
#endif
#define DUP(k) _Pragma("unroll") for (int rep_ = 0; rep_ < (((DUP_MASK >> (k)) & 1) ? 2 : 1); ++rep_)
#define PH(k) if (!((PHASE_MASK >> (k)) & 1)) break;
using pg8::Gemm; using pg8::StaticOrder;
#define RUN_GEMM_LN(EPI, gm, e, PS_, PQ_) do { StaticOrder S_; S_.init((gm).M, (gm).N, F.G, F.bid, 0); ln_fill_tab(S_, PS_, PQ_, (LAS float*)(F.lds + 131072)); pg8::gemm_phase<EPI, StaticOrder, true, true>(F.lds, gm, S_, e); } while (0)
#define RUN_GEMM(EPI, gm, e, rot) do { StaticOrder S_; S_.init((gm).M, (gm).N, F.G, F.bid, rot); pg8::gemm_phase<EPI, StaticOrder, true, true>(F.lds, gm, S_, e); } while (0)

#define WS (F.ws)
#define U (F.a->out)
#define YG ((bf16_t*)((unsigned char*)F.a->out + 36 * MiB))
#define STSSM ((float*)(WS + W_STSSM))
#define STMLA ((float*)(WS + W_STMLA))
#define ST1 ((float*)(WS + W_ST1))
#define ST2 ((float*)(WS + W_ST2))
#define KN ((bf16_t*)(WS + A_KN))
#define VT ((bf16_t*)(WS + A_VT))
#define Q ((bf16_t*)(WS + A_Q))
#define KPE ((bf16_t*)(WS + A_KPE))
#define MIX ((bf16_t*)(WS + A_MIX))
#define R (F.a->out + O_Y)
__global__ void __launch_bounds__(512, 2) fwd_kernel(Args a) {
    extern __shared__ __attribute__((aligned(16))) unsigned char lds_raw[];
    Frame F;
    F.a = (const Args*)__builtin_amdgcn_kernarg_segment_ptr();
    F.out = a.out; F.ws = a.ws; F.lds = (LAS unsigned char*)lds_raw; F.tid = threadIdx.x; F.lane = F.tid & 63; F.wid = __builtin_amdgcn_readfirstlane(F.tid >> 6); F.G = gridDim.x; F.bid = blockIdx.x;
    const int lo = a.ph_lo, hi = a.ph_hi;
    volatile LAS unsigned* bst = (volatile LAS unsigned*)(F.lds + LDS_BYTES - 16);
    if (F.tid < 2) bst[F.tid] = 0u;
    __syncthreads();
    (void)xcd_barrier_post((unsigned*)(WS + W_BAR), bst);
    if (hi > 1000) cg::this_grid().sync();
#define GSYNC(k) if ((k) + 1 < hi) { XcdBarrier b_; b_.bar = (unsigned*)(F.a->ws + W_BAR); b_.x = xb_xcc_id(); b_.st = (volatile LAS unsigned*)(F.lds + LDS_BYTES - 16); xcd_barrier(b_); }
        if (((PHASE_MASK >> 0) & 1) && lo <= 0 && 0 < hi) DUP(0) { prologue(F); }
        if (lo <= 0 && 0 < hi) GSYNC(0)
        if (((PHASE_MASK >> 1) & 1) && lo <= 1 && 1 < hi) DUP(1) { {
            SUB(0) { Gemm g{(const bf16_t*)(WS + A_XB), (const bf16_t*)(WS + W_WIN), MTOK, 1280, 1024}; EpiProj e{U, (float*)(WS + A_PQ)}; RUN_GEMM(EpiProj, g, e, 0); }
            SUB(1) { Gemm g{(const bf16_t*)(WS + W_MEMB), (const bf16_t*)(WS + W_WXK), 256, 1024, 1024}; EpiStore<false> e{(bf16_t*)(WS + W_XK0), 1024, F.a->out + O_MKP, 1024, nullptr, 0, 1}; RUN_GEMM(EpiStore<false>, g, e, 172); }
            SUB(2) { Gemm g{(const bf16_t*)(WS + W_WXV), (const bf16_t*)(WS + W_MEMB), 1024, 256, 1024}; EpiStore<false> e{(bf16_t*)(WS + W_XVT0), 256, nullptr, 0, F.a->out + O_MVP, 1024, 0}; RUN_GEMM(EpiStore<false>, g, e, 168); }
            if (F.G > 92) { if (F.bid >= 92) cvt_caches(F, F.bid - 92, F.G - 92); } else cvt_caches(F, F.bid, F.G);
        } }
        if (lo <= 1 && 1 < hi) GSYNC(1)
        if (((PHASE_MASK >> 2) & 1) && lo <= 2 && 2 < hi) DUP(2) { post_rows(F); ssm_pass_a(F); }
        if (lo <= 2 && 2 < hi) GSYNC(2)
        if (((PHASE_MASK >> 3) & 1) && lo <= 3 && 3 < hi) DUP(3) { {
            SUB(0) ssm_pass_b(F, F.bid - (F.G - 4)); __syncthreads();
            SUB(1) { Gemm g{(const bf16_t*)(WS + A_CQN), (const bf16_t*)(WS + W_WQ), MTOK, 768, 384}; EpiQ e{Q}; RUN_GEMM(EpiQ, g, e, 0); }
            SUB(2) { Gemm g{(const bf16_t*)(WS + A_CKV), (const bf16_t*)(WS + W_WK), KVROWS, 512, 256}; EpiStore<false> e{KN, 512, nullptr, 0, nullptr, 0, 1}; RUN_GEMM(EpiStore<false>, g, e, 52); }
            SUB(3) { Gemm g{(const bf16_t*)(WS + W_WV), (const bf16_t*)(WS + A_CKV), 512, KVROWS, 256}; EpiStore<false> e{VT, KVPAD, nullptr, 0, nullptr, 0, 0}; RUN_GEMM(EpiStore<false>, g, e, 172); }
        } }
        if (lo <= 3 && 3 < hi) GSYNC(3)
        if (((PHASE_MASK >> 4) & 1) && lo <= 4 && 4 < hi) DUP(4) { ssm_pass_c(F); }
        if (lo <= 4 && 4 < hi) GSYNC(4)
        if (((PHASE_MASK >> 5) & 1) && lo <= 5 && 5 < hi) DUP(5) { {
            SUB(0) { Gemm g{YG, (const bf16_t*)(WS + W_WGLU), MTOK, 1024, 512}; EpiGlu e{MIX, STSSM}; RUN_GEMM(EpiGlu, g, e, 0); }
            SUB(1) DUP(13) for (int it = F.bid; it < 256; it += F.G) { const int y = it >> 2, h = it & 3;
                for (int pass = 0; pass < 2; ++pass) { const int x = pass ? y : 127 - y, q0 = x * 128, rg = F.wid & 3;
                    attn_unit<192, 128, 128, false>(F.lds, Q + (size_t)q0 * 768 + h * 192, 768, KN + h * 128, 512, KPE, VT + (size_t)(h * 128) * KVPAD, KVPAD,
                                                    (q0 >> 6) + 2, 64 * ((q0 >> 6) + (rg >> 1) + 1), MIX + (size_t)q0 * 1024 + 512 + h * 128, 1024, STMLA + (size_t)h * MTOK + q0, 128); } }
            SUB(2) DUP(14) for (int it = F.G - 1 - F.bid; it < 128; it += F.G) { const int b = it >> 2, h = it & 3, q0 = TP + b * 32, k0 = TP + b * KVS, rg = F.wid & 3;
                attn_unit<192, 128, 128, false>(F.lds, Q + (size_t)q0 * 768 + h * 192, 768, KN + (size_t)k0 * 512 + h * 128, 512, KPE + (size_t)k0 * 64, VT + (size_t)(h * 128) * KVPAD + k0, KVPAD,
                                                17, rg == 0 ? KVS : 0, MIX + (size_t)q0 * 1024 + 512 + h * 128, 1024, STMLA + (size_t)h * MTOK + q0, 32); }
        } }
        if (lo <= 5 && 5 < hi) GSYNC(5)
        if (((PHASE_MASK >> 6) & 1) && lo <= 6 && 6 < hi) DUP(6) { {
            { Gemm g{MIX, (const bf16_t*)(WS + W_WO), MTOK, 1024, 1024};
              LAS float* tab = (LAS float*)(F.lds + 131072);
              EpiRes<0> e{F.a->in[0], F.a->in[1], R, (bf16_t*)(WS + A_R1B), nullptr, nullptr, nullptr, nullptr, ST1, ST1 + 16 * MTOK, tab};
              StaticOrder S_; S_.init(g.M, g.N, F.G, F.bid, 0); Unit u0;
              if (S_.next(0, u0)) wo_fill_tab(u0, STSSM, STMLA, tab);
              if (S_.next(1, u0)) wo_fill_tab(u0, STSSM, STMLA, tab);
              __syncthreads();
              pg8::gemm_phase<EpiRes<0>, StaticOrder, true, true>(F.lds, g, S_, e); }
            if (F.G > 16) { if (F.bid >= 16) cvt_memcache(F, F.bid - 16, F.G - 16); } else cvt_memcache(F, F.bid, F.G);
        } }
        if (lo <= 6 && 6 < hi) GSYNC(6)
        if (((PHASE_MASK >> 7) & 1) && lo <= 7 && 7 < hi) DUP(7) { { Gemm g{(const bf16_t*)(WS + A_R1B), (const bf16_t*)(WS + W_WXQ), MTOK, 1024, 1024};
            EpiLnAct<0> e{(const LAS float*)(F.lds + 131072), (const float*)(WS + W_CSXQ), (const float*)(WS + W_BWXQ), (bf16_t*)(WS + A_XQ), 1024}; RUN_GEMM_LN(EpiLnAct<0>, g, e, ST1, ST1 + 16 * MTOK); } }
        if (lo <= 7 && 7 < hi) GSYNC(7)
        if (((PHASE_MASK >> 8) & 1) && lo <= 8 && 8 < hi) DUP(8) { {
            const bf16_t* XQ = (const bf16_t*)(WS + A_XQ); bf16_t* XO = (bf16_t*)(WS + A_XO);
            for (int it = F.bid; it < 640; it += F.G) {
                if (it < 512) { const int x = it >> 2, h = it & 3, q0 = x * 128;
                    attn_unit<256, 256, 256, true>(F.lds, XQ + (size_t)q0 * 1024 + h * 256, 1024, (const bf16_t*)(WS + W_XK0) + h * 256, 1024, nullptr, (const bf16_t*)(WS + W_XVT0) + (size_t)h * 65536, 256,
                                                   4, 256, XO + (size_t)q0 * 1024 + h * 256, 1024, nullptr, 128); }
                else { const int b = (it - 512) >> 2, h = it & 3, q0 = TP + b * 32, rg = F.wid & 3;
                    attn_unit<256, 256, 256, true>(F.lds, XQ + (size_t)q0 * 1024 + h * 256, 1024, (const bf16_t*)(WS + A_XKS) + (size_t)b * 262144 + h * 256, 1024, nullptr,
                                                   (const bf16_t*)(WS + A_XVTS) + (size_t)(b * 4 + h) * 65536, 256, 4, rg == 0 ? 256 : 0, XO + (size_t)q0 * 1024 + h * 256, 1024, nullptr, 32); } }
        } }
        if (lo <= 8 && 8 < hi) GSYNC(8)
        if (((PHASE_MASK >> 9) & 1) && lo <= 9 && 9 < hi) DUP(9) { { Gemm g{(const bf16_t*)(WS + A_XO), (const bf16_t*)(WS + W_WXO), (F.G >= 80) ? TP : MTOK, 1024, 1024};
            EpiRes<1> e{nullptr, nullptr, R, (bf16_t*)(WS + A_R2B), nullptr, nullptr, F.a->in[32], F.a->in[33], ST2, ST2 + 16 * MTOK, (const LAS float*)(F.lds + 131072)}; RUN_GEMM_LN(EpiRes<1>, g, e, ST1, ST1 + 16 * MTOK); } }
        if (lo <= 9 && 9 < hi) GSYNC(9)
        if (((PHASE_MASK >> 10) & 1) && lo <= 10 && 10 < hi) DUP(10) { {
            LAS float* tab = (LAS float*)(F.lds + 131072); unsigned* cnt = (unsigned*)(WS + W_BAR + 14336);
            if (F.G >= 80 && F.bid >= F.G - 16) { const int u = F.bid - (F.G - 16); const int pm = TP / 256 + (u >> 2);
                if (F.tid < 256) { float mu, rstd; ln_stats16(ST1, ST1 + 16 * MTOK, pm * 256 + F.tid, mu, rstd); tab[F.tid] = mu; tab[256 + F.tid] = rstd; }
                __syncthreads();
                Gemm gx{(const bf16_t*)(WS + A_XO), (const bf16_t*)(WS + W_WXO), MTOK, 1024, 1024}; pg8::OneUnitOrder Sx{pm, u & 3};
                EpiRes<1> ex{nullptr, nullptr, R, (bf16_t*)(WS + A_R2B), nullptr, nullptr, F.a->in[32], F.a->in[33], ST2, ST2 + 16 * MTOK, tab};
                pg8::gemm_phase<EpiRes<1>, pg8::OneUnitOrder, true, true>(F.lds, gx, Sx, ex);
                asm volatile("s_waitcnt vmcnt(0)" ::: "memory"); __syncthreads();
                if (F.tid == 0) { __builtin_amdgcn_fence(__ATOMIC_RELEASE, "agent"); asm volatile("s_waitcnt vmcnt(0)" ::: "memory"); __hip_atomic_fetch_add(cnt, 1u, __ATOMIC_RELAXED, __HIP_MEMORY_SCOPE_AGENT); }
                __syncthreads(); }
            EpiLnAct<1> e{tab, (const float*)(WS + W_CSFF1), (const float*)(WS + W_BWFF1), (bf16_t*)(WS + A_Z), 4096};
            { Gemm g{(const bf16_t*)(WS + A_R2B), (const bf16_t*)(WS + W_WFF1), (F.G >= 80) ? TP : MTOK, 4096, 1024}; RUN_GEMM_LN(EpiLnAct<1>, g, e, ST2, ST2 + 16 * MTOK); }
            if (F.G >= 80 && F.bid < 64) {
                if (F.tid == 0) { unsigned sp = 0; while (__hip_atomic_load(cnt, __ATOMIC_RELAXED, __HIP_MEMORY_SCOPE_AGENT) < 16u) { __builtin_amdgcn_s_sleep(2); if (++sp > (1u << 22)) break; }
                    __builtin_amdgcn_fence(__ATOMIC_ACQUIRE, "agent"); asm volatile("s_waitcnt vmcnt(0)" ::: "memory"); }
                __syncthreads();
                const int pm = TP / 256 + (F.bid >> 4);
                if (F.tid < 256) { float mu, rstd; ln_stats16(ST2, ST2 + 16 * MTOK, pm * 256 + F.tid, mu, rstd); tab[F.tid] = mu; tab[256 + F.tid] = rstd; }
                __syncthreads();
                Gemm gs{(const bf16_t*)(WS + A_R2B), (const bf16_t*)(WS + W_WFF1), MTOK, 4096, 1024}; pg8::OneUnitOrder Ss{pm, F.bid & 15};
                pg8::gemm_phase<EpiLnAct<1>, pg8::OneUnitOrder, true, true>(F.lds, gs, Ss, e); } } }
        if (lo <= 10 && 10 < hi) GSYNC(10)
        if (((PHASE_MASK >> 11) & 1) && lo <= 11 && 11 < hi) DUP(11) { { Gemm g{(const bf16_t*)(WS + A_Z), (const bf16_t*)(WS + W_WFF2), TP, 1024, 4096};
            EpiRes<1> e{nullptr, nullptr, R, nullptr, nullptr, nullptr, F.a->in[32] + 1024, F.a->in[33] + 1024, ST1, ST1 + 16 * MTOK, (const LAS float*)(F.lds + 131072)}; RUN_GEMM_LN(EpiRes<1>, g, e, ST2, ST2 + 16 * MTOK); }
          { Gemm g{(const bf16_t*)(WS + A_Z) + (size_t)TP * 4096, (const bf16_t*)(WS + W_WFF2), TS, 1024, 512, 4096};
            pg8::SplitKOrder S_{16, 4, 8, 512, F.G, F.bid}; EpiSlab e{(float*)(WS + A_R2B)}; pg8::gemm_phase<EpiSlab, pg8::SplitKOrder, true, true>(F.lds, g, S_, e); } }
        if (lo <= 11 && 11 < hi) GSYNC(11)
        if (((PHASE_MASK >> 12) & 1) && lo <= 12 && 12 < hi) DUP(12) { final_ln(F); }
}

#undef WS
#undef U
#undef YG
#undef STSSM
#undef STMLA
#undef ST1
#undef ST2
#undef KN
#undef VT
#undef Q
#undef KPE
#undef MIX
#undef R
extern "C" void kernel_launch(void* const* d_in, const int* in_sizes, int n_in, void* d_out, int out_size, void* d_ws, size_t ws_size, hipStream_t stream) {
    static int grid = 0;
    if (grid == 0) {
        int dev = 0, cus = 0, per_cu = 0;
        (void)hipGetDevice(&dev); (void)hipDeviceGetAttribute(&cus, hipDeviceAttributeMultiprocessorCount, dev);
        if (hipFuncSetAttribute((const void*)fwd_kernel, hipFuncAttributeMaxDynamicSharedMemorySize, LDS_BYTES) != hipSuccess) fprintf(stderr, "kernel_launch: hipFuncSetAttribute failed\n");
        if (hipOccupancyMaxActiveBlocksPerMultiprocessor(&per_cu, (const void*)fwd_kernel, 512, LDS_BYTES) != hipSuccess || per_cu < 1) { fprintf(stderr, "kernel_launch: occupancy query says %d\n", per_cu); per_cu = 1; }
        (void)hipGetLastError();
        grid = cus > 0 ? cus : 256;
        if (n_in != 34 || ws_size < WS_END) fprintf(stderr, "kernel_launch: unexpected n_in %d / ws_size %zu (need %zu)\n", n_in, ws_size, (size_t)WS_END);
    }
    if (hipMemsetAsync((char*)d_ws + W_BAR, 0, BAR_BYTES, stream) != hipSuccess) fprintf(stderr, "kernel_launch: memset failed\n");
    Args a{};
    for (int i = 0; i < 34; ++i) a.in[i] = (const float*)d_in[i];
    a.out = (float*)d_out; a.ws = (unsigned char*)d_ws;
#if N_LAUNCH_MODE == 1
    a.ph_lo = 0; a.ph_hi = NPHASE;
    void* args[] = {&a};
    hipError_t e = hipLaunchCooperativeKernel((const void*)fwd_kernel, dim3(grid), dim3(512), args, LDS_BYTES, stream);
    if (e != hipSuccess) fprintf(stderr, "cooperative launch failed: %s (grid %d)\n", hipGetErrorString(e), grid);
#else
    for (int ph = 0; ph < NPHASE; ++ph) { a.ph_lo = ph; a.ph_hi = ph + 1; hipLaunchKernelGGL(fwd_kernel, dim3(grid), dim3(512), LDS_BYTES, stream, a); }
#endif
}
```

```cpp
#include <hip/hip_runtime.h>
#include <hip/hip_cooperative_groups.h>
#include <cstdio>
#include <cstdint>
namespace cg = cooperative_groups;

#ifndef N_LAUNCH_MODE
#define N_LAUNCH_MODE 1
#endif

#define LAS __attribute__((address_space(3)))
#define PG8_LAS LAS
typedef unsigned short bf16_t;
typedef short bf16x8 __attribute__((ext_vector_type(8)));
typedef float f32x4 __attribute__((ext_vector_type(4)));
typedef float f32x16 __attribute__((ext_vector_type(16)));
typedef unsigned u32x4 __attribute__((ext_vector_type(4)));
typedef unsigned u32x2 __attribute__((ext_vector_type(2)));

constexpr int TP = 16384, TS = 1024, MTOK = TP + TS;
constexpr int DM = 1024, NPAST = 1024, KVS = 1056;
constexpr int KVROWS = TP + 32 * KVS;
constexpr int KVPAD = KVROWS + 64;
constexpr float EPSN = 1e-5f;
constexpr float ALPHA = 1.189207115002721f;
constexpr float LOG2E = 1.4426950408889634f;
constexpr float QSCALE = 0.07216878364870322f * LOG2E;
constexpr float XSCALE = 0.0625f * LOG2E;

constexpr size_t O_Y = 0, O_CKVP = 17825792, O_KPEP = 22020096, O_SREP = 23068672, O_SIMP = 23070720, O_MKP = 23072768,
                 O_MVP = 23334912, O_CKVS = 23597056, O_KPES = 23859200, O_SRES = 23924736, O_SIMS = 23990272;

constexpr size_t MiB = 1u << 20;
constexpr size_t al256(size_t x) { return (x + 255) & ~(size_t)255; }
constexpr size_t W_WIN = 0;
constexpr size_t W_WQ = W_WIN + al256(1280 * 1024 * 2);
constexpr size_t W_WK = W_WQ + al256(768 * 384 * 2);
constexpr size_t W_WV = W_WK + al256(512 * 256 * 2);
constexpr size_t W_WGLU = W_WV + al256(512 * 256 * 2);
constexpr size_t W_WO = W_WGLU + al256(1024 * 512 * 2);
constexpr size_t W_WXQ = W_WO + 2 * MiB;
constexpr size_t W_WXK = W_WXQ + 2 * MiB;
constexpr size_t W_WXV = W_WXK + 2 * MiB;
constexpr size_t W_WXO = W_WXV + 2 * MiB;
constexpr size_t W_WFF1 = W_WXO + 2 * MiB;
constexpr size_t W_WFF2 = W_WFF1 + 8 * MiB;
constexpr size_t W_CSXQ = W_WFF2 + 8 * MiB;
constexpr size_t W_BWXQ = W_CSXQ + 4096;
constexpr size_t W_CSFF1 = W_BWXQ + 4096;
constexpr size_t W_BWFF1 = W_CSFF1 + 16384;
constexpr size_t W_LAM = W_BWFF1 + 16384;
constexpr size_t W_LAM64 = W_LAM + 16384;
constexpr size_t W_BB = W_LAM64 + 16384;
constexpr size_t W_MEMB = W_BB + 2 * 32 * 64 * 16 * 4;
constexpr size_t W_XK0 = W_MEMB + 256 * 1024 * 2;
constexpr size_t W_XVT0 = W_XK0 + 256 * 1024 * 2;
constexpr size_t W_STSSM = W_XVT0 + 256 * 1024 * 2;
constexpr size_t W_STMLA = W_STSSM + al256(16 * MTOK * 4);
constexpr size_t W_ST1 = W_STMLA + al256(4 * MTOK * 4);
constexpr size_t W_ST2 = W_ST1 + al256(32 * MTOK * 4);
constexpr size_t W_SEND = W_ST2 + al256(32 * MTOK * 4);
constexpr size_t W_BAR = W_SEND + 256 * 2 * 2048 * 4;
constexpr size_t BAR_BYTES = 16384;
constexpr size_t W_ACT = (W_BAR + BAR_BYTES + MiB - 1) / MiB * MiB;
constexpr size_t A_KN = W_ACT, A_VT = W_ACT + 50 * MiB, A_Q = W_ACT + 100 * MiB, A_KPE = W_ACT + 126 * MiB, A_CKV = W_ACT + 133 * MiB,
                 A_CQN = W_ACT + 158 * MiB, A_MIX = W_ACT + 171 * MiB, A_PQ = W_ACT, A_XB = W_ACT + 51 * MiB, A_R1B = W_ACT,
                 A_XQ = W_ACT + 34 * MiB, A_XKS = W_ACT + 68 * MiB, A_XVTS = W_ACT + 84 * MiB, A_XO = W_ACT + 101 * MiB,
                 A_R2B = W_ACT + 140 * MiB, A_Z = W_ACT, WS_END = W_ACT + 205 * MiB;
static_assert(WS_END <= 256 * MiB, "workspace");
static_assert((size_t)KVPAD * 512 * 2 <= 50 * MiB && (size_t)MTOK * 768 * 2 <= 26 * MiB && (size_t)KVPAD * 64 * 2 <= 7 * MiB && (size_t)KVPAD * 256 * 2 <= 25 * MiB &&
              (size_t)MTOK * 384 * 2 <= 13 * MiB && (size_t)MTOK * 1024 * 2 <= 34 * MiB && (size_t)MTOK * 768 * 4 <= 51 * MiB && (size_t)MTOK * 4096 * 2 <= 136 * MiB, "regions");

constexpr int LDS_BYTES = 141312 + 64;

__constant__ double c_invrev[32] = {0.15915494309189535,0.11934937021124886,0.089499401608891013,0.067115083005227255,0.050329212104487035,0.037741584717419771,0.028302195830623399,0.02122365276477766,0.015915494309189534,0.011934937021124886,0.0089499401608891024,0.0067115083005227253,0.0050329212104487037,0.0037741584717419772,0.0028302195830623399,0.0021223652764777662,0.0015915494309189536,0.0011934937021124885,0.00089499401608891024,0.0006711508300522726,0.00050329212104487033,0.00037741584717419774,0.00028302195830623395,0.00021223652764777661,0.00015915494309189535,0.00011934937021124886,8.9499401608891018e-05,6.7115083005227254e-05,5.0329212104487035e-05,3.7741584717419777e-05,2.8302195830623396e-05,2.1223652764777659e-05};

__device__ __forceinline__ unsigned cvt_pk_bf16(float lo, float hi) { unsigned r; asm volatile("v_cvt_pk_bf16_f32 %0, %1, %2" : "=v"(r) : "v"(lo), "v"(hi)); return r; }
__device__ __forceinline__ u32x2 pack4(f32x4 v) { u32x2 w; w.x = cvt_pk_bf16(v[0], v[1]); w.y = cvt_pk_bf16(v[2], v[3]); return w; }
__device__ __forceinline__ float bf16_round(float x) { return __uint_as_float(cvt_pk_bf16(x, 0.f) << 16); }
__device__ __forceinline__ void rope_cs(int pos, int i, float& c, float& s) {
    double rev = (double)pos * c_invrev[i]; rev -= __builtin_floor(rev); const float r = (float)rev;
    s = __builtin_amdgcn_sinf(r); c = __builtin_amdgcn_cosf(r);
}
__device__ __forceinline__ int tok_pos(int row) { return row < TP ? row : NPAST + ((row - TP) & 31); }
__device__ __forceinline__ int swap23(int r) { return (r & ~12) | ((r & 4) << 1) | ((r & 8) >> 1); }
__device__ __forceinline__ int tok_kvrow(int row) { return row < TP ? row : TP + ((row - TP) >> 5) * KVS + NPAST + ((row - TP) & 31); }

struct Args { const float* in[34]; float* out; unsigned char* ws; int ph_lo, ph_hi; };
struct Frame {
    const Args* a; float* out; unsigned char* ws; LAS unsigned char* lds;
    int tid, lane, wid, G, bid;
};

namespace pg8 {
constexpr int BM = 256, BK = 64, HALF = 128, HTB = HALF * BK * 2, STAGE_BYTES = 8 * HTB, NXCD = 8, WGM = 8;
__host__ __device__ __forceinline__ int lds_byte(int r, int c) { const int st = (r >> 4) * 2 + (c >> 5), rr = r & 15, cc = c & 31, ob = rr * 64 + cc * 2; return st * 1024 + (ob ^ (((ob >> 9) & 1) << 5)); }
__host__ __device__ __forceinline__ void stage_rc(int b, int& R, int& C) { const int st = b / 1024, sb = b % 1024, swz = sb ^ (((sb >> 9) & 1) << 5); R = (st >> 1) * 16 + swz / 64; C = (st & 1) * 32 + (swz % 64) / 2; }
__host__ __device__ __forceinline__ int perm32(int rho) { const int n = rho >> 4, i = rho & 15; return 8 * (i >> 2) + 4 * n + (i & 3); }
struct Unit { int pm, pn, idx, ko; };
struct Gemm { const bf16_t* A; const bf16_t* Bt; int M, N, K, LD; };
struct StaticOrder {
    int nM, nN, nwg, G, c;
    __device__ __forceinline__ void init(int M, int N, int G_, int c_, int rot) { nM = M / BM; nN = N / BM; nwg = nM * nN; G = G_; c = (c_ + rot) % G_; }
    __device__ __forceinline__ bool next(int i, Unit& u) const {
        const long L = (long)i * G + c; if (L >= nwg) return false;
        int wgid = (int)L; { const int q = nwg / NXCD, r = nwg % NXCD, xcd = wgid % NXCD, off = wgid / NXCD; wgid = (xcd < r ? xcd * (q + 1) : r * (q + 1) + (xcd - r) * q) + off; }
        const int nig = WGM * nN, gid = wgid / nig, fm = gid * WGM, gsz = (nM - fm) < WGM ? (nM - fm) : WGM;
        u.pm = fm + ((wgid % nig) % gsz); u.pn = (wgid % nig) / gsz; u.idx = i; u.ko = 0; return true;
    }
    __device__ __forceinline__ void a_ready(const Unit&) const {}
    __device__ __forceinline__ void done(const Unit&) const {}
};
struct OneUnitOrder {
    int pm, pn;
    __device__ __forceinline__ bool next(int i, Unit& u) const { if (i > 0) return false; u.pm = pm; u.pn = pn; u.idx = 0; u.ko = 0; return true; }
    __device__ __forceinline__ void a_ready(const Unit&) const {}
    __device__ __forceinline__ void done(const Unit&) const {}
};
struct SplitKOrder {
    int nt, nN, ns, ks, G, c;
    __device__ __forceinline__ bool next(int i, Unit& u) const { const int L = i * G + c; if (L >= nt * ns) return false; const int t = L % nt, s = L / nt; u.pm = t / nN; u.pn = t % nN; u.idx = i; u.ko = s * ks; return true; }
    __device__ __forceinline__ void a_ready(const Unit&) const {}
    __device__ __forceinline__ void done(const Unit&) const {}
};
template <class Epi, class Sched, bool ALIGN_EPI = false, bool SP2 = false>
__device__ __forceinline__ void gemm_phase(PG8_LAS unsigned char* lds, const Gemm g, const Sched& S, const Epi& E) {
    const int tid = threadIdx.x, wid = __builtin_amdgcn_readfirstlane(tid >> 6), lane = tid & 63, wr = wid >> 2, wc = wid & 3, fr = lane & 15, fq = lane >> 4;
    int K_ = g.K; asm volatile("" : "+s"(K_)); const int K = K_, nt = K / BK, LD = g.LD ? g.LD : K;
    unsigned voffA[2], voffB[2];
#pragma unroll
    for (int i = 0; i < 2; ++i) { int R, C; stage_rc(tid * 16 + i * 8192, R, C); const int Rb = Epi::PERM ? ((R & ~31) + perm32(R & 31)) : R;
        voffA[i] = (unsigned)(R * LD + C) * 2u; voffB[i] = (unsigned)(Rb * LD + C) * 2u; }
    const size_t kstep = (size_t)(BK * 2);
    const size_t hstep = (size_t)HALF * LD * 2;
    const size_t tstep = 2 * hstep;
    const unsigned ldsw = (unsigned)wid * 1024u;
    const int aoff = lds_byte(wr * 64 + fr, fq * 8), boff = lds_byte(wc * 32 + fr, fq * 8);
#define PG8_SA(b, h) (((b) * 2 + (h)) * HTB)
#define PG8_SB(b, h) ((4 + (b) * 2 + (h)) * HTB)
#define PG8_STAGE(bufoff, gbase, voff) do { _Pragma("unroll") for (int _i = 0; _i < 2; ++_i) \
        __builtin_amdgcn_global_load_lds((const unsigned*)((const char*)(gbase) + (voff)[_i]), (PG8_LAS unsigned*)(lds + (bufoff) + ldsw + _i * 8192), 16, 0, 0); } while (0)
#define PG8_LDA(dst, b, h) do { _Pragma("unroll") for (int m = 0; m < 4; ++m) _Pragma("unroll") for (int k = 0; k < 2; ++k) dst[m][k] = *(const PG8_LAS bf16x8*)(lds + PG8_SA(b, h) + aoff + m * 2048 + k * 1024); } while (0)
#define PG8_LDB(dst, b, h) do { _Pragma("unroll") for (int n = 0; n < 2; ++n) _Pragma("unroll") for (int k = 0; k < 2; ++k) dst[n][k] = *(const PG8_LAS bf16x8*)(lds + PG8_SB(b, h) + boff + n * 2048 + k * 1024); } while (0)
#define PG8_MMA(ai, bj, At, Bt) do { __builtin_amdgcn_s_setprio(1); _Pragma("unroll") for (int m = 0; m < 4; ++m) _Pragma("unroll") for (int n = 0; n < 2; ++n) _Pragma("unroll") for (int k = 0; k < 2; ++k) \
        acc[ai][bj][m][n] = __builtin_amdgcn_mfma_f32_16x16x32_bf16(Bt[n][k], At[m][k], acc[ai][bj][m][n], 0, 0, 0); __builtin_amdgcn_s_setprio(0); } while (0)
#define PG8_WAIT_V(n) asm volatile("s_waitcnt vmcnt(" #n ")" ::: "memory")
#define PG8_WAIT_L(n) asm volatile("s_waitcnt lgkmcnt(" #n ")" ::: "memory")
#define PG8_BAR __builtin_amdgcn_s_barrier()
#define PG8_SCHED __builtin_amdgcn_sched_barrier(0)
    Unit cur, nxt; int ui = 0;
    if (!S.next(0, cur)) return;
    f32x4 acc[2][2][4][2];
#pragma unroll
    for (int a = 0; a < 2; ++a)
#pragma unroll
        for (int b = 0; b < 2; ++b)
#pragma unroll
            for (int m = 0; m < 4; ++m)
#pragma unroll
                for (int n = 0; n < 2; ++n) acc[a][b][m][n] = (f32x4){0.f, 0.f, 0.f, 0.f};
    bf16x8 At[4][2], B0[2][2], B1[2][2];
    const char* cA = (const char*)g.A + (size_t)cur.pm * tstep + (size_t)cur.ko * 2; const char* cB = (const char*)g.Bt + (size_t)cur.pn * tstep + (size_t)cur.ko * 2;
    S.a_ready(cur);
    if constexpr (SP2) {
        PG8_STAGE(PG8_SB(0, 0), cB, voffB); PG8_STAGE(PG8_SB(0, 1), cB + hstep, voffB); PG8_STAGE(PG8_SA(0, 0), cA, voffA); PG8_STAGE(PG8_SA(0, 1), cA + hstep, voffA);
        if (wr == 1) PG8_BAR;
        PG8_WAIT_V(2); PG8_BAR;
        PG8_STAGE(PG8_SB(1, 0), cB + kstep, voffB); PG8_STAGE(PG8_SA(1, 0), cA + kstep, voffA); PG8_STAGE(PG8_SB(1, 1), cB + hstep + kstep, voffB);
        PG8_WAIT_V(6); PG8_BAR;
    } else {
        PG8_STAGE(PG8_SB(0, 0), cB, voffB); PG8_STAGE(PG8_SA(0, 0), cA, voffA); PG8_STAGE(PG8_SB(0, 1), cB + hstep, voffB); PG8_STAGE(PG8_SA(0, 1), cA + hstep, voffA);
        if (wr == 1) PG8_BAR;
        PG8_WAIT_V(4); PG8_BAR;
        PG8_STAGE(PG8_SB(1, 0), cB + kstep, voffB); PG8_STAGE(PG8_SA(1, 0), cA + kstep, voffA); PG8_STAGE(PG8_SB(1, 1), cB + hstep + kstep, voffB);
        PG8_WAIT_V(6); PG8_BAR;
    }
    for (;;) {
        const bool has_next = S.next(ui + 1, nxt);
        const char* nA = has_next ? (const char*)g.A + (size_t)nxt.pm * tstep + (size_t)nxt.ko * 2 : cA; const char* nB = has_next ? (const char*)g.Bt + (size_t)nxt.pn * tstep + (size_t)nxt.ko * 2 : cB;
        for (int t = 0; t < nt; t += 2) {
            const bool last = (t == nt - 2);
            if constexpr (Epi::MIDK) { if (t == (nt >> 1)) E.mid(acc, cur, wr, fr); }
            const char* a1 = cA + (size_t)(t + 1) * kstep;
            const char* a2 = last ? nA : cA + (size_t)(t + 2) * kstep; const char* b2 = last ? nB : cB + (size_t)(t + 2) * kstep;
            const char* a3 = a2 + kstep; const char* b3 = b2 + kstep;
            if (last && has_next) S.a_ready(nxt);
            if constexpr (SP2) {
            PG8_LDB(B0, 0, 0); PG8_LDB(B1, 0, 1); PG8_SCHED; PG8_LDA(At, 0, 0); PG8_STAGE(PG8_SA(1, 1), a1 + hstep, voffA);
            PG8_WAIT_V(8); PG8_WAIT_L(0); PG8_BAR; PG8_MMA(0, 0, At, B0); PG8_MMA(0, 1, At, B1); PG8_BAR; PG8_SCHED;
            PG8_LDA(At, 0, 1); PG8_STAGE(PG8_SB(0, 0), b2, voffB); PG8_STAGE(PG8_SB(0, 1), b2 + hstep, voffB); PG8_STAGE(PG8_SA(0, 0), a2, voffA);
            PG8_WAIT_V(8); PG8_WAIT_L(0); PG8_BAR; PG8_MMA(1, 0, At, B0); PG8_MMA(1, 1, At, B1); PG8_BAR; PG8_SCHED;
            PG8_LDB(B0, 1, 0); PG8_LDB(B1, 1, 1); PG8_SCHED; PG8_LDA(At, 1, 0); PG8_STAGE(PG8_SA(0, 1), a2 + hstep, voffA);
            PG8_WAIT_V(8); PG8_WAIT_L(0); PG8_BAR; PG8_MMA(0, 0, At, B0); PG8_MMA(0, 1, At, B1); PG8_BAR; PG8_SCHED;
            PG8_LDA(At, 1, 1); PG8_STAGE(PG8_SB(1, 0), b3, voffB); PG8_STAGE(PG8_SB(1, 1), b3 + hstep, voffB); PG8_STAGE(PG8_SA(1, 0), a3, voffA);
            PG8_WAIT_V(8); PG8_WAIT_L(0); PG8_BAR; PG8_MMA(1, 0, At, B0); PG8_MMA(1, 1, At, B1); PG8_BAR; PG8_SCHED;
            } else {
            PG8_LDB(B0, 0, 0); PG8_SCHED; PG8_LDA(At, 0, 0); PG8_STAGE(PG8_SA(1, 1), a1 + hstep, voffA);
            PG8_WAIT_L(8); PG8_BAR; PG8_WAIT_L(0); PG8_MMA(0, 0, At, B0); PG8_BAR; PG8_SCHED;
            PG8_LDB(B1, 0, 1); PG8_STAGE(PG8_SB(0, 0), b2, voffB);
            PG8_BAR; PG8_WAIT_L(0); PG8_MMA(0, 1, At, B1); PG8_BAR;
            PG8_LDA(At, 0, 1); PG8_STAGE(PG8_SA(0, 0), a2, voffA);
            PG8_BAR; PG8_WAIT_L(0); PG8_MMA(1, 0, At, B0); PG8_BAR; PG8_SCHED;
            PG8_STAGE(PG8_SB(0, 1), b2 + hstep, voffB);
            PG8_WAIT_V(6); PG8_BAR; PG8_MMA(1, 1, At, B1); PG8_BAR;
            PG8_LDB(B0, 1, 0); PG8_SCHED; PG8_LDA(At, 1, 0); PG8_STAGE(PG8_SA(0, 1), a2 + hstep, voffA);
            PG8_WAIT_L(8); PG8_BAR; PG8_WAIT_L(0); PG8_MMA(0, 0, At, B0); PG8_BAR; PG8_SCHED;
            PG8_LDB(B1, 1, 1); PG8_STAGE(PG8_SB(1, 0), b3, voffB);
            PG8_BAR; PG8_WAIT_L(0); PG8_MMA(0, 1, At, B1); PG8_BAR;
            PG8_LDA(At, 1, 1); PG8_STAGE(PG8_SA(1, 0), a3, voffA);
            PG8_BAR; PG8_WAIT_L(0); PG8_MMA(1, 0, At, B0); PG8_BAR; PG8_SCHED;
            PG8_STAGE(PG8_SB(1, 1), b3 + hstep, voffB);
            PG8_WAIT_V(6); PG8_BAR; PG8_MMA(1, 1, At, B1); PG8_BAR;
            }
        }
        if constexpr (ALIGN_EPI) { if (wr == 0) PG8_BAR; }
        if constexpr (!Epi::AFTER_DRAIN) { E(acc, cur, wr, wc, fr, fq); S.done(cur); }
        if (!has_next) break;
#pragma unroll
        for (int a = 0; a < 2; ++a)
#pragma unroll
            for (int b = 0; b < 2; ++b)
#pragma unroll
                for (int m = 0; m < 4; ++m)
#pragma unroll
                    for (int n = 0; n < 2; ++n) acc[a][b][m][n] = (f32x4){0.f, 0.f, 0.f, 0.f};
        cur = nxt; cA = nA; cB = nB; ++ui;
        if constexpr (ALIGN_EPI) { if (wr == 1) PG8_BAR; }
    }
    PG8_WAIT_V(0);
    if constexpr (!ALIGN_EPI) { if (wr == 0) PG8_BAR; }
    PG8_BAR;
    if constexpr (Epi::AFTER_DRAIN) { E.fused(acc, cur, wr, wc, fr, fq, lds, wid, lane); S.done(cur); }
#undef PG8_SA
#undef PG8_SB
#undef PG8_STAGE
#undef PG8_LDA
#undef PG8_LDB
#undef PG8_MMA
#undef PG8_WAIT_V
#undef PG8_WAIT_L
#undef PG8_BAR
#undef PG8_SCHED
}
}
using pg8::Unit;
typedef f32x4 Acc[2][2][4][2];
#define EPI_ROWS _Pragma("unroll") for (int ai = 0; ai < 2; ++ai) _Pragma("unroll") for (int m = 0; m < 4; ++m)
#define EPI_COLS _Pragma("unroll") for (int bj = 0; bj < 2; ++bj) _Pragma("unroll") for (int n = 0; n < 2; ++n)

struct EpiProj {
    static constexpr bool PERM = false, AFTER_DRAIN = false, MIDK = false;
    float* U; float* PQ;
    __device__ __forceinline__ void operator()(const Acc& acc, const Unit& u, int wr, int wc, int fr, int fq) const {
        const bool isu = u.pn < 2; float* base = isu ? U : PQ; const int ld = isu ? 512 : 768; const int c0 = (isu ? u.pn : u.pn - 2) * 256 + wc * 32 + 4 * fq;
        EPI_ROWS { const int row = u.pm * 256 + ai * 128 + wr * 64 + m * 16 + fr; float* rp = base + (size_t)row * ld + c0;
            EPI_COLS *(f32x4*)(rp + bj * 128 + n * 16) = acc[ai][bj][m][n]; }
    }
};
struct EpiSlab {
    static constexpr bool PERM = false, AFTER_DRAIN = false, MIDK = false;
    float* S;
    __device__ __forceinline__ void operator()(const Acc& acc, const Unit& u, int wr, int wc, int fr, int fq) const {
        float* base = S + (size_t)(u.ko >> 9) * 1024 * 1024 + u.pn * 256 + wc * 32 + 4 * fq;
        EPI_ROWS { const int row = u.pm * 256 + ai * 128 + wr * 64 + m * 16 + fr;
            EPI_COLS *(f32x4*)(base + (size_t)row * 1024 + bj * 128 + n * 16) = acc[ai][bj][m][n]; }
    }
};
template <bool VT> struct EpiStore {
    static constexpr bool PERM = !VT, AFTER_DRAIN = false, MIDK = false;
    bf16_t* O; int ldc; float* F32; int ldf; float* F32T; int ldt; int rowswap;
    __device__ __forceinline__ void operator()(const Acc& acc, const Unit& u, int wr, int wc, int fr, int fq) const {
        if constexpr (VT) { const int sw = ((fq & 1) << 1) | (fq >> 1);
            EPI_ROWS { const int row = u.pm * 256 + ai * 128 + wr * 64 + m * 16 + fr;
                EPI_COLS { const int cb = u.pn * 256 + bj * 128 + wc * 32 + n * 16; const f32x4 v = acc[ai][bj][m][n];
                    *(u32x2*)(O + (size_t)row * ldc + cb + 4 * sw) = pack4(v);
                    if (F32) *(f32x4*)(F32 + (size_t)row * ldf + cb + 4 * fq) = v;
                    if (F32T) { _Pragma("unroll") for (int j = 0; j < 4; ++j) F32T[(size_t)(cb + 4 * fq + j) * ldt + row] = v[j]; } } }
        } else {
            EPI_ROWS { const int row = u.pm * 256 + ai * 128 + wr * 64 + m * 16 + fr;
                _Pragma("unroll") for (int bj = 0; bj < 2; ++bj) { const int cb = u.pn * 256 + bj * 128 + wc * 32 + 8 * fq; const f32x4 v0 = acc[ai][bj][m][0], v1 = acc[ai][bj][m][1];
                    const u32x2 h0 = pack4(v0), h1 = pack4(v1); u32x4 w; w.x = h0.x; w.y = h0.y; w.z = h1.x; w.w = h1.y;
                    *(u32x4*)(O + (size_t)(rowswap ? swap23(row) : row) * ldc + cb) = w;
                    if (F32) { *(f32x4*)(F32 + (size_t)row * ldf + cb) = v0; *(f32x4*)(F32 + (size_t)row * ldf + cb + 4) = v1; }
                    if (F32T) { _Pragma("unroll") for (int j = 0; j < 4; ++j) { F32T[(size_t)(cb + j) * ldt + row] = v0[j]; F32T[(size_t)(cb + 4 + j) * ldt + row] = v1[j]; } } } }
        }
    }
};
struct EpiQ {
    static constexpr bool PERM = false, AFTER_DRAIN = false, MIDK = false;
    bf16_t* Q;
    __device__ __forceinline__ void operator()(const Acc& acc, const Unit& u, int wr, int wc, int fr, int fq) const {
        EPI_ROWS { const int row = u.pm * 256 + ai * 128 + wr * 64 + m * 16 + fr; bf16_t* qp = Q + (size_t)row * 768;
            if (u.pn < 2) { EPI_COLS { const int h = 2 * u.pn + bj, d = wc * 32 + n * 16 + 4 * fq; *(u32x2*)(qp + h * 192 + d) = pack4(acc[ai][bj][m][n] * QSCALE); } }
            else { const int pos = tok_pos(row);
                _Pragma("unroll") for (int n = 0; n < 2; ++n) { f32x4 o1, o2;
                    _Pragma("unroll") for (int j = 0; j < 4; ++j) { float c, s; rope_cs(pos, n * 16 + 4 * fq + j, c, s); const float x1 = acc[ai][0][m][n][j], x2 = acc[ai][1][m][n][j];
                        o1[j] = (x1 * c - x2 * s) * QSCALE; o2[j] = (x2 * c + x1 * s) * QSCALE; }
                    *(u32x2*)(qp + wc * 192 + 128 + n * 16 + 4 * fq) = pack4(o1); *(u32x2*)(qp + wc * 192 + 160 + n * 16 + 4 * fq) = pack4(o2); } }
        }
    }
};
struct EpiGlu {
    static constexpr bool PERM = true, AFTER_DRAIN = false, MIDK = false;
    bf16_t* MIX; float* ST;
    __device__ __forceinline__ void operator()(const Acc& acc, const Unit& u, int wr, int wc, int fr, int fq) const {
        EPI_ROWS { const int row = u.pm * 256 + ai * 128 + wr * 64 + m * 16 + fr; float q = 0.f; u32x2 h[2];
            _Pragma("unroll") for (int n = 0; n < 2; ++n) { const f32x4 v = acc[ai][0][m][n], g = acc[ai][1][m][n]; f32x4 o;
                _Pragma("unroll") for (int j = 0; j < 4; ++j) { o[j] = v[j] * __builtin_amdgcn_rcpf(1.f + __builtin_amdgcn_exp2f(-g[j] * LOG2E)); q += o[j] * o[j]; }
                h[n] = pack4(o); }
            u32x4 w; w.x = h[0].x; w.y = h[0].y; w.z = h[1].x; w.w = h[1].y;
            *(u32x4*)(MIX + (size_t)row * 1024 + u.pn * 128 + wc * 32 + 8 * fq) = w;
            q += __shfl_xor(q, 16); q += __shfl_xor(q, 32);
            if (fq == 0) ST[(size_t)(u.pn * 4 + wc) * MTOK + row] = q; }
    }
};
__device__ __forceinline__ void ln_stats16(const float* PS, const float* PQ, int row, float& mu, float& rstd) {
    float s = 0.f, q = 0.f;
#pragma unroll
    for (int i = 0; i < 16; ++i) { s += PS[(size_t)i * MTOK + row]; q += PQ[(size_t)i * MTOK + row]; }
    mu = s * (1.f / 1024.f); const float var = q * (1.f / 1024.f) - mu * mu; rstd = rsqrtf(var + EPSN);
}
template <int MODE> struct EpiRes {
    static constexpr bool PERM = true, AFTER_DRAIN = false, MIDK = (MODE == 0);
    const float* xp; const float* xs; float* R; bf16_t* Rb; const float* PSin; const float* PQin; const float* g; const float* b; float* PSout; float* PQout; const LAS float* tab;
    __device__ __forceinline__ void mid(Acc& acc, const Unit& u, int wr, int fr) const {
        EPI_ROWS { const float ratio = tab[(u.idx & 1) * 512 + ai * 128 + wr * 64 + m * 16 + fr];
            EPI_COLS acc[ai][bj][m][n] *= ratio; }
    }
    __device__ __forceinline__ void operator()(const Acc& acc, const Unit& u, int wr, int wc, int fr, int fq) const {
        const int c0 = u.pn * 256 + wc * 32 + 8 * fq;
        EPI_ROWS { const int row = u.pm * 256 + ai * 128 + wr * 64 + m * 16 + fr; float rowscale = 1.f, mu = 0.f, rstd = 1.f;
            if (MODE == 0) rowscale = tab[(u.idx & 1) * 512 + 256 + ai * 128 + wr * 64 + m * 16 + fr]; else { mu = tab[u.idx * 512 + ai * 128 + wr * 64 + m * 16 + fr]; rstd = tab[u.idx * 512 + 256 + ai * 128 + wr * 64 + m * 16 + fr]; }
            const float* rsrc = MODE == 0 ? (row < TP ? xp + (size_t)row * 1024 : xs + (size_t)(row - TP) * 1024) : R + (size_t)row * 1024;
            float s = 0.f, q = 0.f;
            EPI_COLS { const int col = c0 + bj * 128 + n * 4; f32x4 res = *(const f32x4*)(rsrc + col);
                if (MODE == 1) { const f32x4 g4 = *(const f32x4*)(g + col), b4 = *(const f32x4*)(b + col); res = (res - mu) * rstd * g4 + b4; }
                const f32x4 v = res * ALPHA + acc[ai][bj][m][n] * rowscale;
                s += (v[0] + v[1]) + (v[2] + v[3]); q += (v[0] * v[0] + v[1] * v[1]) + (v[2] * v[2] + v[3] * v[3]);
                *(f32x4*)(R + (size_t)row * 1024 + col) = v;
                if (Rb) *(u32x2*)(Rb + (size_t)row * 1024 + col) = pack4(v); }
            s += __shfl_xor(s, 16); s += __shfl_xor(s, 32); q += __shfl_xor(q, 16); q += __shfl_xor(q, 32);
            if (fq == 0) { PSout[(size_t)(u.pn * 4 + wc) * MTOK + row] = s; PQout[(size_t)(u.pn * 4 + wc) * MTOK + row] = q; } }
    }
};
template <int ACT> struct EpiLnAct {
    static constexpr bool PERM = true, AFTER_DRAIN = false, MIDK = false;
    const LAS float* tab; const float* cs; const float* bw; bf16_t* O; int ldc;
    __device__ __forceinline__ void operator()(const Acc& acc, const Unit& u, int wr, int wc, int fr, int fq) const {
        const int c0 = u.pn * 256 + wc * 32 + 8 * fq; f32x4 cs4[2][2], bw4[2][2];
        EPI_COLS { cs4[bj][n] = *(const f32x4*)(cs + c0 + bj * 128 + n * 4); bw4[bj][n] = *(const f32x4*)(bw + c0 + bj * 128 + n * 4); }
        EPI_ROWS { const int row = u.pm * 256 + ai * 128 + wr * 64 + m * 16 + fr; const float mu = tab[u.idx * 512 + ai * 128 + wr * 64 + m * 16 + fr], rstd = tab[u.idx * 512 + 256 + ai * 128 + wr * 64 + m * 16 + fr];
            _Pragma("unroll") for (int bj = 0; bj < 2; ++bj) { u32x2 h[2];
                _Pragma("unroll") for (int n = 0; n < 2; ++n) { f32x4 v = (acc[ai][bj][m][n] - cs4[bj][n] * mu) * rstd + bw4[bj][n];
                    if (ACT == 0) v = v * XSCALE; else { _Pragma("unroll") for (int j = 0; j < 4; ++j) { const float r = fmaxf(v[j], 0.f); v[j] = r * r; } }
                    h[n] = pack4(v); }
                u32x4 w; w.x = h[0].x; w.y = h[0].y; w.z = h[1].x; w.w = h[1].y;
                *(u32x4*)(O + (size_t)row * ldc + c0 + bj * 128) = w; } }
    }
};

__device__ __forceinline__ void wo_fill_tab(const Unit& u, const float* STssm, const float* STmla, LAS float* tab) {
    const int t = threadIdx.x;
    if (t < 256) { const int row = u.pm * 256 + t; float s1 = 0.f, s2 = 0.f;
#pragma unroll
        for (int i = 0; i < 16; ++i) s1 += STssm[(size_t)i * MTOK + row];
#pragma unroll
        for (int i = 0; i < 4; ++i) s2 += STmla[(size_t)i * MTOK + row];
        const float r1 = rsqrtf(s1 * (1.f / 512.f) + EPSN), r2 = rsqrtf(s2 * (1.f / 512.f) + EPSN);
        tab[(u.idx & 1) * 512 + t] = r1 / r2; tab[(u.idx & 1) * 512 + 256 + t] = r2; }
}

__device__ __forceinline__ void ln_fill_tab(const pg8::StaticOrder& S, const float* PS, const float* PQ, LAS float* tab) {
    const int t = threadIdx.x; Unit u;
    if (t < 256) {
#pragma unroll 1
        for (int i = 0; i < 5; ++i) if (S.next(i, u)) { float mu, rstd; ln_stats16(PS, PQ, u.pm * 256 + t, mu, rstd); tab[i * 512 + t] = mu; tab[i * 512 + 256 + t] = rstd; } }
    __syncthreads();
}

template <int DQK, int DKN, int DV, bool SPLITDV>
__device__ __forceinline__ void attn_unit(LAS unsigned char* lds, const bf16_t* Qp, int ldq, const bf16_t* Kn, int ldkn, const bf16_t* Kpe, const bf16_t* Vt, int ldvt,
                                          int ntiles, int kvlim, bf16_t* Op, int ldo, float* statp, int nrows) {
    constexpr int NS = DQK / 16, KROWB = DQK * 2 + 16, VROWB = 144, KTILE = 64 * KROWB, VTILE = DV * VROWB, STAGE = KTILE + VTILE;
    constexpr int CPR = DQK / 8, KCH = 64 * CPR / 512, VCH = DV * 8 / 512, NKH = SPLITDV ? 2 : 1, NDB = 4;
    static_assert((SPLITDV ? DV / 64 : DV / 32) == NDB, "value tiling");
    int tid_ = threadIdx.x; asm volatile("" : "+v"(tid_));
    const int tid = tid_, wid = __builtin_amdgcn_readfirstlane(tid >> 6), lane = tid & 63, r32 = lane & 31, hi = lane >> 5, rg = wid & 3, grp = wid >> 2;
    const int keyoff = SPLITDV ? 0 : 32 * grp, dbase = SPLITDV ? grp * (DV / 2) : 0;
    const bool wact = kvlim > 0;
    bf16x8 qf[NS];
    { const bf16_t* qrow = Qp + (size_t)(rg * 32 + r32) * ldq + hi * 8;
#pragma unroll
      for (int s = 0; s < NS; ++s) qf[s] = wact ? *(const bf16x8*)(qrow + 16 * s) : (bf16x8){0, 0, 0, 0, 0, 0, 0, 0}; }
    constexpr bool KREG = (CPR == 32) && (DKN == DQK);
    const bf16_t* kp[KREG ? 1 : KCH]; int kst[KREG ? 1 : KCH], kld[KREG ? 1 : KCH];
    if constexpr (KREG) { const int row = tid >> 5, cc = tid & 31; kp[0] = Kn + (size_t)row * ldkn + cc * 8; kst[0] = 64 * ldkn; kld[0] = row * KROWB + cc * 16; }
    else {
#pragma unroll
        for (int i = 0; i < KCH; ++i) { const int c = tid + 512 * i, row = c / CPR, cc = c - row * CPR;
            if (cc < DKN / 8) { kp[i] = Kn + (size_t)row * ldkn + cc * 8; kst[i] = 64 * ldkn; } else { kp[i] = Kpe + (size_t)row * 64 + (cc - DKN / 8) * 8; kst[i] = 64 * 64; }
            kld[i] = row * KROWB + cc * 16; } }
    const bf16_t* vp0 = Vt + (size_t)(tid >> 3) * ldvt + (tid & 7) * 8; const int vld0 = KTILE + (tid >> 3) * VROWB + (tid & 7) * 16;
#define KP(i) (KREG ? kp[0] + (size_t)(i) * 16 * ldkn : kp[KREG ? 0 : (i)])
#define KST(i) kst[KREG ? 0 : (i)]
#define KLD(i) (KREG ? kld[0] + (i) * 16 * KROWB : kld[KREG ? 0 : (i)])
    u32x4 sk[KCH], sv[VCH];
#define AT_ISSUE_K(t) do { _Pragma("unroll") for (int i = 0; i < KCH; ++i) sk[i] = *(const u32x4*)(KP(i) + (size_t)(t) * KST(i)); } while (0)
#define AT_ISSUE_V(t) do { _Pragma("unroll") for (int i = 0; i < VCH; ++i) sv[i] = *(const u32x4*)(vp0 + (size_t)(i) * 64 * ldvt + (size_t)(t) * 64); } while (0)
#define AT_ISSUE(t) do { AT_ISSUE_K(t); AT_ISSUE_V(t); } while (0)
#define AT_WRITE(st) do { _Pragma("unroll") for (int i = 0; i < KCH; ++i) *(LAS u32x4*)(lds + (st) * STAGE + KLD(i)) = sk[i]; \
                          _Pragma("unroll") for (int i = 0; i < VCH; ++i) *(LAS u32x4*)(lds + (st) * STAGE + vld0 + (i) * 64 * VROWB) = sv[i]; } while (0)
    f32x16 o[NDB];
#pragma unroll
    for (int d = 0; d < NDB; ++d)
#pragma unroll
        for (int r = 0; r < 16; ++r) o[d][r] = 0.f;
    float mrun = -1e30f, lrun = 0.f;
    const int kboff = (keyoff + r32) * KROWB + hi * 16, vboff = KTILE + (dbase + r32) * VROWB + keyoff * 2 + hi * 16;
    AT_ISSUE(0); AT_WRITE(0); __syncthreads();
    if (!SPLITDV && ntiles > 1) AT_ISSUE(1);
    for (int t = 0; t < ntiles; ++t) {
        const int st = t & 1;
        if (SPLITDV) { if (t + 1 < ntiles) AT_ISSUE_K(t + 1); }
        else if (grp == 1) { if (t + 1 < ntiles) AT_WRITE(st ^ 1); if (t + 2 < ntiles) AT_ISSUE(t + 2); }
        if (t * 64 + keyoff < kvlim) {
            f32x16 p[NKH];
            const LAS unsigned char* kb = lds + st * STAGE + kboff;
#pragma unroll
            for (int kh = 0; kh < NKH; ++kh) {
#pragma unroll
                for (int r = 0; r < 16; ++r) p[kh][r] = 0.f;
#pragma unroll
                for (int s = 0; s < NS; ++s) { const bf16x8 kf = *(const LAS bf16x8*)(kb + kh * 32 * KROWB + s * 32); p[kh] = __builtin_amdgcn_mfma_f32_32x32x16_bf16(kf, qf[s], p[kh], 0, 0, 0); }
            }
            float tmax = p[0][0];
#pragma unroll
            for (int kh = 0; kh < NKH; ++kh)
#pragma unroll
                for (int r = 0; r < 16; ++r) tmax = fmaxf(tmax, p[kh][r]);
            { auto rr = __builtin_amdgcn_permlane32_swap(__float_as_uint(tmax), __float_as_uint(tmax), false, false); tmax = fmaxf(__uint_as_float(rr[0]), __uint_as_float(rr[1])); }
            const float mnew = fmaxf(mrun, tmax);
            if (__any(mnew > mrun)) { const float alpha = __builtin_amdgcn_exp2f(mrun - mnew); lrun *= alpha; mrun = mnew;
#pragma unroll
                for (int d = 0; d < NDB; ++d)
#pragma unroll
                    for (int r = 0; r < 16; ++r) o[d][r] *= alpha; }
            float ls = 0.f;
#pragma unroll
            for (int kh = 0; kh < NKH; ++kh)
#pragma unroll
                for (int r = 0; r < 16; ++r) { p[kh][r] = __builtin_amdgcn_exp2f(p[kh][r] - mrun); ls += p[kh][r]; }
            lrun += ls;
            bf16x8 pf[NKH * 2];
#pragma unroll
            for (int kh = 0; kh < NKH; ++kh)
#pragma unroll
                for (int s2 = 0; s2 < 2; ++s2) { u32x4 w; w.x = cvt_pk_bf16(p[kh][8 * s2 + 0], p[kh][8 * s2 + 1]); w.y = cvt_pk_bf16(p[kh][8 * s2 + 2], p[kh][8 * s2 + 3]);
                    w.z = cvt_pk_bf16(p[kh][8 * s2 + 4], p[kh][8 * s2 + 5]); w.w = cvt_pk_bf16(p[kh][8 * s2 + 6], p[kh][8 * s2 + 7]); pf[kh * 2 + s2] = *(bf16x8*)&w; }
            if (SPLITDV && t + 1 < ntiles) AT_ISSUE_V(t + 1);
            const LAS unsigned char* vb = lds + st * STAGE + vboff;
#pragma unroll
            for (int d = 0; d < NDB; ++d)
#pragma unroll
                for (int ks = 0; ks < NKH * 2; ++ks) { const bf16x8 vf = *(const LAS bf16x8*)(vb + d * 32 * VROWB + ks * 32); o[d] = __builtin_amdgcn_mfma_f32_32x32x16_bf16(vf, pf[ks], o[d], 0, 0, 0); }
        } else if (SPLITDV && t + 1 < ntiles) AT_ISSUE_V(t + 1);
        if (SPLITDV && t + 1 < ntiles) AT_WRITE(st ^ 1);
        if (!SPLITDV && grp == 0) { if (t + 1 < ntiles) AT_WRITE(st ^ 1); if (t + 2 < ntiles) AT_ISSUE(t + 2); }
        __syncthreads();
    }
#undef AT_ISSUE
#undef AT_ISSUE_K
#undef AT_ISSUE_V
#undef KP
#undef KST
#undef KLD
#undef AT_WRITE
    lrun += __shfl_xor(lrun, 32);
    if (!SPLITDV) {
        LAS float* MO = (LAS float*)lds; LAS float* MM = (LAS float*)(lds + 65536); LAS float* ML = (LAS float*)(lds + 65536 + 1024);
        if (grp == 1) {
#pragma unroll
            for (int d = 0; d < NDB; ++d)
#pragma unroll
                for (int r = 0; r < 16; ++r) MO[(rg * 64 + d * 16 + r) * 64 + lane] = o[d][r];
            MM[rg * 64 + lane] = mrun; ML[rg * 64 + lane] = lrun;
        }
        __syncthreads();
        if (grp == 0) {
            const float m1 = MM[rg * 64 + lane], l1 = ML[rg * 64 + lane], ms = fmaxf(mrun, m1);
            const float a0 = __builtin_amdgcn_exp2f(mrun - ms), a1 = __builtin_amdgcn_exp2f(m1 - ms);
            lrun = lrun * a0 + l1 * a1;
#pragma unroll
            for (int d = 0; d < NDB; ++d)
#pragma unroll
                for (int r = 0; r < 16; ++r) o[d][r] = o[d][r] * a0 + MO[(rg * 64 + d * 16 + r) * 64 + lane] * a1;
        }
    }
    if (SPLITDV || grp == 0) {
        const float inv = __builtin_amdgcn_rcpf(lrun); const int row = rg * 32 + r32; const bool ok = wact && row < nrows; float ss = 0.f;
        bf16_t* orow = Op + (size_t)row * ldo + dbase + 4 * hi;
#pragma unroll
        for (int d = 0; d < NDB; ++d)
#pragma unroll
            for (int g4 = 0; g4 < 4; ++g4) { f32x4 v; v[0] = o[d][4 * g4] * inv; v[1] = o[d][4 * g4 + 1] * inv; v[2] = o[d][4 * g4 + 2] * inv; v[3] = o[d][4 * g4 + 3] * inv;
                ss += (v[0] * v[0] + v[1] * v[1]) + (v[2] * v[2] + v[3] * v[3]);
                if (ok) *(u32x2*)(orow + 32 * d + 8 * g4) = pack4(v); }
        ss += __shfl_xor(ss, 32);
        if (statp && ok && hi == 0) statp[row] = ss;
    }
    __syncthreads();
}


__device__ __forceinline__ float gelu_tanh(float x) { const float z2 = 1.5957691216057308f * (x + 0.044715f * x * x * x); return x * __builtin_amdgcn_rcpf(1.f + __builtin_amdgcn_exp2f(-z2 * LOG2E)); }
struct SsmU { bf16x8 hi, lo; };
__device__ __forceinline__ void split_hilo(f32x4 a, f32x4 b, u32x4& hi, u32x4& lo) {
    hi.x = cvt_pk_bf16(a[0], a[1]); hi.y = cvt_pk_bf16(a[2], a[3]); hi.z = cvt_pk_bf16(b[0], b[1]); hi.w = cvt_pk_bf16(b[2], b[3]);
    lo.x = cvt_pk_bf16(a[0] - __uint_as_float(hi.x << 16), a[1] - __uint_as_float(hi.x & 0xffff0000u)); lo.y = cvt_pk_bf16(a[2] - __uint_as_float(hi.y << 16), a[3] - __uint_as_float(hi.y & 0xffff0000u));
    lo.z = cvt_pk_bf16(b[0] - __uint_as_float(hi.z << 16), b[1] - __uint_as_float(hi.z & 0xffff0000u)); lo.w = cvt_pk_bf16(b[2] - __uint_as_float(hi.w << 16), b[3] - __uint_as_float(hi.w & 0xffff0000u));
}
struct SsmW { float lr, li; bf16x8 ab[8]; };
__device__ __forceinline__ void ssm_load_w(const Frame& F, int g, int lane, SsmW& w) {
    const float* LAM = (const float*)(F.ws + W_LAM); const float* BB = (const float*)(F.ws + W_BB);
    w.lr = LAM[g * 64 + lane]; w.li = LAM[2048 + g * 64 + lane];
    const int q = lane >> 4;
#pragma unroll
    for (int blk = 0; blk < 8; ++blk) { const int row = 16 * blk + (lane & 15);
        const float* bp = (row < 64 ? BB + (size_t)(g * 64 + row) * 16 : BB + 32768 + (size_t)(g * 64 + row - 64) * 16) + 8 * (q & 1);
        u32x4 hi, lo; split_hilo(*(const f32x4*)bp, *(const f32x4*)(bp + 4), hi, lo); const u32x4 sel = q < 2 ? hi : lo; w.ab[blk] = *(const bf16x8*)&sel; }
}
__device__ __forceinline__ void ssm_load_u(const float* U, int tb, int g, int lane, SsmU& ub) {
    const int q = lane >> 4; const float* up = U + (size_t)(tb + (lane & 15)) * 512 + g * 16 + 8 * (q & 1);
    u32x4 hi, lo; split_hilo(*(const f32x4*)up, *(const f32x4*)(up + 4), hi, lo); if (q >= 2) lo = (u32x4){0u, 0u, 0u, 0u};
    ub.hi = *(const bf16x8*)&hi; ub.lo = *(const bf16x8*)&lo;
}
template <bool WR> __device__ __forceinline__ void ssm_block16(const SsmW& w, const SsmU& ub, int lane, float& xr, float& xi, LAS float* XW) {
#pragma unroll
    for (int blk = 0; blk < 8; ++blk) { f32x4 d = {0.f, 0.f, 0.f, 0.f};
        d = __builtin_amdgcn_mfma_f32_16x16x32_bf16(w.ab[blk], ub.hi, d, 0, 0, 0); d = __builtin_amdgcn_mfma_f32_16x16x32_bf16(w.ab[blk], ub.lo, d, 0, 0, 0);
        *(LAS f32x4*)(XW + (lane & 15) * 132 + 16 * blk + 4 * (lane >> 4)) = d; }
    float br[16], bi[16];
#pragma unroll
    for (int t = 0; t < 16; ++t) { br[t] = XW[t * 132 + lane]; bi[t] = XW[t * 132 + 64 + lane]; }
#pragma unroll
    for (int t = 0; t < 16; ++t) { const float nr = fmaf(w.lr, xr, fmaf(-w.li, xi, br[t])), ni = fmaf(w.lr, xi, fmaf(w.li, xr, bi[t])); xr = nr; xi = ni;
        if (WR) { XW[t * 132 + lane] = xr; XW[t * 132 + 64 + lane] = xi; } }
}
__device__ __forceinline__ void ssm_pass_a(const Frame& F) {
    const float* U = F.out; float* SEND = (float*)(F.ws + W_SEND); LAS float* XW = (LAS float*)(F.lds + F.wid * 8448);
    const int g = (F.bid * 8 + F.wid) & 31, p = F.lane; SsmW w; ssm_load_w(F, g, p, w);
    for (int it = F.bid * 8 + F.wid; it < 256 * 32; it += F.G * 8) { const int c = it >> 5;
        float xr = 0.f, xi = 0.f;
        SsmU ub[4];
#pragma unroll
        for (int sb = 0; sb < 4; ++sb) ssm_load_u(U, c * 64 + sb * 16, g, p, ub[sb]);
#pragma unroll
        for (int sb = 0; sb < 4; ++sb) ssm_block16<false>(w, ub[sb], p, xr, xi, XW);
        SEND[(size_t)c * 4096 + g * 64 + p] = xr; SEND[(size_t)c * 4096 + 2048 + g * 64 + p] = xi; }
}
__device__ __forceinline__ void ssm_pass_b(const Frame& F, int b0) {
    float* SEND = (float*)(F.ws + W_SEND); const float* LAM64 = (const float*)(F.ws + W_LAM64);
    const int i = b0 * 512 + F.tid; if (i < 0 || i >= 2048) return;
    const float l6r = LAM64[i], l6i = LAM64[2048 + i]; float xr = 0.f, xi = 0.f;
    float nr_[16], ni_[16];
#pragma unroll
    for (int j = 0; j < 16; ++j) { nr_[j] = SEND[(size_t)j * 4096 + i]; ni_[j] = SEND[(size_t)j * 4096 + 2048 + i]; }
    for (int c0 = 0; c0 < 256; c0 += 16) { float sr[16], si[16];
#pragma unroll
        for (int j = 0; j < 16; ++j) { sr[j] = nr_[j]; si[j] = ni_[j]; }
        if (c0 + 16 < 256) {
#pragma unroll
            for (int j = 0; j < 16; ++j) { nr_[j] = SEND[(size_t)(c0 + 16 + j) * 4096 + i]; ni_[j] = SEND[(size_t)(c0 + 16 + j) * 4096 + 2048 + i]; } }
#pragma unroll
        for (int j = 0; j < 16; ++j) { SEND[(size_t)(c0 + j) * 4096 + i] = xr; SEND[(size_t)(c0 + j) * 4096 + 2048 + i] = xi;
            const float nr = fmaf(l6r, xr, fmaf(-l6i, xi, sr[j])), ni = fmaf(l6r, xi, fmaf(l6i, xr, si[j])); xr = nr; xi = ni; } }
}
__device__ __forceinline__ void ssm_pass_c(const Frame& F) {
    const float* U = F.out; bf16_t* YG = (bf16_t*)((unsigned char*)F.out + 36 * MiB); const float* SEND = (const float*)(F.ws + W_SEND);
    const float* c_re = F.a->in[18]; const float* c_im = F.a->in[19]; const float* dsk = F.a->in[20];
    LAS float* XW = (LAS float*)(F.lds + F.wid * 8448);
    const int p = F.lane, hq = 4 * (F.lane >> 4), tl = F.lane & 15;
    const int g = (F.bid * 8 + F.wid) & 31; SsmW w; ssm_load_w(F, g, p, w);
    bf16x8 cab[4];
#pragma unroll
    for (int ks = 0; ks < 4; ++ks) { const int k = 32 * ks + 8 * (F.lane >> 4); const float* cp = ks < 2 ? c_re + (size_t)(g * 16 + tl) * 64 + k : c_im + (size_t)(g * 16 + tl) * 64 + (k - 64);
        f32x4 a = *(const f32x4*)cp, b = *(const f32x4*)(cp + 4); if (ks >= 2) { a = -a; b = -b; }
        u32x4 w; w.x = cvt_pk_bf16(a[0], a[1]); w.y = cvt_pk_bf16(a[2], a[3]); w.z = cvt_pk_bf16(b[0], b[1]); w.w = cvt_pk_bf16(b[2], b[3]); cab[ks] = *(bf16x8*)&w; }
    const f32x4 ds4 = *(const f32x4*)(dsk + g * 16 + hq);
    for (int it = F.bid * 8 + F.wid; it < 9216; it += F.G * 8) {
        const bool prompt = it < 8192; const int c = prompt ? (it >> 5) : ((it - 8192) >> 5);
        float xr, xi; int tok0, nsb;
        if (prompt) { xr = SEND[(size_t)c * 4096 + g * 64 + p]; xi = SEND[(size_t)c * 4096 + 2048 + g * 64 + p];
            tok0 = c * 64; nsb = 4;
        } else { xr = F.a->in[5][(size_t)(c * 32 + g) * 64 + p]; xi = F.a->in[6][(size_t)(c * 32 + g) * 64 + p]; tok0 = TP + c * 32; nsb = 2; }
        SsmU ub[4]; f32x4 u4a[4];
#pragma unroll
        for (int sb = 0; sb < 4; ++sb) { ssm_load_u(U, tok0 + sb * 16, g, p, ub[sb]); u4a[sb] = *(const f32x4*)(U + (size_t)(tok0 + sb * 16 + tl) * 512 + g * 16 + hq); }
#pragma unroll
        for (int sb = 0; sb < 4; ++sb) { if (sb >= nsb) break; const int tb = tok0 + sb * 16;
            ssm_block16<true>(w, ub[sb], p, xr, xi, XW);
            f32x4 y0 = {0.f, 0.f, 0.f, 0.f}, y1 = {0.f, 0.f, 0.f, 0.f};
#pragma unroll
            for (int ks = 0; ks < 4; ++ks) { const LAS float* xp = XW + tl * 132 + 32 * ks + 8 * (F.lane >> 4); const f32x4 xa = *(const LAS f32x4*)xp, xb = *(const LAS f32x4*)(xp + 4);
                u32x4 w; w.x = cvt_pk_bf16(xa[0], xa[1]); w.y = cvt_pk_bf16(xa[2], xa[3]); w.z = cvt_pk_bf16(xb[0], xb[1]); w.w = cvt_pk_bf16(xb[2], xb[3]); const bf16x8 xf = *(bf16x8*)&w;
                if (ks & 1) y1 = __builtin_amdgcn_mfma_f32_16x16x32_bf16(cab[ks], xf, y1, 0, 0, 0); else y0 = __builtin_amdgcn_mfma_f32_16x16x32_bf16(cab[ks], xf, y0, 0, 0, 0); }
            f32x4 y = y0 + y1 + ds4 * u4a[sb];
#pragma unroll
            for (int j = 0; j < 4; ++j) y[j] = gelu_tanh(y[j]);
            *(u32x2*)(YG + (size_t)(tb + tl) * 512 + g * 16 + hq) = pack4(y);
        }
        if (prompt) { if (c == 255) { F.out[O_SREP + g * 64 + p] = xr; F.out[O_SIMP + g * 64 + p] = xi; } }
        else { F.out[O_SRES + (size_t)(c * 32 + g) * 64 + p] = xr; F.out[O_SIMS + (size_t)(c * 32 + g) * 64 + p] = xi; }
    }
}

__device__ __forceinline__ float wave_sum(float v) {
#pragma unroll
    for (int o = 32; o > 0; o >>= 1) v += __shfl_xor(v, o);
    return v;
}
__device__ __forceinline__ void post_rows(const Frame& F) {
    const float* PQ = (const float*)(F.ws + A_PQ); bf16_t* CQN = (bf16_t*)(F.ws + A_CQN); bf16_t* CKV = (bf16_t*)(F.ws + A_CKV); bf16_t* KPE = (bf16_t*)(F.ws + A_KPE);
    const float* gkv = F.a->in[12];
    const int l = F.lane, rstep = F.G * 8; int row = F.bid * 8 + F.wid;
    f32x4 nq0 = {0.f, 0.f, 0.f, 0.f}, nkv = nq0; u32x2 nq1 = {0u, 0u}; float npe = 0.f;
    if (row < MTOK) { const float* pr = PQ + (size_t)row * 768; nq0 = *(const f32x4*)(pr + 4 * l); nq1 = *(const u32x2*)(pr + 256 + 2 * l); nkv = *(const f32x4*)(pr + 384 + 4 * l); npe = pr[640 + l]; }
    for (; row < MTOK; row += rstep) {
        const f32x4 q0 = nq0, kv = nkv; const u32x2 q1r = nq1; const float pe = npe; const float q10 = __uint_as_float(q1r.x), q11 = __uint_as_float(q1r.y);
        if (row + rstep < MTOK) { const float* pr = PQ + (size_t)(row + rstep) * 768; nq0 = *(const f32x4*)(pr + 4 * l); nq1 = *(const u32x2*)(pr + 256 + 2 * l); nkv = *(const f32x4*)(pr + 384 + 4 * l); npe = pr[640 + l]; }
        const float sq = wave_sum((q0[0] * q0[0] + q0[1] * q0[1]) + (q0[2] * q0[2] + q0[3] * q0[3]) + q10 * q10 + q11 * q11);
        const float skv = wave_sum((kv[0] * kv[0] + kv[1] * kv[1]) + (kv[2] * kv[2] + kv[3] * kv[3]));
        const float rq = rsqrtf(sq * (1.f / 384.f) + EPSN), rkv = rsqrtf(skv * (1.f / 256.f) + EPSN);
        *(u32x2*)(CQN + (size_t)row * 384 + 4 * l) = pack4(q0 * rq); *(unsigned*)(CQN + (size_t)row * 384 + 256 + 2 * l) = cvt_pk_bf16(q10 * rq, q11 * rq);
        const f32x4 g4 = *(const f32x4*)(gkv + 4 * l); const f32x4 kvn = kv * rkv * g4; const int kr = tok_kvrow(row);
        float* oc = row < TP ? F.out + O_CKVP + (size_t)row * 256 : F.out + O_CKVS + (size_t)(row - TP) * 256; float* ok = row < TP ? F.out + O_KPEP + (size_t)row * 64 : F.out + O_KPES + (size_t)(row - TP) * 64;
        *(f32x4*)(oc + 4 * l) = kvn; *(u32x2*)(CKV + (size_t)kr * 256 + 4 * l) = pack4(kvn);
        float c, s; rope_cs(tok_pos(row), l & 31, c, s); const float other = __shfl_xor(pe, 32);
        const float ro = l < 32 ? pe * c - other * s : pe * c + other * s;
        ok[l] = ro; const float ron = __shfl_xor(ro, 1); if ((l & 1) == 0) *(unsigned*)(KPE + (size_t)swap23(kr) * 64 + l) = cvt_pk_bf16(ro, ron); }
}
__device__ __forceinline__ void final_ln(const Frame& F) {
    const float* g = F.a->in[32] + 2048; const float* b = F.a->in[33] + 2048;
    const int rstep = F.G * 8; int row = F.bid * 8 + F.wid; f32x4 nv[4];
#pragma unroll
    for (int i = 0; i < 4; ++i) nv[i] = row < MTOK ? *(const f32x4*)(F.out + O_Y + (size_t)row * 1024 + i * 256 + 4 * F.lane) : (f32x4){0.f, 0.f, 0.f, 0.f};
    for (; row < MTOK; row += rstep) { float* pr = F.out + O_Y + (size_t)row * 1024; f32x4 v[4]; float s = 0.f;
#pragma unroll
        for (int i = 0; i < 4; ++i) { v[i] = nv[i]; s += (v[i][0] + v[i][1]) + (v[i][2] + v[i][3]); }
        if (row + rstep < MTOK) {
#pragma unroll
            for (int i = 0; i < 4; ++i) nv[i] = *(const f32x4*)(pr + (size_t)rstep * 1024 + i * 256 + 4 * F.lane); }
        if (row >= TP) {
            const float* ST2 = (const float*)(F.ws + W_ST2); float mu2, rstd2; ln_stats16(ST2, ST2 + 16 * MTOK, row, mu2, rstd2);
            const float* SL = (const float*)(F.ws + A_R2B) + (size_t)(row - TP) * 1024; s = 0.f;
#pragma unroll
            for (int i = 0; i < 4; ++i) { const int c = i * 256 + 4 * F.lane; const f32x4 g1 = *(const f32x4*)(F.a->in[32] + 1024 + c), b1 = *(const f32x4*)(F.a->in[33] + 1024 + c);
                f32x4 a = (v[i] - mu2) * rstd2 * g1 + b1; a = a * ALPHA;
#pragma unroll
                for (int k = 0; k < 8; ++k) a = a + *(const f32x4*)(SL + (size_t)k * 1024 * 1024 + c);
                v[i] = a; s += (a[0] + a[1]) + (a[2] + a[3]); } }
        const float mu = wave_sum(s) * (1.f / 1024.f); float q = 0.f;
#pragma unroll
        for (int i = 0; i < 4; ++i) { const f32x4 d = v[i] - mu; q += (d[0] * d[0] + d[1] * d[1]) + (d[2] * d[2] + d[3] * d[3]); }
        const float rstd = rsqrtf(wave_sum(q) * (1.f / 1024.f) + EPSN);
#pragma unroll
        for (int i = 0; i < 4; ++i) { const f32x4 g4 = *(const f32x4*)(g + i * 256 + 4 * F.lane), b4 = *(const f32x4*)(b + i * 256 + 4 * F.lane); *(f32x4*)(pr + i * 256 + 4 * F.lane) = (v[i] - mu) * rstd * g4 + b4; } }
}

struct MapId { __device__ __forceinline__ int operator()(int n) const { return n; } };
struct MapWin { __device__ __forceinline__ int operator()(int n) const { return n < 1216 ? n : -1; } };
struct MapWq { __device__ __forceinline__ int operator()(int n) const { if (n < 512) return (n >> 7) * 192 + (n & 127); const int x = n - 512, part = x >> 7, h = (x >> 5) & 3, i = x & 31; return h * 192 + 128 + part * 32 + i; } };
struct MapWk { __device__ __forceinline__ int operator()(int n) const { return (n >> 7) * 256 + (n & 127); } };
struct MapWv { __device__ __forceinline__ int operator()(int n) const { return (n >> 7) * 256 + 128 + (n & 127); } };
struct MapGlu { __device__ __forceinline__ int operator()(int n) const { const int pn = n >> 8, bj = (n >> 7) & 1, x = n & 127; return bj * 512 + pn * 128 + x; } };
template <class CM, bool PERMK = false> __device__ __forceinline__ void wconv(const Frame& F, bf16_t* __restrict__ dst, const float* __restrict__ src, int ld, int K, int N, CM cm, const float* sc0, const float* sc1, int ksplit, int& rot) {
    const int ntn = N >> 5, ntiles = ntn * (K >> 6), tid = F.tid, kr = tid >> 3, nq = tid & 7;
    LAS float* T = (LAS float*)F.lds;
    for (int base = ((F.bid + F.G - rot % F.G) % F.G) * 4; base < ntiles; base += F.G * 4) { f32x4 v[4];
#pragma unroll
        for (int u = 0; u < 4; ++u) { const int tile = base + u; v[u] = (f32x4){0.f, 0.f, 0.f, 0.f};
            if (tile < ntiles) { const int tn = tile % ntn, tk = tile / ntn, col = cm(tn * 32), k = tk * 64 + kr;
                if (col >= 0) { v[u] = *(const f32x4*)(src + (size_t)k * ld + col + 4 * nq); if (sc0) v[u] = v[u] * (k < ksplit ? sc0[k] : sc1[k - ksplit]); } } }
#pragma unroll
        for (int u = 0; u < 4; ++u) {
#pragma unroll
            for (int j = 0; j < 4; ++j) T[u * 2112 + kr * 33 + 4 * nq + j] = v[u][j]; }
        __syncthreads();
        { const int half = tid >> 8, tt = tid & 255, n = tt >> 3, kq = tt & 7;
#pragma unroll
          for (int uu = 0; uu < 2; ++uu) { const int u = half * 2 + uu, tile = base + u;
              if (tile < ntiles) { const int tn = tile % ntn, tk = tile / ntn; float x[8];
#pragma unroll
                  for (int j = 0; j < 8; ++j) { const int pos = 8 * kq + j, kk = PERMK ? ((pos & ~12) | ((pos & 4) << 1) | ((pos & 8) >> 1)) : pos; x[j] = T[u * 2112 + kk * 33 + n]; }
                  u32x4 w; w.x = cvt_pk_bf16(x[0], x[1]); w.y = cvt_pk_bf16(x[2], x[3]); w.z = cvt_pk_bf16(x[4], x[5]); w.w = cvt_pk_bf16(x[6], x[7]);
                  *(u32x4*)(dst + (size_t)(tn * 32 + n) * K + tk * 64 + 8 * kq) = w; } } }
        __syncthreads(); }
    rot += (ntiles + 3) >> 2;
}
__device__ __forceinline__ void cvt_flat(const Frame& F, bf16_t* __restrict__ dst, const float* __restrict__ src, long n8) {
    const long gs = (long)F.G * 512;
    for (long base = (long)F.bid * 512 + F.tid; base < n8; base += 4 * gs) { f32x4 a[4], b[4];
#pragma unroll
        for (int u = 0; u < 4; ++u) { const long i = base + u * gs; const long ii = i < n8 ? i : 0; a[u] = *(const f32x4*)(src + ii * 8); b[u] = *(const f32x4*)(src + ii * 8 + 4); }
#pragma unroll
        for (int u = 0; u < 4; ++u) { const long i = base + u * gs; if (i < n8) { u32x4 w; w.x = cvt_pk_bf16(a[u][0], a[u][1]); w.y = cvt_pk_bf16(a[u][2], a[u][3]); w.z = cvt_pk_bf16(b[u][0], b[u][1]); w.w = cvt_pk_bf16(b[u][2], b[u][3]); *(u32x4*)(dst + i * 8) = w; } } }
}
__device__ __forceinline__ void colsum_job(const Frame& F, const float* W, int N, const float* g, const float* b, float* cs, float* bw, int rotb) {
    LAS float* red = (LAS float*)F.lds;
    const int seg = F.tid >> 4, col = F.tid & 15;
    for (int task = (F.bid + F.G - rotb % F.G) % F.G; task < N / 16; task += F.G) { const int n = task * 16 + col; float s = 0.f, t = 0.f;
#pragma unroll
        for (int j = 0; j < 32; ++j) { const int k = seg * 32 + j; const float w = W[(size_t)k * N + n]; s += bf16_round(w * g[k]); t = fmaf(b[k], w, t); }
        red[F.tid] = s; red[512 + F.tid] = t; __syncthreads();
        if (F.tid < 16) { float a = 0.f, c = 0.f;
#pragma unroll
            for (int i = 0; i < 32; ++i) { a += red[i * 16 + F.tid]; c += red[512 + i * 16 + F.tid]; }
            cs[n] = a; bw[n] = c; }
        __syncthreads(); }
}
__device__ __forceinline__ void ssm_consts(const Frame& F) {
    const int i = F.bid * 512 + F.tid; if (i >= 2048) return;
    const int g = i >> 6; float* LAM = (float*)(F.ws + W_LAM); float* LAM64 = (float*)(F.ws + W_LAM64); float* BB = (float*)(F.ws + W_BB);
    const double ar = F.a->in[14][i], ai = F.a->in[15][i], dt = exp((double)F.a->in[21][g]);
    const double mag = exp(ar * dt), lr = mag * cos(ai * dt), li = mag * sin(ai * dt);
    LAM[i] = (float)lr; LAM[2048 + i] = (float)li;
    double pr = lr, pi = li;
#pragma unroll
    for (int k = 0; k < 6; ++k) { const double nr = pr * pr - pi * pi, ni = 2.0 * pr * pi; pr = nr; pi = ni; }
    LAM64[i] = (float)pr; LAM64[2048 + i] = (float)pi;
    const double nr = lr - 1.0, ni = li, den = ar * ar + ai * ai, fr = (nr * ar + ni * ai) / den, fi = (ni * ar - nr * ai) / den;
#pragma unroll
    for (int h = 0; h < 16; ++h) { const double br = F.a->in[16][(size_t)i * 16 + h], bi = F.a->in[17][(size_t)i * 16 + h];
        BB[(size_t)i * 16 + h] = (float)(fr * br - fi * bi); BB[32768 + (size_t)i * 16 + h] = (float)(fr * bi + fi * br); }
}
__device__ __forceinline__ void cvt_caches(const Frame& F, int b0, int nb) {
    unsigned char* ws = F.ws; { bf16_t* CKV = (bf16_t*)(ws + A_CKV); bf16_t* KPE = (bf16_t*)(ws + A_KPE); const long gs = (long)nb * 512;
#pragma unroll 4
      for (long i = (long)b0 * 512 + F.tid; i < 32L * 1024 * 32; i += gs) { const int c8 = (int)(i & 31), j = (int)((i >> 5) & 1023), bb = (int)(i >> 15);
          const float* s = F.a->in[3] + ((size_t)(bb * 1024 + j) * 256 + c8 * 8); const f32x4 a = *(const f32x4*)s, b = *(const f32x4*)(s + 4);
          u32x4 w; w.x = cvt_pk_bf16(a[0], a[1]); w.y = cvt_pk_bf16(a[2], a[3]); w.z = cvt_pk_bf16(b[0], b[1]); w.w = cvt_pk_bf16(b[2], b[3]);
          *(u32x4*)(CKV + (size_t)(TP + bb * KVS + j) * 256 + c8 * 8) = w; }
#pragma unroll 2
      for (long i = (long)b0 * 512 + F.tid; i < 32L * 1024 * 8; i += gs) { const int c8 = (int)(i & 7), j = (int)((i >> 3) & 1023), bb = (int)(i >> 13);
          const float* s = F.a->in[4] + ((size_t)(bb * 1024 + j) * 64 + c8 * 8); const f32x4 a = *(const f32x4*)s, b = *(const f32x4*)(s + 4);
          u32x4 w; w.x = cvt_pk_bf16(a[0], a[1]); w.y = cvt_pk_bf16(a[2], a[3]); w.z = cvt_pk_bf16(b[0], b[1]); w.w = cvt_pk_bf16(b[2], b[3]);
          *(u32x4*)(KPE + (size_t)swap23(TP + bb * KVS + j) * 64 + c8 * 8) = w; } }
}
#ifndef PRO_DUP
#define PRO_DUP 0
#endif
#define DUPP(j) _Pragma("unroll") for (int rp_ = 0; rp_ < (((PRO_DUP >> (j)) & 1) ? 2 : 1); ++rp_)
__device__ __forceinline__ void prologue(const Frame& F) {
    unsigned char* ws = F.ws;
    DUPP(0) ssm_consts(F);
    int rot = 8;
    DUPP(1) {
    wconv(F, (bf16_t*)(ws + W_WIN), F.a->in[9], 1216, 1024, 1280, MapWin(), nullptr, nullptr, 0, rot);
    }
    DUPP(2) {
    if (F.G > 8) { if (F.bid >= 4) { Frame F2 = F; F2.bid = F.bid - 4; F2.G = F.G - 4; cvt_flat(F2, (bf16_t*)(ws + A_XB), F.a->in[0], (long)TP * 128); } }
    else cvt_flat(F, (bf16_t*)(ws + A_XB), F.a->in[0], (long)TP * 128);
    cvt_flat(F, (bf16_t*)(ws + A_XB) + (size_t)TP * 1024, F.a->in[1], (long)TS * 128);
    cvt_flat(F, (bf16_t*)(ws + W_MEMB), F.a->in[2], 256 * 128);
    }
    DUPP(1) {
    wconv(F, (bf16_t*)(ws + W_WXK), F.a->in[27], 1024, 1024, 1024, MapId(), nullptr, nullptr, 0, rot);
    wconv(F, (bf16_t*)(ws + W_WXV), F.a->in[28], 1024, 1024, 1024, MapId(), nullptr, nullptr, 0, rot);
    wconv(F, (bf16_t*)(ws + W_WQ), F.a->in[11], 768, 384, 768, MapWq(), F.a->in[10], F.a->in[10], 384, rot);
    wconv(F, (bf16_t*)(ws + W_WK), F.a->in[13], 1024, 256, 512, MapWk(), nullptr, nullptr, 0, rot);
    wconv(F, (bf16_t*)(ws + W_WV), F.a->in[13], 1024, 256, 512, MapWv(), nullptr, nullptr, 0, rot);
    wconv(F, (bf16_t*)(ws + W_WGLU), F.a->in[22], 1024, 512, 1024, MapGlu(), nullptr, nullptr, 0, rot);
    wconv(F, (bf16_t*)(ws + W_WO), F.a->in[25], 1024, 1024, 1024, MapId(), F.a->in[23], F.a->in[24], 512, rot);
    wconv(F, (bf16_t*)(ws + W_WXQ), F.a->in[26], 1024, 1024, 1024, MapId(), F.a->in[32], F.a->in[32], 1024, rot);
    wconv(F, (bf16_t*)(ws + W_WXO), F.a->in[29], 1024, 1024, 1024, MapId(), nullptr, nullptr, 0, rot);
    wconv(F, (bf16_t*)(ws + W_WFF1), F.a->in[30], 4096, 1024, 4096, MapId(), F.a->in[32] + 1024, F.a->in[32] + 1024, 1024, rot);
    wconv(F, (bf16_t*)(ws + W_WFF2), F.a->in[31], 1024, 4096, 1024, MapId(), nullptr, nullptr, 0, rot);
    }
    DUPP(4) {
    colsum_job(F, F.a->in[26], 1024, F.a->in[32], F.a->in[33], (float*)(ws + W_CSXQ), (float*)(ws + W_BWXQ), 0);
    colsum_job(F, F.a->in[30], 4096, F.a->in[32] + 1024, F.a->in[33] + 1024, (float*)(ws + W_CSFF1), (float*)(ws + W_BWFF1), 64);
    }
}
__device__ __forceinline__ void cvt_memcache(const Frame& F, int b0, int bstride) {
    bf16_t* XKS = (bf16_t*)(F.ws + A_XKS); bf16_t* XVTS = (bf16_t*)(F.ws + A_XVTS); const float* ck = F.a->in[7]; const float* cv = F.a->in[8];
    const long gs = (long)bstride * 512;
    for (long i = (long)b0 * 512 + F.tid; i < 32L * 256 * 128; i += gs) { const f32x4 a = *(const f32x4*)(ck + i * 8), b = *(const f32x4*)(ck + i * 8 + 4);
        const long rowi = i >> 7, c8 = i & 127; const long drow = (rowi & ~255L) | swap23((int)(rowi & 255));
        u32x4 w; w.x = cvt_pk_bf16(a[0], a[1]); w.y = cvt_pk_bf16(a[2], a[3]); w.z = cvt_pk_bf16(b[0], b[1]); w.w = cvt_pk_bf16(b[2], b[3]); *(u32x4*)(XKS + drow * 1024 + c8 * 8) = w; }
    { Frame F2 = F; F2.bid = b0; F2.G = bstride; int rot = 0;
      for (int bb = 0; bb < 32; ++bb) wconv<MapId, false>(F2, XVTS + (size_t)bb * 262144, cv + (size_t)bb * 262144, 1024, 256, 1024, MapId(), nullptr, nullptr, 0, rot); }
}

#define XB_TMO      128
#define XB_XCNT(j)  (256  + 64 * (j))
#define XB_XSUB(j)  (1280 + 64 * (j))
#define XB_XGEN(j)  (2304 + 64 * (j))
#define XB_TOP      3328
#define XB_TOPGEN   3392
#define XCD_BAR_WORDS 3456
#define XB_SPIN_CAP (1u << 18)

__device__ __forceinline__ unsigned xb_ld(unsigned* p)              { return __hip_atomic_load(p, __ATOMIC_RELAXED, __HIP_MEMORY_SCOPE_AGENT); }
__device__ __forceinline__ unsigned xb_add(unsigned* p, unsigned v) { return __hip_atomic_fetch_add(p, v, __ATOMIC_RELAXED, __HIP_MEMORY_SCOPE_AGENT); }
__device__ __forceinline__ unsigned xb_xcc_id() { return (unsigned)__builtin_amdgcn_s_getreg((3 << 11) | 20) & 0xFu; }
#define XB_SPIN(cond, bar) do { unsigned _sp = 0; while (cond) { __builtin_amdgcn_s_sleep(1); \
    if ((++_sp & 255u) == 0u) { if (xb_ld(&(bar)[XB_TMO])) break; if (_sp > XB_SPIN_CAP) { atomicAdd(&(bar)[XB_TMO], 1u); break; } } } } while (0)

struct XcdBarrier {
    unsigned* bar; unsigned x;
    volatile LAS unsigned* st;
};

__device__ __forceinline__ XcdBarrier xcd_barrier_post(unsigned* bar, volatile LAS unsigned* st) {
    XcdBarrier b; b.bar = bar; b.x = xb_xcc_id(); b.st = st;
    if (threadIdx.x == 0) (void)xb_add(&bar[XB_XCNT(b.x)], 1u);
    return b;
}
__device__ __forceinline__ void xcd_barrier_complete(unsigned* bar, unsigned x, unsigned& nloc, unsigned& nx) {
    const unsigned G = gridDim.x * gridDim.y * gridDim.z;
    unsigned sum, cnt, mine, sp = 0u;
    for (;;) {
        sum = 0u; cnt = 0u; mine = 0u;
#pragma unroll
        for (unsigned j = 0; j < 16; ++j) { const unsigned c = xb_ld(&bar[XB_XCNT(j)]); sum += c; cnt += (c > 0u) ? 1u : 0u; mine = (j == x) ? c : mine; }
        if (sum == G) break;
        __builtin_amdgcn_s_sleep(1);
        if ((++sp & 255u) == 0u) { if (xb_ld(&bar[XB_TMO])) break; if (sp > XB_SPIN_CAP) { atomicAdd(&bar[XB_TMO], 1u); break; } }
    }
    nloc = mine > 0u ? mine : 1u; nx = cnt > 0u ? cnt : 1u;
}

__device__ __forceinline__ void xcd_barrier(const XcdBarrier& b) {
    asm volatile("s_waitcnt vmcnt(0)" ::: "memory");
    __syncthreads();
    if (threadIdx.x == 0) {
        unsigned* bar = b.bar;
        __builtin_amdgcn_s_waitcnt(0);
        unsigned nloc = b.st[0], nx = b.st[1];
        if (nloc == 0u) { xcd_barrier_complete(bar, b.x, nloc, nx); b.st[0] = nloc; b.st[1] = nx; }
        const unsigned old = xb_add(&bar[XB_XSUB(b.x)], 1u);
        const unsigned gen = old / nloc;
        if (old + 1u == (gen + 1u) * nloc) {
            __builtin_amdgcn_fence(__ATOMIC_RELEASE, "agent");
            asm volatile("s_waitcnt vmcnt(0)" ::: "memory");
            const unsigned og = xb_add(&bar[XB_TOP], 1u);
            const unsigned tg = og / nx;
            if (og + 1u == (tg + 1u) * nx) xb_add(&bar[XB_TOPGEN], 1u);
            else XB_SPIN(xb_ld(&bar[XB_TOPGEN]) == tg, bar);
            __builtin_amdgcn_fence(__ATOMIC_ACQUIRE, "agent");
            xb_add(&bar[XB_XGEN(b.x)], 1u);
            asm volatile("s_waitcnt vmcnt(0)" ::: "memory");
        } else {
            XB_SPIN(xb_ld(&bar[XB_XGEN(b.x)]) == gen, bar);
            __builtin_amdgcn_fence(__ATOMIC_ACQUIRE, "agent");
            asm volatile("s_waitcnt vmcnt(0)" ::: "memory");
        }
    }
    __syncthreads();
}

constexpr int NPHASE = 13;
#ifndef PHASE_MASK
#define PHASE_MASK 0x1FFF
#endif
#ifndef SUBMASK
#define SUBMASK 0xFF
#endif
#define SUB(j) if ((SUBMASK >> (j)) & 1)
#ifndef DUP_MASK
#define DUP_MASK 0
#endif
#define DUP(k) _Pragma("unroll") for (int rep_ = 0; rep_ < (((DUP_MASK >> (k)) & 1) ? 2 : 1); ++rep_)
#define PH(k) if (!((PHASE_MASK >> (k)) & 1)) break;
using pg8::Gemm; using pg8::StaticOrder;
#define RUN_GEMM_LN(EPI, gm, e, PS_, PQ_) do { StaticOrder S_; S_.init((gm).M, (gm).N, F.G, F.bid, 0); ln_fill_tab(S_, PS_, PQ_, (LAS float*)(F.lds + 131072)); pg8::gemm_phase<EPI, StaticOrder, true, true>(F.lds, gm, S_, e); } while (0)
#define RUN_GEMM(EPI, gm, e, rot) do { StaticOrder S_; S_.init((gm).M, (gm).N, F.G, F.bid, rot); pg8::gemm_phase<EPI, StaticOrder, true, true>(F.lds, gm, S_, e); } while (0)

#define WS (F.ws)
#define U (F.a->out)
#define YG ((bf16_t*)((unsigned char*)F.a->out + 36 * MiB))
#define STSSM ((float*)(WS + W_STSSM))
#define STMLA ((float*)(WS + W_STMLA))
#define ST1 ((float*)(WS + W_ST1))
#define ST2 ((float*)(WS + W_ST2))
#define KN ((bf16_t*)(WS + A_KN))
#define VT ((bf16_t*)(WS + A_VT))
#define Q ((bf16_t*)(WS + A_Q))
#define KPE ((bf16_t*)(WS + A_KPE))
#define MIX ((bf16_t*)(WS + A_MIX))
#define R (F.a->out + O_Y)
__global__ void __launch_bounds__(512, 2) fwd_kernel(Args a) {
    extern __shared__ __attribute__((aligned(16))) unsigned char lds_raw[];
    Frame F;
    F.a = (const Args*)__builtin_amdgcn_kernarg_segment_ptr();
    F.out = a.out; F.ws = a.ws; F.lds = (LAS unsigned char*)lds_raw; F.tid = threadIdx.x; F.lane = F.tid & 63; F.wid = __builtin_amdgcn_readfirstlane(F.tid >> 6); F.G = gridDim.x; F.bid = blockIdx.x;
    const int lo = a.ph_lo, hi = a.ph_hi;
    volatile LAS unsigned* bst = (volatile LAS unsigned*)(F.lds + LDS_BYTES - 16);
    if (F.tid < 2) bst[F.tid] = 0u;
    __syncthreads();
    (void)xcd_barrier_post((unsigned*)(WS + W_BAR), bst);
    if (hi > 1000) cg::this_grid().sync();
#define GSYNC(k) if ((k) + 1 < hi) { XcdBarrier b_; b_.bar = (unsigned*)(F.a->ws + W_BAR); b_.x = xb_xcc_id(); b_.st = (volatile LAS unsigned*)(F.lds + LDS_BYTES - 16); xcd_barrier(b_); }
        if (((PHASE_MASK >> 0) & 1) && lo <= 0 && 0 < hi) DUP(0) { prologue(F); }
        if (lo <= 0 && 0 < hi) GSYNC(0)
        if (((PHASE_MASK >> 1) & 1) && lo <= 1 && 1 < hi) DUP(1) { {
            SUB(0) { Gemm g{(const bf16_t*)(WS + A_XB), (const bf16_t*)(WS + W_WIN), MTOK, 1280, 1024}; EpiProj e{U, (float*)(WS + A_PQ)}; RUN_GEMM(EpiProj, g, e, 0); }
            SUB(1) { Gemm g{(const bf16_t*)(WS + W_MEMB), (const bf16_t*)(WS + W_WXK), 256, 1024, 1024}; EpiStore<false> e{(bf16_t*)(WS + W_XK0), 1024, F.a->out + O_MKP, 1024, nullptr, 0, 1}; RUN_GEMM(EpiStore<false>, g, e, 172); }
            SUB(2) { Gemm g{(const bf16_t*)(WS + W_WXV), (const bf16_t*)(WS + W_MEMB), 1024, 256, 1024}; EpiStore<false> e{(bf16_t*)(WS + W_XVT0), 256, nullptr, 0, F.a->out + O_MVP, 1024, 0}; RUN_GEMM(EpiStore<false>, g, e, 168); }
            if (F.G > 92) { if (F.bid >= 92) cvt_caches(F, F.bid - 92, F.G - 92); } else cvt_caches(F, F.bid, F.G);
        } }
        if (lo <= 1 && 1 < hi) GSYNC(1)
        if (((PHASE_MASK >> 2) & 1) && lo <= 2 && 2 < hi) DUP(2) { post_rows(F); ssm_pass_a(F); }
        if (lo <= 2 && 2 < hi) GSYNC(2)
        if (((PHASE_MASK >> 3) & 1) && lo <= 3 && 3 < hi) DUP(3) { {
            SUB(0) ssm_pass_b(F, F.bid - (F.G - 4)); __syncthreads();
            SUB(1) { Gemm g{(const bf16_t*)(WS + A_CQN), (const bf16_t*)(WS + W_WQ), MTOK, 768, 384}; EpiQ e{Q}; RUN_GEMM(EpiQ, g, e, 0); }
            SUB(2) { Gemm g{(const bf16_t*)(WS + A_CKV), (const bf16_t*)(WS + W_WK), KVROWS, 512, 256}; EpiStore<false> e{KN, 512, nullptr, 0, nullptr, 0, 1}; RUN_GEMM(EpiStore<false>, g, e, 52); }
            SUB(3) { Gemm g{(const bf16_t*)(WS + W_WV), (const bf16_t*)(WS + A_CKV), 512, KVROWS, 256}; EpiStore<false> e{VT, KVPAD, nullptr, 0, nullptr, 0, 0}; RUN_GEMM(EpiStore<false>, g, e, 172); }
        } }
        if (lo <= 3 && 3 < hi) GSYNC(3)
        if (((PHASE_MASK >> 4) & 1) && lo <= 4 && 4 < hi) DUP(4) { ssm_pass_c(F); }
        if (lo <= 4 && 4 < hi) GSYNC(4)
        if (((PHASE_MASK >> 5) & 1) && lo <= 5 && 5 < hi) DUP(5) { {
            SUB(0) { Gemm g{YG, (const bf16_t*)(WS + W_WGLU), MTOK, 1024, 512}; EpiGlu e{MIX, STSSM}; RUN_GEMM(EpiGlu, g, e, 0); }
            SUB(1) DUP(13) for (int it = F.bid; it < 256; it += F.G) { const int y = it >> 2, h = it & 3;
                for (int pass = 0; pass < 2; ++pass) { const int x = pass ? y : 127 - y, q0 = x * 128, rg = F.wid & 3;
                    attn_unit<192, 128, 128, false>(F.lds, Q + (size_t)q0 * 768 + h * 192, 768, KN + h * 128, 512, KPE, VT + (size_t)(h * 128) * KVPAD, KVPAD,
                                                    (q0 >> 6) + 2, 64 * ((q0 >> 6) + (rg >> 1) + 1), MIX + (size_t)q0 * 1024 + 512 + h * 128, 1024, STMLA + (size_t)h * MTOK + q0, 128); } }
            SUB(2) DUP(14) for (int it = F.G - 1 - F.bid; it < 128; it += F.G) { const int b = it >> 2, h = it & 3, q0 = TP + b * 32, k0 = TP + b * KVS, rg = F.wid & 3;
                attn_unit<192, 128, 128, false>(F.lds, Q + (size_t)q0 * 768 + h * 192, 768, KN + (size_t)k0 * 512 + h * 128, 512, KPE + (size_t)k0 * 64, VT + (size_t)(h * 128) * KVPAD + k0, KVPAD,
                                                17, rg == 0 ? KVS : 0, MIX + (size_t)q0 * 1024 + 512 + h * 128, 1024, STMLA + (size_t)h * MTOK + q0, 32); }
        } }
        if (lo <= 5 && 5 < hi) GSYNC(5)
        if (((PHASE_MASK >> 6) & 1) && lo <= 6 && 6 < hi) DUP(6) { {
            { Gemm g{MIX, (const bf16_t*)(WS + W_WO), MTOK, 1024, 1024};
              LAS float* tab = (LAS float*)(F.lds + 131072);
              EpiRes<0> e{F.a->in[0], F.a->in[1], R, (bf16_t*)(WS + A_R1B), nullptr, nullptr, nullptr, nullptr, ST1, ST1 + 16 * MTOK, tab};
              StaticOrder S_; S_.init(g.M, g.N, F.G, F.bid, 0); Unit u0;
              if (S_.next(0, u0)) wo_fill_tab(u0, STSSM, STMLA, tab);
              if (S_.next(1, u0)) wo_fill_tab(u0, STSSM, STMLA, tab);
              __syncthreads();
              pg8::gemm_phase<EpiRes<0>, StaticOrder, true, true>(F.lds, g, S_, e); }
            if (F.G > 16) { if (F.bid >= 16) cvt_memcache(F, F.bid - 16, F.G - 16); } else cvt_memcache(F, F.bid, F.G);
        } }
        if (lo <= 6 && 6 < hi) GSYNC(6)
        if (((PHASE_MASK >> 7) & 1) && lo <= 7 && 7 < hi) DUP(7) { { Gemm g{(const bf16_t*)(WS + A_R1B), (const bf16_t*)(WS + W_WXQ), (F.G >= 80) ? TP : MTOK, 1024, 1024};
            EpiLnAct<0> e{(const LAS float*)(F.lds + 131072), (const float*)(WS + W_CSXQ), (const float*)(WS + W_BWXQ), (bf16_t*)(WS + A_XQ), 1024}; RUN_GEMM_LN(EpiLnAct<0>, g, e, ST1, ST1 + 16 * MTOK); } }
        if (lo <= 7 && 7 < hi) GSYNC(7)
        if (((PHASE_MASK >> 8) & 1) && lo <= 8 && 8 < hi) DUP(8) { {
            const bf16_t* XQ = (const bf16_t*)(WS + A_XQ); bf16_t* XO = (bf16_t*)(WS + A_XO); unsigned* cnt2 = (unsigned*)(WS + W_BAR + 14336) + 16;
            if (F.G >= 80 && F.bid >= F.G - 16) {
                const int u = F.bid - (F.G - 16), pm = TP / 256 + (u >> 2); LAS float* tab = (LAS float*)(F.lds + 131072);
                if (F.tid < 256) { float mu, rstd; ln_stats16(ST1, ST1 + 16 * MTOK, pm * 256 + F.tid, mu, rstd); tab[F.tid] = mu; tab[256 + F.tid] = rstd; }
                __syncthreads();
                Gemm gx{(const bf16_t*)(WS + A_R1B), (const bf16_t*)(WS + W_WXQ), MTOK, 1024, 1024}; pg8::OneUnitOrder Sx{pm, u & 3};
                EpiLnAct<0> ex{tab, (const float*)(WS + W_CSXQ), (const float*)(WS + W_BWXQ), (bf16_t*)(WS + A_XQ), 1024};
                pg8::gemm_phase<EpiLnAct<0>, pg8::OneUnitOrder, true, true>(F.lds, gx, Sx, ex);
                asm volatile("s_waitcnt vmcnt(0)" ::: "memory"); __syncthreads();
                if (F.tid == 0) { __builtin_amdgcn_fence(__ATOMIC_RELEASE, "agent"); asm volatile("s_waitcnt vmcnt(0)" ::: "memory"); __hip_atomic_fetch_add(cnt2, 1u, __ATOMIC_RELAXED, __HIP_MEMORY_SCOPE_AGENT); }
                __syncthreads(); }
            for (int it = F.bid; it < 640; it += F.G) {
                if (it >= 512 && F.G >= 80) {
                    if (F.tid == 0) { unsigned sp = 0; while (__hip_atomic_load(cnt2, __ATOMIC_RELAXED, __HIP_MEMORY_SCOPE_AGENT) < 16u) { __builtin_amdgcn_s_sleep(2); if (++sp > (1u << 22)) break; }
                        __builtin_amdgcn_fence(__ATOMIC_ACQUIRE, "agent"); asm volatile("s_waitcnt vmcnt(0)" ::: "memory"); }
                    __syncthreads(); }
                if (it < 512) { const int x = it >> 2, h = it & 3, q0 = x * 128;
                    attn_unit<256, 256, 256, true>(F.lds, XQ + (size_t)q0 * 1024 + h * 256, 1024, (const bf16_t*)(WS + W_XK0) + h * 256, 1024, nullptr, (const bf16_t*)(WS + W_XVT0) + (size_t)h * 65536, 256,
                                                   4, 256, XO + (size_t)q0 * 1024 + h * 256, 1024, nullptr, 128); }
                else { const int b = (it - 512) >> 2, h = it & 3, q0 = TP + b * 32, rg = F.wid & 3;
                    attn_unit<256, 256, 256, true>(F.lds, XQ + (size_t)q0 * 1024 + h * 256, 1024, (const bf16_t*)(WS + A_XKS) + (size_t)b * 262144 + h * 256, 1024, nullptr,
                                                   (const bf16_t*)(WS + A_XVTS) + (size_t)(b * 4 + h) * 65536, 256, 4, rg == 0 ? 256 : 0, XO + (size_t)q0 * 1024 + h * 256, 1024, nullptr, 32); } }
        } }
        if (lo <= 8 && 8 < hi) GSYNC(8)
        if (((PHASE_MASK >> 9) & 1) && lo <= 9 && 9 < hi) DUP(9) { { Gemm g{(const bf16_t*)(WS + A_XO), (const bf16_t*)(WS + W_WXO), (F.G >= 80) ? TP : MTOK, 1024, 1024};
            EpiRes<1> e{nullptr, nullptr, R, (bf16_t*)(WS + A_R2B), nullptr, nullptr, F.a->in[32], F.a->in[33], ST2, ST2 + 16 * MTOK, (const LAS float*)(F.lds + 131072)}; RUN_GEMM_LN(EpiRes<1>, g, e, ST1, ST1 + 16 * MTOK); } }
        if (lo <= 9 && 9 < hi) GSYNC(9)
        if (((PHASE_MASK >> 10) & 1) && lo <= 10 && 10 < hi) DUP(10) { {
            LAS float* tab = (LAS float*)(F.lds + 131072); unsigned* cnt = (unsigned*)(WS + W_BAR + 14336);
            if (F.G >= 80 && F.bid >= F.G - 16) { const int u = F.bid - (F.G - 16); const int pm = TP / 256 + (u >> 2);
                if (F.tid < 256) { float mu, rstd; ln_stats16(ST1, ST1 + 16 * MTOK, pm * 256 + F.tid, mu, rstd); tab[F.tid] = mu; tab[256 + F.tid] = rstd; }
                __syncthreads();
                Gemm gx{(const bf16_t*)(WS + A_XO), (const bf16_t*)(WS + W_WXO), MTOK, 1024, 1024}; pg8::OneUnitOrder Sx{pm, u & 3};
                EpiRes<1> ex{nullptr, nullptr, R, (bf16_t*)(WS + A_R2B), nullptr, nullptr, F.a->in[32], F.a->in[33], ST2, ST2 + 16 * MTOK, tab};
                pg8::gemm_phase<EpiRes<1>, pg8::OneUnitOrder, true, true>(F.lds, gx, Sx, ex);
                asm volatile("s_waitcnt vmcnt(0)" ::: "memory"); __syncthreads();
                if (F.tid == 0) { __builtin_amdgcn_fence(__ATOMIC_RELEASE, "agent"); asm volatile("s_waitcnt vmcnt(0)" ::: "memory"); __hip_atomic_fetch_add(cnt, 1u, __ATOMIC_RELAXED, __HIP_MEMORY_SCOPE_AGENT); }
                __syncthreads(); }
            EpiLnAct<1> e{tab, (const float*)(WS + W_CSFF1), (const float*)(WS + W_BWFF1), (bf16_t*)(WS + A_Z), 4096};
            { Gemm g{(const bf16_t*)(WS + A_R2B), (const bf16_t*)(WS + W_WFF1), (F.G >= 80) ? TP : MTOK, 4096, 1024}; RUN_GEMM_LN(EpiLnAct<1>, g, e, ST2, ST2 + 16 * MTOK); }
            if (F.G >= 80 && F.bid < 64) {
                if (F.tid == 0) { unsigned sp = 0; while (__hip_atomic_load(cnt, __ATOMIC_RELAXED, __HIP_MEMORY_SCOPE_AGENT) < 16u) { __builtin_amdgcn_s_sleep(2); if (++sp > (1u << 22)) break; }
                    __builtin_amdgcn_fence(__ATOMIC_ACQUIRE, "agent"); asm volatile("s_waitcnt vmcnt(0)" ::: "memory"); }
                __syncthreads();
                const int pm = TP / 256 + (F.bid >> 4);
                if (F.tid < 256) { float mu, rstd; ln_stats16(ST2, ST2 + 16 * MTOK, pm * 256 + F.tid, mu, rstd); tab[F.tid] = mu; tab[256 + F.tid] = rstd; }
                __syncthreads();
                Gemm gs{(const bf16_t*)(WS + A_R2B), (const bf16_t*)(WS + W_WFF1), MTOK, 4096, 1024}; pg8::OneUnitOrder Ss{pm, F.bid & 15};
                pg8::gemm_phase<EpiLnAct<1>, pg8::OneUnitOrder, true, true>(F.lds, gs, Ss, e); } } }
        if (lo <= 10 && 10 < hi) GSYNC(10)
        if (((PHASE_MASK >> 11) & 1) && lo <= 11 && 11 < hi) DUP(11) { { Gemm g{(const bf16_t*)(WS + A_Z), (const bf16_t*)(WS + W_WFF2), TP, 1024, 4096};
            EpiRes<1> e{nullptr, nullptr, R, nullptr, nullptr, nullptr, F.a->in[32] + 1024, F.a->in[33] + 1024, ST1, ST1 + 16 * MTOK, (const LAS float*)(F.lds + 131072)}; RUN_GEMM_LN(EpiRes<1>, g, e, ST2, ST2 + 16 * MTOK); }
          { Gemm g{(const bf16_t*)(WS + A_Z) + (size_t)TP * 4096, (const bf16_t*)(WS + W_WFF2), TS, 1024, 512, 4096};
            pg8::SplitKOrder S_{16, 4, 8, 512, F.G, F.bid}; EpiSlab e{(float*)(WS + A_R2B)}; pg8::gemm_phase<EpiSlab, pg8::SplitKOrder, true, true>(F.lds, g, S_, e); } }
        if (lo <= 11 && 11 < hi) GSYNC(11)
        if (((PHASE_MASK >> 12) & 1) && lo <= 12 && 12 < hi) DUP(12) { final_ln(F); }
}

#undef WS
#undef U
#undef YG
#undef STSSM
#undef STMLA
#undef ST1
#undef ST2
#undef KN
#undef VT
#undef Q
#undef KPE
#undef MIX
#undef R
extern "C" void kernel_launch(void* const* d_in, const int* in_sizes, int n_in, void* d_out, int out_size, void* d_ws, size_t ws_size, hipStream_t stream) {
    static int grid = 0;
    if (grid == 0) {
        int dev = 0, cus = 0, per_cu = 0;
        (void)hipGetDevice(&dev); (void)hipDeviceGetAttribute(&cus, hipDeviceAttributeMultiprocessorCount, dev);
        if (hipFuncSetAttribute((const void*)fwd_kernel, hipFuncAttributeMaxDynamicSharedMemorySize, LDS_BYTES) != hipSuccess) fprintf(stderr, "kernel_launch: hipFuncSetAttribute failed\n");
        if (hipOccupancyMaxActiveBlocksPerMultiprocessor(&per_cu, (const void*)fwd_kernel, 512, LDS_BYTES) != hipSuccess || per_cu < 1) { fprintf(stderr, "kernel_launch: occupancy query says %d\n", per_cu); per_cu = 1; }
        (void)hipGetLastError();
        grid = cus > 0 ? cus : 256;
        if (n_in != 34 || ws_size < WS_END) fprintf(stderr, "kernel_launch: unexpected n_in %d / ws_size %zu (need %zu)\n", n_in, ws_size, (size_t)WS_END);
    }
    if (hipMemsetAsync((char*)d_ws + W_BAR, 0, BAR_BYTES, stream) != hipSuccess) fprintf(stderr, "kernel_launch: memset failed\n");
    Args a{};
    for (int i = 0; i < 34; ++i) a.in[i] = (const float*)d_in[i];
    a.out = (float*)d_out; a.ws = (unsigned char*)d_ws;
#if N_LAUNCH_MODE == 1
    a.ph_lo = 0; a.ph_hi = NPHASE;
    void* args[] = {&a};
    hipError_t e = hipLaunchCooperativeKernel((const void*)fwd_kernel, dim3(grid), dim3(512), args, LDS_BYTES, stream);
    if (e != hipSuccess) fprintf(stderr, "cooperative launch failed: %s (grid %d)\n", hipGetErrorString(e), grid);
#else
    for (int ph = 0; ph < NPHASE; ++ph) { a.ph_lo = ph; a.ph_hi = ph + 1; hipLaunchKernelGGL(fwd_kernel, dim3(grid), dim3(512), LDS_BYTES, stream, a); }
#endif
}
```

```cpp
#include <hip/hip_runtime.h>
#include <hip/hip_cooperative_groups.h>
#include <cstdio>
#include <cstdint>
namespace cg = cooperative_groups;

#ifndef N_LAUNCH_MODE
#define N_LAUNCH_MODE 1
#endif

#define LAS __attribute__((address_space(3)))
#define PG8_LAS LAS
typedef unsigned short bf16_t;
typedef short bf16x8 __attribute__((ext_vector_type(8)));
typedef float f32x4 __attribute__((ext_vector_type(4)));
typedef float f32x16 __attribute__((ext_vector_type(16)));
typedef unsigned u32x4 __attribute__((ext_vector_type(4)));
typedef unsigned u32x2 __attribute__((ext_vector_type(2)));

constexpr int TP = 16384, TS = 1024, MTOK = TP + TS;
constexpr int DM = 1024, NPAST = 1024, KVS = 1056;
constexpr int KVROWS = TP + 32 * KVS;
constexpr int KVPAD = KVROWS + 64;
constexpr float EPSN = 1e-5f;
constexpr float ALPHA = 1.189207115002721f;
constexpr float LOG2E = 1.4426950408889634f;
constexpr float QSCALE = 0.07216878364870322f * LOG2E;
constexpr float XSCALE = 0.0625f * LOG2E;

constexpr size_t O_Y = 0, O_CKVP = 17825792, O_KPEP = 22020096, O_SREP = 23068672, O_SIMP = 23070720, O_MKP = 23072768,
                 O_MVP = 23334912, O_CKVS = 23597056, O_KPES = 23859200, O_SRES = 23924736, O_SIMS = 23990272;

constexpr size_t MiB = 1u << 20;
constexpr size_t al256(size_t x) { return (x + 255) & ~(size_t)255; }
constexpr size_t W_WIN = 0;
constexpr size_t W_WQ = W_WIN + al256(1280 * 1024 * 2);
constexpr size_t W_WK = W_WQ + al256(768 * 384 * 2);
constexpr size_t W_WV = W_WK + al256(512 * 256 * 2);
constexpr size_t W_WGLU = W_WV + al256(512 * 256 * 2);
constexpr size_t W_WO = W_WGLU + al256(1024 * 512 * 2);
constexpr size_t W_WXQ = W_WO + 2 * MiB;
constexpr size_t W_WXK = W_WXQ + 2 * MiB;
constexpr size_t W_WXV = W_WXK + 2 * MiB;
constexpr size_t W_WXO = W_WXV + 2 * MiB;
constexpr size_t W_WFF1 = W_WXO + 2 * MiB;
constexpr size_t W_WFF2 = W_WFF1 + 8 * MiB;
constexpr size_t W_CSXQ = W_WFF2 + 8 * MiB;
constexpr size_t W_BWXQ = W_CSXQ + 4096;
constexpr size_t W_CSFF1 = W_BWXQ + 4096;
constexpr size_t W_BWFF1 = W_CSFF1 + 16384;
constexpr size_t W_LAM = W_BWFF1 + 16384;
constexpr size_t W_LAM64 = W_LAM + 16384;
constexpr size_t W_BB = W_LAM64 + 16384;
constexpr size_t W_MEMB = W_BB + 2 * 32 * 64 * 16 * 4;
constexpr size_t W_XK0 = W_MEMB + 256 * 1024 * 2;
constexpr size_t W_XVT0 = W_XK0 + 256 * 1024 * 2;
constexpr size_t W_STSSM = W_XVT0 + 256 * 1024 * 2;
constexpr size_t W_STMLA = W_STSSM + al256(16 * MTOK * 4);
constexpr size_t W_ST1 = W_STMLA + al256(4 * MTOK * 4);
constexpr size_t W_ST2 = W_ST1 + al256(32 * MTOK * 4);
constexpr size_t W_SEND = W_ST2 + al256(32 * MTOK * 4);
constexpr size_t W_BAR = W_SEND + 256 * 2 * 2048 * 4;
constexpr size_t BAR_BYTES = 16384;
constexpr size_t W_ACT = (W_BAR + BAR_BYTES + MiB - 1) / MiB * MiB;
constexpr size_t A_KN = W_ACT, A_VT = W_ACT + 50 * MiB, A_Q = W_ACT + 100 * MiB, A_KPE = W_ACT + 126 * MiB, A_CKV = W_ACT + 133 * MiB,
                 A_CQN = W_ACT + 158 * MiB, A_MIX = W_ACT + 171 * MiB, A_PQ = W_ACT, A_XB = W_ACT + 51 * MiB, A_R1B = W_ACT,
                 A_XQ = W_ACT + 34 * MiB, A_XKS = W_ACT + 68 * MiB, A_XVTS = W_ACT + 84 * MiB, A_XO = W_ACT + 101 * MiB,
                 A_R2B = W_ACT + 140 * MiB, A_Z = W_ACT, WS_END = W_ACT + 205 * MiB;
static_assert(WS_END <= 256 * MiB, "workspace");
static_assert((size_t)KVPAD * 512 * 2 <= 50 * MiB && (size_t)MTOK * 768 * 2 <= 26 * MiB && (size_t)KVPAD * 64 * 2 <= 7 * MiB && (size_t)KVPAD * 256 * 2 <= 25 * MiB &&
              (size_t)MTOK * 384 * 2 <= 13 * MiB && (size_t)MTOK * 1024 * 2 <= 34 * MiB && (size_t)MTOK * 768 * 4 <= 51 * MiB && (size_t)MTOK * 4096 * 2 <= 136 * MiB, "regions");

constexpr int LDS_BYTES = 141312 + 64;

__constant__ double c_invrev[32] = {0.15915494309189535,0.11934937021124886,0.089499401608891013,0.067115083005227255,0.050329212104487035,0.037741584717419771,0.028302195830623399,0.02122365276477766,0.015915494309189534,0.011934937021124886,0.0089499401608891024,0.0067115083005227253,0.0050329212104487037,0.0037741584717419772,0.0028302195830623399,0.0021223652764777662,0.0015915494309189536,0.0011934937021124885,0.00089499401608891024,0.0006711508300522726,0.00050329212104487033,0.00037741584717419774,0.00028302195830623395,0.00021223652764777661,0.00015915494309189535,0.00011934937021124886,8.9499401608891018e-05,6.7115083005227254e-05,5.0329212104487035e-05,3.7741584717419777e-05,2.8302195830623396e-05,2.1223652764777659e-05};

__device__ __forceinline__ unsigned cvt_pk_bf16(float lo, float hi) { unsigned r; asm volatile("v_cvt_pk_bf16_f32 %0, %1, %2" : "=v"(r) : "v"(lo), "v"(hi)); return r; }
__device__ __forceinline__ u32x2 pack4(f32x4 v) { u32x2 w; w.x = cvt_pk_bf16(v[0], v[1]); w.y = cvt_pk_bf16(v[2], v[3]); return w; }
__device__ __forceinline__ float bf16_round(float x) { return __uint_as_float(cvt_pk_bf16(x, 0.f) << 16); }
__device__ __forceinline__ void rope_cs(int pos, int i, float& c, float& s) {
    double rev = (double)pos * c_invrev[i]; rev -= __builtin_floor(rev); const float r = (float)rev;
    s = __builtin_amdgcn_sinf(r); c = __builtin_amdgcn_cosf(r);
}
__device__ __forceinline__ int tok_pos(int row) { return row < TP ? row : NPAST + ((row - TP) & 31); }
__device__ __forceinline__ int swap23(int r) { return (r & ~12) | ((r & 4) << 1) | ((r & 8) >> 1); }
__device__ __forceinline__ int tok_kvrow(int row) { return row < TP ? row : TP + ((row - TP) >> 5) * KVS + NPAST + ((row - TP) & 31); }

struct Args { const float* in[34]; float* out; unsigned char* ws; int ph_lo, ph_hi; };
struct Frame {
    const Args* a; float* out; unsigned char* ws; LAS unsigned char* lds;
    int tid, lane, wid, G, bid;
};

namespace pg8 {
constexpr int BM = 256, BK = 64, HALF = 128, HTB = HALF * BK * 2, STAGE_BYTES = 8 * HTB, NXCD = 8, WGM = 8;
__host__ __device__ __forceinline__ int lds_byte(int r, int c) { const int st = (r >> 4) * 2 + (c >> 5), rr = r & 15, cc = c & 31, ob = rr * 64 + cc * 2; return st * 1024 + (ob ^ (((ob >> 9) & 1) << 5)); }
__host__ __device__ __forceinline__ void stage_rc(int b, int& R, int& C) { const int st = b / 1024, sb = b % 1024, swz = sb ^ (((sb >> 9) & 1) << 5); R = (st >> 1) * 16 + swz / 64; C = (st & 1) * 32 + (swz % 64) / 2; }
__host__ __device__ __forceinline__ int perm32(int rho) { const int n = rho >> 4, i = rho & 15; return 8 * (i >> 2) + 4 * n + (i & 3); }
struct Unit { int pm, pn, idx, ko; };
struct Gemm { const bf16_t* A; const bf16_t* Bt; int M, N, K, LD; };
struct StaticOrder {
    int nM, nN, nwg, G, c;
    __device__ __forceinline__ void init(int M, int N, int G_, int c_, int rot) { nM = M / BM; nN = N / BM; nwg = nM * nN; G = G_; c = (c_ + rot) % G_; }
    __device__ __forceinline__ bool next(int i, Unit& u) const {
        const long L = (long)i * G + c; if (L >= nwg) return false;
        int wgid = (int)L; { const int q = nwg / NXCD, r = nwg % NXCD, xcd = wgid % NXCD, off = wgid / NXCD; wgid = (xcd < r ? xcd * (q + 1) : r * (q + 1) + (xcd - r) * q) + off; }
        const int nig = WGM * nN, gid = wgid / nig, fm = gid * WGM, gsz = (nM - fm) < WGM ? (nM - fm) : WGM;
        u.pm = fm + ((wgid % nig) % gsz); u.pn = (wgid % nig) / gsz; u.idx = i; u.ko = 0; return true;
    }
    __device__ __forceinline__ void a_ready(const Unit&) const {}
    __device__ __forceinline__ void done(const Unit&) const {}
};
struct OneUnitOrder {
    int pm, pn;
    __device__ __forceinline__ bool next(int i, Unit& u) const { if (i > 0) return false; u.pm = pm; u.pn = pn; u.idx = 0; u.ko = 0; return true; }
    __device__ __forceinline__ void a_ready(const Unit&) const {}
    __device__ __forceinline__ void done(const Unit&) const {}
};
struct SplitKOrder {
    int nt, nN, ns, ks, G, c;
    __device__ __forceinline__ bool next(int i, Unit& u) const { const int L = i * G + c; if (L >= nt * ns) return false; const int t = L % nt, s = L / nt; u.pm = t / nN; u.pn = t % nN; u.idx = i; u.ko = s * ks; return true; }
    __device__ __forceinline__ void a_ready(const Unit&) const {}
    __device__ __forceinline__ void done(const Unit&) const {}
};
template <class Epi, class Sched, bool ALIGN_EPI = false, bool SP2 = false>
__device__ __forceinline__ void gemm_phase(PG8_LAS unsigned char* lds, const Gemm g, const Sched& S, const Epi& E) {
    const int tid = threadIdx.x, wid = __builtin_amdgcn_readfirstlane(tid >> 6), lane = tid & 63, wr = wid >> 2, wc = wid & 3, fr = lane & 15, fq = lane >> 4;
    int K_ = g.K; asm volatile("" : "+s"(K_)); const int K = K_, nt = K / BK, LD = g.LD ? g.LD : K;
    unsigned voffA[2], voffB[2];
#pragma unroll
    for (int i = 0; i < 2; ++i) { int R, C; stage_rc(tid * 16 + i * 8192, R, C); const int Rb = Epi::PERM ? ((R & ~31) + perm32(R & 31)) : R;
        voffA[i] = (unsigned)(R * LD + C) * 2u; voffB[i] = (unsigned)(Rb * LD + C) * 2u; }
    const size_t kstep = (size_t)(BK * 2);
    const size_t hstep = (size_t)HALF * LD * 2;
    const size_t tstep = 2 * hstep;
    const unsigned ldsw = (unsigned)wid * 1024u;
    const int aoff = lds_byte(wr * 64 + fr, fq * 8), boff = lds_byte(wc * 32 + fr, fq * 8);
#define PG8_SA(b, h) (((b) * 2 + (h)) * HTB)
#define PG8_SB(b, h) ((4 + (b) * 2 + (h)) * HTB)
#define PG8_STAGE(bufoff, gbase, voff) do { _Pragma("unroll") for (int _i = 0; _i < 2; ++_i) \
        __builtin_amdgcn_global_load_lds((const unsigned*)((const char*)(gbase) + (voff)[_i]), (PG8_LAS unsigned*)(lds + (bufoff) + ldsw + _i * 8192), 16, 0, 0); } while (0)
#define PG8_LDA(dst, b, h) do { _Pragma("unroll") for (int m = 0; m < 4; ++m) _Pragma("unroll") for (int k = 0; k < 2; ++k) dst[m][k] = *(const PG8_LAS bf16x8*)(lds + PG8_SA(b, h) + aoff + m * 2048 + k * 1024); } while (0)
#define PG8_LDB(dst, b, h) do { _Pragma("unroll") for (int n = 0; n < 2; ++n) _Pragma("unroll") for (int k = 0; k < 2; ++k) dst[n][k] = *(const PG8_LAS bf16x8*)(lds + PG8_SB(b, h) + boff + n * 2048 + k * 1024); } while (0)
#define PG8_MMA(ai, bj, At, Bt) do { __builtin_amdgcn_s_setprio(1); _Pragma("unroll") for (int m = 0; m < 4; ++m) _Pragma("unroll") for (int n = 0; n < 2; ++n) _Pragma("unroll") for (int k = 0; k < 2; ++k) \
        acc[ai][bj][m][n] = __builtin_amdgcn_mfma_f32_16x16x32_bf16(Bt[n][k], At[m][k], acc[ai][bj][m][n], 0, 0, 0); __builtin_amdgcn_s_setprio(0); } while (0)
#define PG8_WAIT_V(n) asm volatile("s_waitcnt vmcnt(" #n ")" ::: "memory")
#define PG8_WAIT_L(n) asm volatile("s_waitcnt lgkmcnt(" #n ")" ::: "memory")
#define PG8_BAR __builtin_amdgcn_s_barrier()
#define PG8_SCHED __builtin_amdgcn_sched_barrier(0)
    Unit cur, nxt; int ui = 0;
    if (!S.next(0, cur)) return;
    f32x4 acc[2][2][4][2];
#pragma unroll
    for (int a = 0; a < 2; ++a)
#pragma unroll
        for (int b = 0; b < 2; ++b)
#pragma unroll
            for (int m = 0; m < 4; ++m)
#pragma unroll
                for (int n = 0; n < 2; ++n) acc[a][b][m][n] = (f32x4){0.f, 0.f, 0.f, 0.f};
    bf16x8 At[4][2], B0[2][2], B1[2][2];
    const char* cA = (const char*)g.A + (size_t)cur.pm * tstep + (size_t)cur.ko * 2; const char* cB = (const char*)g.Bt + (size_t)cur.pn * tstep + (size_t)cur.ko * 2;
    S.a_ready(cur);
    if constexpr (SP2) {
        PG8_STAGE(PG8_SB(0, 0), cB, voffB); PG8_STAGE(PG8_SB(0, 1), cB + hstep, voffB); PG8_STAGE(PG8_SA(0, 0), cA, voffA); PG8_STAGE(PG8_SA(0, 1), cA + hstep, voffA);
        if (wr == 1) PG8_BAR;
        PG8_WAIT_V(2); PG8_BAR;
        PG8_STAGE(PG8_SB(1, 0), cB + kstep, voffB); PG8_STAGE(PG8_SA(1, 0), cA + kstep, voffA); PG8_STAGE(PG8_SB(1, 1), cB + hstep + kstep, voffB);
        PG8_WAIT_V(6); PG8_BAR;
    } else {
        PG8_STAGE(PG8_SB(0, 0), cB, voffB); PG8_STAGE(PG8_SA(0, 0), cA, voffA); PG8_STAGE(PG8_SB(0, 1), cB + hstep, voffB); PG8_STAGE(PG8_SA(0, 1), cA + hstep, voffA);
        if (wr == 1) PG8_BAR;
        PG8_WAIT_V(4); PG8_BAR;
        PG8_STAGE(PG8_SB(1, 0), cB + kstep, voffB); PG8_STAGE(PG8_SA(1, 0), cA + kstep, voffA); PG8_STAGE(PG8_SB(1, 1), cB + hstep + kstep, voffB);
        PG8_WAIT_V(6); PG8_BAR;
    }
    for (;;) {
        const bool has_next = S.next(ui + 1, nxt);
        const char* nA = has_next ? (const char*)g.A + (size_t)nxt.pm * tstep + (size_t)nxt.ko * 2 : cA; const char* nB = has_next ? (const char*)g.Bt + (size_t)nxt.pn * tstep + (size_t)nxt.ko * 2 : cB;
        for (int t = 0; t < nt; t += 2) {
            const bool last = (t == nt - 2);
            if constexpr (Epi::MIDK) { if (t == (nt >> 1)) E.mid(acc, cur, wr, fr); }
            const char* a1 = cA + (size_t)(t + 1) * kstep;
            const char* a2 = last ? nA : cA + (size_t)(t + 2) * kstep; const char* b2 = last ? nB : cB + (size_t)(t + 2) * kstep;
            const char* a3 = a2 + kstep; const char* b3 = b2 + kstep;
            if (last && has_next) S.a_ready(nxt);
            if constexpr (SP2) {
            PG8_LDB(B0, 0, 0); PG8_LDB(B1, 0, 1); PG8_SCHED; PG8_LDA(At, 0, 0); PG8_STAGE(PG8_SA(1, 1), a1 + hstep, voffA);
            PG8_WAIT_V(8); PG8_WAIT_L(0); PG8_BAR; PG8_MMA(0, 0, At, B0); PG8_MMA(0, 1, At, B1); PG8_BAR; PG8_SCHED;
            PG8_LDA(At, 0, 1); PG8_STAGE(PG8_SB(0, 0), b2, voffB); PG8_STAGE(PG8_SB(0, 1), b2 + hstep, voffB); PG8_STAGE(PG8_SA(0, 0), a2, voffA);
            PG8_WAIT_V(8); PG8_WAIT_L(0); PG8_BAR; PG8_MMA(1, 0, At, B0); PG8_MMA(1, 1, At, B1); PG8_BAR; PG8_SCHED;
            PG8_LDB(B0, 1, 0); PG8_LDB(B1, 1, 1); PG8_SCHED; PG8_LDA(At, 1, 0); PG8_STAGE(PG8_SA(0, 1), a2 + hstep, voffA);
            PG8_WAIT_V(8); PG8_WAIT_L(0); PG8_BAR; PG8_MMA(0, 0, At, B0); PG8_MMA(0, 1, At, B1); PG8_BAR; PG8_SCHED;
            PG8_LDA(At, 1, 1); PG8_STAGE(PG8_SB(1, 0), b3, voffB); PG8_STAGE(PG8_SB(1, 1), b3 + hstep, voffB); PG8_STAGE(PG8_SA(1, 0), a3, voffA);
            PG8_WAIT_V(8); PG8_WAIT_L(0); PG8_BAR; PG8_MMA(1, 0, At, B0); PG8_MMA(1, 1, At, B1); PG8_BAR; PG8_SCHED;
            } else {
            PG8_LDB(B0, 0, 0); PG8_SCHED; PG8_LDA(At, 0, 0); PG8_STAGE(PG8_SA(1, 1), a1 + hstep, voffA);
            PG8_WAIT_L(8); PG8_BAR; PG8_WAIT_L(0); PG8_MMA(0, 0, At, B0); PG8_BAR; PG8_SCHED;
            PG8_LDB(B1, 0, 1); PG8_STAGE(PG8_SB(0, 0), b2, voffB);
            PG8_BAR; PG8_WAIT_L(0); PG8_MMA(0, 1, At, B1); PG8_BAR;
            PG8_LDA(At, 0, 1); PG8_STAGE(PG8_SA(0, 0), a2, voffA);
            PG8_BAR; PG8_WAIT_L(0); PG8_MMA(1, 0, At, B0); PG8_BAR; PG8_SCHED;
            PG8_STAGE(PG8_SB(0, 1), b2 + hstep, voffB);
            PG8_WAIT_V(6); PG8_BAR; PG8_MMA(1, 1, At, B1); PG8_BAR;
            PG8_LDB(B0, 1, 0); PG8_SCHED; PG8_LDA(At, 1, 0); PG8_STAGE(PG8_SA(0, 1), a2 + hstep, voffA);
            PG8_WAIT_L(8); PG8_BAR; PG8_WAIT_L(0); PG8_MMA(0, 0, At, B0); PG8_BAR; PG8_SCHED;
            PG8_LDB(B1, 1, 1); PG8_STAGE(PG8_SB(1, 0), b3, voffB);
            PG8_BAR; PG8_WAIT_L(0); PG8_MMA(0, 1, At, B1); PG8_BAR;
            PG8_LDA(At, 1, 1); PG8_STAGE(PG8_SA(1, 0), a3, voffA);
            PG8_BAR; PG8_WAIT_L(0); PG8_MMA(1, 0, At, B0); PG8_BAR; PG8_SCHED;
            PG8_STAGE(PG8_SB(1, 1), b3 + hstep, voffB);
            PG8_WAIT_V(6); PG8_BAR; PG8_MMA(1, 1, At, B1); PG8_BAR;
            }
        }
        if constexpr (ALIGN_EPI) { if (wr == 0) PG8_BAR; }
        if constexpr (!Epi::AFTER_DRAIN) { E(acc, cur, wr, wc, fr, fq); S.done(cur); }
        if (!has_next) break;
#pragma unroll
        for (int a = 0; a < 2; ++a)
#pragma unroll
            for (int b = 0; b < 2; ++b)
#pragma unroll
                for (int m = 0; m < 4; ++m)
#pragma unroll
                    for (int n = 0; n < 2; ++n) acc[a][b][m][n] = (f32x4){0.f, 0.f, 0.f, 0.f};
        cur = nxt; cA = nA; cB = nB; ++ui;
        if constexpr (ALIGN_EPI) { if (wr == 1) PG8_BAR; }
    }
    PG8_WAIT_V(0);
    if constexpr (!ALIGN_EPI) { if (wr == 0) PG8_BAR; }
    PG8_BAR;
    if constexpr (Epi::AFTER_DRAIN) { E.fused(acc, cur, wr, wc, fr, fq, lds, wid, lane); S.done(cur); }
#undef PG8_SA
#undef PG8_SB
#undef PG8_STAGE
#undef PG8_LDA
#undef PG8_LDB
#undef PG8_MMA
#undef PG8_WAIT_V
#undef PG8_WAIT_L
#undef PG8_BAR
#undef PG8_SCHED
}
}
using pg8::Unit;
typedef f32x4 Acc[2][2][4][2];
#define EPI_ROWS _Pragma("unroll") for (int ai = 0; ai < 2; ++ai) _Pragma("unroll") for (int m = 0; m < 4; ++m)
#define EPI_COLS _Pragma("unroll") for (int bj = 0; bj < 2; ++bj) _Pragma("unroll") for (int n = 0; n < 2; ++n)

struct EpiProj {
    static constexpr bool PERM = false, AFTER_DRAIN = false, MIDK = false;
    float* U; float* PQ;
    __device__ __forceinline__ void operator()(const Acc& acc, const Unit& u, int wr, int wc, int fr, int fq) const {
        const bool isu = u.pn < 2; float* base = isu ? U : PQ; const int ld = isu ? 512 : 768; const int c0 = (isu ? u.pn : u.pn - 2) * 256 + wc * 32 + 4 * fq;
        EPI_ROWS { const int row = u.pm * 256 + ai * 128 + wr * 64 + m * 16 + fr; float* rp = base + (size_t)row * ld + c0;
            EPI_COLS *(f32x4*)(rp + bj * 128 + n * 16) = acc[ai][bj][m][n]; }
    }
};
struct EpiSlab {
    static constexpr bool PERM = false, AFTER_DRAIN = false, MIDK = false;
    float* S;
    __device__ __forceinline__ void operator()(const Acc& acc, const Unit& u, int wr, int wc, int fr, int fq) const {
        float* base = S + (size_t)(u.ko >> 9) * 1024 * 1024 + u.pn * 256 + wc * 32 + 4 * fq;
        EPI_ROWS { const int row = u.pm * 256 + ai * 128 + wr * 64 + m * 16 + fr;
            EPI_COLS *(f32x4*)(base + (size_t)row * 1024 + bj * 128 + n * 16) = acc[ai][bj][m][n]; }
    }
};
template <bool VT> struct EpiStore {
    static constexpr bool PERM = !VT, AFTER_DRAIN = false, MIDK = false;
    bf16_t* O; int ldc; float* F32; int ldf; float* F32T; int ldt; int rowswap;
    __device__ __forceinline__ void operator()(const Acc& acc, const Unit& u, int wr, int wc, int fr, int fq) const {
        if constexpr (VT) { const int sw = ((fq & 1) << 1) | (fq >> 1);
            EPI_ROWS { const int row = u.pm * 256 + ai * 128 + wr * 64 + m * 16 + fr;
                EPI_COLS { const int cb = u.pn * 256 + bj * 128 + wc * 32 + n * 16; const f32x4 v = acc[ai][bj][m][n];
                    *(u32x2*)(O + (size_t)row * ldc + cb + 4 * sw) = pack4(v);
                    if (F32) *(f32x4*)(F32 + (size_t)row * ldf + cb + 4 * fq) = v;
                    if (F32T) { _Pragma("unroll") for (int j = 0; j < 4; ++j) F32T[(size_t)(cb + 4 * fq + j) * ldt + row] = v[j]; } } }
        } else {
            EPI_ROWS { const int row = u.pm * 256 + ai * 128 + wr * 64 + m * 16 + fr;
                _Pragma("unroll") for (int bj = 0; bj < 2; ++bj) { const int cb = u.pn * 256 + bj * 128 + wc * 32 + 8 * fq; const f32x4 v0 = acc[ai][bj][m][0], v1 = acc[ai][bj][m][1];
                    const u32x2 h0 = pack4(v0), h1 = pack4(v1); u32x4 w; w.x = h0.x; w.y = h0.y; w.z = h1.x; w.w = h1.y;
                    *(u32x4*)(O + (size_t)(rowswap ? swap23(row) : row) * ldc + cb) = w;
                    if (F32) { *(f32x4*)(F32 + (size_t)row * ldf + cb) = v0; *(f32x4*)(F32 + (size_t)row * ldf + cb + 4) = v1; }
                    if (F32T) { _Pragma("unroll") for (int j = 0; j < 4; ++j) { F32T[(size_t)(cb + j) * ldt + row] = v0[j]; F32T[(size_t)(cb + 4 + j) * ldt + row] = v1[j]; } } } }
        }
    }
};
struct EpiQ {
    static constexpr bool PERM = false, AFTER_DRAIN = false, MIDK = false;
    bf16_t* Q;
    __device__ __forceinline__ void operator()(const Acc& acc, const Unit& u, int wr, int wc, int fr, int fq) const {
        EPI_ROWS { const int row = u.pm * 256 + ai * 128 + wr * 64 + m * 16 + fr; bf16_t* qp = Q + (size_t)row * 768;
            if (u.pn < 2) { EPI_COLS { const int h = 2 * u.pn + bj, d = wc * 32 + n * 16 + 4 * fq; *(u32x2*)(qp + h * 192 + d) = pack4(acc[ai][bj][m][n] * QSCALE); } }
            else { const int pos = tok_pos(row);
                _Pragma("unroll") for (int n = 0; n < 2; ++n) { f32x4 o1, o2;
                    _Pragma("unroll") for (int j = 0; j < 4; ++j) { float c, s; rope_cs(pos, n * 16 + 4 * fq + j, c, s); const float x1 = acc[ai][0][m][n][j], x2 = acc[ai][1][m][n][j];
                        o1[j] = (x1 * c - x2 * s) * QSCALE; o2[j] = (x2 * c + x1 * s) * QSCALE; }
                    *(u32x2*)(qp + wc * 192 + 128 + n * 16 + 4 * fq) = pack4(o1); *(u32x2*)(qp + wc * 192 + 160 + n * 16 + 4 * fq) = pack4(o2); } }
        }
    }
};
struct EpiGlu {
    static constexpr bool PERM = true, AFTER_DRAIN = false, MIDK = false;
    bf16_t* MIX; float* ST;
    __device__ __forceinline__ void operator()(const Acc& acc, const Unit& u, int wr, int wc, int fr, int fq) const {
        EPI_ROWS { const int row = u.pm * 256 + ai * 128 + wr * 64 + m * 16 + fr; float q = 0.f; u32x2 h[2];
            _Pragma("unroll") for (int n = 0; n < 2; ++n) { const f32x4 v = acc[ai][0][m][n], g = acc[ai][1][m][n]; f32x4 o;
                _Pragma("unroll") for (int j = 0; j < 4; ++j) { o[j] = v[j] * __builtin_amdgcn_rcpf(1.f + __builtin_amdgcn_exp2f(-g[j] * LOG2E)); q += o[j] * o[j]; }
                h[n] = pack4(o); }
            u32x4 w; w.x = h[0].x; w.y = h[0].y; w.z = h[1].x; w.w = h[1].y;
            *(u32x4*)(MIX + (size_t)row * 1024 + u.pn * 128 + wc * 32 + 8 * fq) = w;
            q += __shfl_xor(q, 16); q += __shfl_xor(q, 32);
            if (fq == 0) ST[(size_t)(u.pn * 4 + wc) * MTOK + row] = q; }
    }
};
__device__ __forceinline__ void ln_stats16(const float* PS, const float* PQ, int row, float& mu, float& rstd) {
    float s = 0.f, q = 0.f;
#pragma unroll
    for (int i = 0; i < 16; ++i) { s += PS[(size_t)i * MTOK + row]; q += PQ[(size_t)i * MTOK + row]; }
    mu = s * (1.f / 1024.f); const float var = q * (1.f / 1024.f) - mu * mu; rstd = rsqrtf(var + EPSN);
}
template <int MODE> struct EpiRes {
    static constexpr bool PERM = true, AFTER_DRAIN = false, MIDK = (MODE == 0);
    const float* xp; const float* xs; float* R; bf16_t* Rb; const float* PSin; const float* PQin; const float* g; const float* b; float* PSout; float* PQout; const LAS float* tab;
    __device__ __forceinline__ void mid(Acc& acc, const Unit& u, int wr, int fr) const {
        EPI_ROWS { const float ratio = tab[(u.idx & 1) * 512 + ai * 128 + wr * 64 + m * 16 + fr];
            EPI_COLS acc[ai][bj][m][n] *= ratio; }
    }
    __device__ __forceinline__ void operator()(const Acc& acc, const Unit& u, int wr, int wc, int fr, int fq) const {
        const int c0 = u.pn * 256 + wc * 32 + 8 * fq;
        EPI_ROWS { const int row = u.pm * 256 + ai * 128 + wr * 64 + m * 16 + fr; float rowscale = 1.f, mu = 0.f, rstd = 1.f;
            if (MODE == 0) rowscale = tab[(u.idx & 1) * 512 + 256 + ai * 128 + wr * 64 + m * 16 + fr]; else { mu = tab[u.idx * 512 + ai * 128 + wr * 64 + m * 16 + fr]; rstd = tab[u.idx * 512 + 256 + ai * 128 + wr * 64 + m * 16 + fr]; }
            const float* rsrc = MODE == 0 ? (row < TP ? xp + (size_t)row * 1024 : xs + (size_t)(row - TP) * 1024) : R + (size_t)row * 1024;
            float s = 0.f, q = 0.f;
            EPI_COLS { const int col = c0 + bj * 128 + n * 4; f32x4 res = *(const f32x4*)(rsrc + col);
                if (MODE == 1) { const f32x4 g4 = *(const f32x4*)(g + col), b4 = *(const f32x4*)(b + col); res = (res - mu) * rstd * g4 + b4; }
                const f32x4 v = res * ALPHA + acc[ai][bj][m][n] * rowscale;
                s += (v[0] + v[1]) + (v[2] + v[3]); q += (v[0] * v[0] + v[1] * v[1]) + (v[2] * v[2] + v[3] * v[3]);
                *(f32x4*)(R + (size_t)row * 1024 + col) = v;
                if (Rb) *(u32x2*)(Rb + (size_t)row * 1024 + col) = pack4(v); }
            s += __shfl_xor(s, 16); s += __shfl_xor(s, 32); q += __shfl_xor(q, 16); q += __shfl_xor(q, 32);
            if (fq == 0) { PSout[(size_t)(u.pn * 4 + wc) * MTOK + row] = s; PQout[(size_t)(u.pn * 4 + wc) * MTOK + row] = q; } }
    }
};
template <int ACT> struct EpiLnAct {
    static constexpr bool PERM = true, AFTER_DRAIN = false, MIDK = false;
    const LAS float* tab; const float* cs; const float* bw; bf16_t* O; int ldc;
    __device__ __forceinline__ void operator()(const Acc& acc, const Unit& u, int wr, int wc, int fr, int fq) const {
        const int c0 = u.pn * 256 + wc * 32 + 8 * fq; f32x4 cs4[2][2], bw4[2][2];
        EPI_COLS { cs4[bj][n] = *(const f32x4*)(cs + c0 + bj * 128 + n * 4); bw4[bj][n] = *(const f32x4*)(bw + c0 + bj * 128 + n * 4); }
        EPI_ROWS { const int row = u.pm * 256 + ai * 128 + wr * 64 + m * 16 + fr; const float mu = tab[u.idx * 512 + ai * 128 + wr * 64 + m * 16 + fr], rstd = tab[u.idx * 512 + 256 + ai * 128 + wr * 64 + m * 16 + fr];
            _Pragma("unroll") for (int bj = 0; bj < 2; ++bj) { u32x2 h[2];
                _Pragma("unroll") for (int n = 0; n < 2; ++n) { f32x4 v = (acc[ai][bj][m][n] - cs4[bj][n] * mu) * rstd + bw4[bj][n];
                    if (ACT == 0) v = v * XSCALE; else { _Pragma("unroll") for (int j = 0; j < 4; ++j) { const float r = fmaxf(v[j], 0.f); v[j] = r * r; } }
                    h[n] = pack4(v); }
                u32x4 w; w.x = h[0].x; w.y = h[0].y; w.z = h[1].x; w.w = h[1].y;
                *(u32x4*)(O + (size_t)row * ldc + c0 + bj * 128) = w; } }
    }
};

__device__ __forceinline__ void wo_fill_tab(const Unit& u, const float* STssm, const float* STmla, LAS float* tab) {
    const int t = threadIdx.x;
    if (t < 256) { const int row = u.pm * 256 + t; float s1 = 0.f, s2 = 0.f;
#pragma unroll
        for (int i = 0; i < 16; ++i) s1 += STssm[(size_t)i * MTOK + row];
#pragma unroll
        for (int i = 0; i < 4; ++i) s2 += STmla[(size_t)i * MTOK + row];
        const float r1 = rsqrtf(s1 * (1.f / 512.f) + EPSN), r2 = rsqrtf(s2 * (1.f / 512.f) + EPSN);
        tab[(u.idx & 1) * 512 + t] = r1 / r2; tab[(u.idx & 1) * 512 + 256 + t] = r2; }
}

__device__ __forceinline__ void ln_fill_tab(const pg8::StaticOrder& S, const float* PS, const float* PQ, LAS float* tab) {
    const int t = threadIdx.x; Unit u;
    if (t < 256) {
#pragma unroll 1
        for (int i = 0; i < 5; ++i) if (S.next(i, u)) { float mu, rstd; ln_stats16(PS, PQ, u.pm * 256 + t, mu, rstd); tab[i * 512 + t] = mu; tab[i * 512 + 256 + t] = rstd; } }
    __syncthreads();
}

template <int DQK, int DKN, int DV, bool SPLITDV>
__device__ __forceinline__ void attn_unit(LAS unsigned char* lds, const bf16_t* Qp, int ldq, const bf16_t* Kn, int ldkn, const bf16_t* Kpe, const bf16_t* Vt, int ldvt,
                                          int ntiles, int kvlim, bf16_t* Op, int ldo, float* statp, int nrows) {
    constexpr int NS = DQK / 16, KROWB = DQK * 2 + 16, VROWB = 144, KTILE = 64 * KROWB, VTILE = DV * VROWB, STAGE = KTILE + VTILE;
    constexpr int CPR = DQK / 8, KCH = 64 * CPR / 512, VCH = DV * 8 / 512, NKH = SPLITDV ? 2 : 1, NDB = 4;
    static_assert((SPLITDV ? DV / 64 : DV / 32) == NDB, "value tiling");
    int tid_ = threadIdx.x; asm volatile("" : "+v"(tid_));
    const int tid = tid_, wid = __builtin_amdgcn_readfirstlane(tid >> 6), lane = tid & 63, r32 = lane & 31, hi = lane >> 5, rg = wid & 3, grp = wid >> 2;
    const int keyoff = SPLITDV ? 0 : 32 * grp, dbase = SPLITDV ? grp * (DV / 2) : 0;
    const bool wact = kvlim > 0;
    bf16x8 qf[NS];
    { const bf16_t* qrow = Qp + (size_t)(rg * 32 + r32) * ldq + hi * 8;
#pragma unroll
      for (int s = 0; s < NS; ++s) qf[s] = wact ? *(const bf16x8*)(qrow + 16 * s) : (bf16x8){0, 0, 0, 0, 0, 0, 0, 0}; }
    constexpr bool KREG = (CPR == 32) && (DKN == DQK);
    const bf16_t* kp[KREG ? 1 : KCH]; int kst[KREG ? 1 : KCH], kld[KREG ? 1 : KCH];
    if constexpr (KREG) { const int row = tid >> 5, cc = tid & 31; kp[0] = Kn + (size_t)row * ldkn + cc * 8; kst[0] = 64 * ldkn; kld[0] = row * KROWB + cc * 16; }
    else {
#pragma unroll
        for (int i = 0; i < KCH; ++i) { const int c = tid + 512 * i, row = c / CPR, cc = c - row * CPR;
            if (cc < DKN / 8) { kp[i] = Kn + (size_t)row * ldkn + cc * 8; kst[i] = 64 * ldkn; } else { kp[i] = Kpe + (size_t)row * 64 + (cc - DKN / 8) * 8; kst[i] = 64 * 64; }
            kld[i] = row * KROWB + cc * 16; } }
    const bf16_t* vp0 = Vt + (size_t)(tid >> 3) * ldvt + (tid & 7) * 8; const int vld0 = KTILE + (tid >> 3) * VROWB + (tid & 7) * 16;
#define KP(i) (KREG ? kp[0] + (size_t)(i) * 16 * ldkn : kp[KREG ? 0 : (i)])
#define KST(i) kst[KREG ? 0 : (i)]
#define KLD(i) (KREG ? kld[0] + (i) * 16 * KROWB : kld[KREG ? 0 : (i)])
    u32x4 sk[KCH], sv[VCH];
#define AT_ISSUE_K(t) do { _Pragma("unroll") for (int i = 0; i < KCH; ++i) sk[i] = *(const u32x4*)(KP(i) + (size_t)(t) * KST(i)); } while (0)
#define AT_ISSUE_V(t) do { _Pragma("unroll") for (int i = 0; i < VCH; ++i) sv[i] = *(const u32x4*)(vp0 + (size_t)(i) * 64 * ldvt + (size_t)(t) * 64); } while (0)
#define AT_ISSUE(t) do { AT_ISSUE_K(t); AT_ISSUE_V(t); } while (0)
#define AT_WRITE(st) do { _Pragma("unroll") for (int i = 0; i < KCH; ++i) *(LAS u32x4*)(lds + (st) * STAGE + KLD(i)) = sk[i]; \
                          _Pragma("unroll") for (int i = 0; i < VCH; ++i) *(LAS u32x4*)(lds + (st) * STAGE + vld0 + (i) * 64 * VROWB) = sv[i]; } while (0)
    f32x16 o[NDB];
#pragma unroll
    for (int d = 0; d < NDB; ++d)
#pragma unroll
        for (int r = 0; r < 16; ++r) o[d][r] = 0.f;
    float mrun = -1e30f, lrun = 0.f;
    const int kboff = (keyoff + r32) * KROWB + hi * 16, vboff = KTILE + (dbase + r32) * VROWB + keyoff * 2 + hi * 16;
    AT_ISSUE(0); AT_WRITE(0); __syncthreads();
    if (!SPLITDV && ntiles > 1) AT_ISSUE(1);
    for (int t = 0; t < ntiles; ++t) {
        const int st = t & 1;
        if (SPLITDV) { if (t + 1 < ntiles) AT_ISSUE_K(t + 1); }
        else if (grp == 1) { if (t + 1 < ntiles) AT_WRITE(st ^ 1); if (t + 2 < ntiles) AT_ISSUE(t + 2); }
        if (t * 64 + keyoff < kvlim) {
            f32x16 p[NKH];
            const LAS unsigned char* kb = lds + st * STAGE + kboff;
#pragma unroll
            for (int kh = 0; kh < NKH; ++kh) {
#pragma unroll
                for (int r = 0; r < 16; ++r) p[kh][r] = 0.f;
#pragma unroll
                for (int s = 0; s < NS; ++s) { const bf16x8 kf = *(const LAS bf16x8*)(kb + kh * 32 * KROWB + s * 32); p[kh] = __builtin_amdgcn_mfma_f32_32x32x16_bf16(kf, qf[s], p[kh], 0, 0, 0); }
            }
            float tmax = p[0][0];
#pragma unroll
            for (int kh = 0; kh < NKH; ++kh)
#pragma unroll
                for (int r = 0; r < 16; ++r) tmax = fmaxf(tmax, p[kh][r]);
            { auto rr = __builtin_amdgcn_permlane32_swap(__float_as_uint(tmax), __float_as_uint(tmax), false, false); tmax = fmaxf(__uint_as_float(rr[0]), __uint_as_float(rr[1])); }
            const float mnew = fmaxf(mrun, tmax);
            if (__any(mnew > mrun)) { const float alpha = __builtin_amdgcn_exp2f(mrun - mnew); lrun *= alpha; mrun = mnew;
#pragma unroll
                for (int d = 0; d < NDB; ++d)
#pragma unroll
                    for (int r = 0; r < 16; ++r) o[d][r] *= alpha; }
            float ls = 0.f;
#pragma unroll
            for (int kh = 0; kh < NKH; ++kh)
#pragma unroll
                for (int r = 0; r < 16; ++r) { p[kh][r] = __builtin_amdgcn_exp2f(p[kh][r] - mrun); ls += p[kh][r]; }
            lrun += ls;
            bf16x8 pf[NKH * 2];
#pragma unroll
            for (int kh = 0; kh < NKH; ++kh)
#pragma unroll
                for (int s2 = 0; s2 < 2; ++s2) { u32x4 w; w.x = cvt_pk_bf16(p[kh][8 * s2 + 0], p[kh][8 * s2 + 1]); w.y = cvt_pk_bf16(p[kh][8 * s2 + 2], p[kh][8 * s2 + 3]);
                    w.z = cvt_pk_bf16(p[kh][8 * s2 + 4], p[kh][8 * s2 + 5]); w.w = cvt_pk_bf16(p[kh][8 * s2 + 6], p[kh][8 * s2 + 7]); pf[kh * 2 + s2] = *(bf16x8*)&w; }
            if (SPLITDV && t + 1 < ntiles) AT_ISSUE_V(t + 1);
            const LAS unsigned char* vb = lds + st * STAGE + vboff;
#pragma unroll
            for (int d = 0; d < NDB; ++d)
#pragma unroll
                for (int ks = 0; ks < NKH * 2; ++ks) { const bf16x8 vf = *(const LAS bf16x8*)(vb + d * 32 * VROWB + ks * 32); o[d] = __builtin_amdgcn_mfma_f32_32x32x16_bf16(vf, pf[ks], o[d], 0, 0, 0); }
        } else if (SPLITDV && t + 1 < ntiles) AT_ISSUE_V(t + 1);
        if (SPLITDV && t + 1 < ntiles) AT_WRITE(st ^ 1);
        if (!SPLITDV && grp == 0) { if (t + 1 < ntiles) AT_WRITE(st ^ 1); if (t + 2 < ntiles) AT_ISSUE(t + 2); }
        __syncthreads();
    }
#undef AT_ISSUE
#undef AT_ISSUE_K
#undef AT_ISSUE_V
#undef KP
#undef KST
#undef KLD
#undef AT_WRITE
    lrun += __shfl_xor(lrun, 32);
    if (!SPLITDV) {
        LAS float* MO = (LAS float*)lds; LAS float* MM = (LAS float*)(lds + 65536); LAS float* ML = (LAS float*)(lds + 65536 + 1024);
        if (grp == 1) {
#pragma unroll
            for (int d = 0; d < NDB; ++d)
#pragma unroll
                for (int r = 0; r < 16; ++r) MO[(rg * 64 + d * 16 + r) * 64 + lane] = o[d][r];
            MM[rg * 64 + lane] = mrun; ML[rg * 64 + lane] = lrun;
        }
        __syncthreads();
        if (grp == 0) {
            const float m1 = MM[rg * 64 + lane], l1 = ML[rg * 64 + lane], ms = fmaxf(mrun, m1);
            const float a0 = __builtin_amdgcn_exp2f(mrun - ms), a1 = __builtin_amdgcn_exp2f(m1 - ms);
            lrun = lrun * a0 + l1 * a1;
#pragma unroll
            for (int d = 0; d < NDB; ++d)
#pragma unroll
                for (int r = 0; r < 16; ++r) o[d][r] = o[d][r] * a0 + MO[(rg * 64 + d * 16 + r) * 64 + lane] * a1;
        }
    }
    if (SPLITDV || grp == 0) {
        const float inv = __builtin_amdgcn_rcpf(lrun); const int row = rg * 32 + r32; const bool ok = wact && row < nrows; float ss = 0.f;
        bf16_t* orow = Op + (size_t)row * ldo + dbase + 4 * hi;
#pragma unroll
        for (int d = 0; d < NDB; ++d)
#pragma unroll
            for (int g4 = 0; g4 < 4; ++g4) { f32x4 v; v[0] = o[d][4 * g4] * inv; v[1] = o[d][4 * g4 + 1] * inv; v[2] = o[d][4 * g4 + 2] * inv; v[3] = o[d][4 * g4 + 3] * inv;
                ss += (v[0] * v[0] + v[1] * v[1]) + (v[2] * v[2] + v[3] * v[3]);
                if (ok) *(u32x2*)(orow + 32 * d + 8 * g4) = pack4(v); }
        ss += __shfl_xor(ss, 32);
        if (statp && ok && hi == 0) statp[row] = ss;
    }
    __syncthreads();
}


__device__ __forceinline__ float gelu_tanh(float x) { const float z2 = 1.5957691216057308f * (x + 0.044715f * x * x * x); return x * __builtin_amdgcn_rcpf(1.f + __builtin_amdgcn_exp2f(-z2 * LOG2E)); }
struct SsmU { bf16x8 hi, lo; };
__device__ __forceinline__ void split_hilo(f32x4 a, f32x4 b, u32x4& hi, u32x4& lo) {
    hi.x = cvt_pk_bf16(a[0], a[1]); hi.y = cvt_pk_bf16(a[2], a[3]); hi.z = cvt_pk_bf16(b[0], b[1]); hi.w = cvt_pk_bf16(b[2], b[3]);
    lo.x = cvt_pk_bf16(a[0] - __uint_as_float(hi.x << 16), a[1] - __uint_as_float(hi.x & 0xffff0000u)); lo.y = cvt_pk_bf16(a[2] - __uint_as_float(hi.y << 16), a[3] - __uint_as_float(hi.y & 0xffff0000u));
    lo.z = cvt_pk_bf16(b[0] - __uint_as_float(hi.z << 16), b[1] - __uint_as_float(hi.z & 0xffff0000u)); lo.w = cvt_pk_bf16(b[2] - __uint_as_float(hi.w << 16), b[3] - __uint_as_float(hi.w & 0xffff0000u));
}
struct SsmW { float lr, li; bf16x8 ab[8]; };
__device__ __forceinline__ void ssm_load_w(const Frame& F, int g, int lane, SsmW& w) {
    const float* LAM = (const float*)(F.ws + W_LAM); const float* BB = (const float*)(F.ws + W_BB);
    w.lr = LAM[g * 64 + lane]; w.li = LAM[2048 + g * 64 + lane];
    const int q = lane >> 4;
#pragma unroll
    for (int blk = 0; blk < 8; ++blk) { const int row = 16 * blk + (lane & 15);
        const float* bp = (row < 64 ? BB + (size_t)(g * 64 + row) * 16 : BB + 32768 + (size_t)(g * 64 + row - 64) * 16) + 8 * (q & 1);
        u32x4 hi, lo; split_hilo(*(const f32x4*)bp, *(const f32x4*)(bp + 4), hi, lo); const u32x4 sel = q < 2 ? hi : lo; w.ab[blk] = *(const bf16x8*)&sel; }
}
__device__ __forceinline__ void ssm_load_u(const float* U, int tb, int g, int lane, SsmU& ub) {
    const int q = lane >> 4; const float* up = U + (size_t)(tb + (lane & 15)) * 512 + g * 16 + 8 * (q & 1);
    u32x4 hi, lo; split_hilo(*(const f32x4*)up, *(const f32x4*)(up + 4), hi, lo); if (q >= 2) lo = (u32x4){0u, 0u, 0u, 0u};
    ub.hi = *(const bf16x8*)&hi; ub.lo = *(const bf16x8*)&lo;
}
template <bool WR> __device__ __forceinline__ void ssm_block16(const SsmW& w, const SsmU& ub, int lane, float& xr, float& xi, LAS float* XW) {
#pragma unroll
    for (int blk = 0; blk < 8; ++blk) { f32x4 d = {0.f, 0.f, 0.f, 0.f};
        d = __builtin_amdgcn_mfma_f32_16x16x32_bf16(w.ab[blk], ub.hi, d, 0, 0, 0); d = __builtin_amdgcn_mfma_f32_16x16x32_bf16(w.ab[blk], ub.lo, d, 0, 0, 0);
        *(LAS f32x4*)(XW + (lane & 15) * 132 + 16 * blk + 4 * (lane >> 4)) = d; }
    float br[16], bi[16];
#pragma unroll
    for (int t = 0; t < 16; ++t) { br[t] = XW[t * 132 + lane]; bi[t] = XW[t * 132 + 64 + lane]; }
#pragma unroll
    for (int t = 0; t < 16; ++t) { const float nr = fmaf(w.lr, xr, fmaf(-w.li, xi, br[t])), ni = fmaf(w.lr, xi, fmaf(w.li, xr, bi[t])); xr = nr; xi = ni;
        if (WR) { XW[t * 132 + lane] = xr; XW[t * 132 + 64 + lane] = xi; } }
}
__device__ __forceinline__ void ssm_pass_a(const Frame& F) {
    const float* U = F.out; float* SEND = (float*)(F.ws + W_SEND); LAS float* XW = (LAS float*)(F.lds + F.wid * 8448);
    const int g = (F.bid * 8 + F.wid) & 31, p = F.lane; SsmW w; ssm_load_w(F, g, p, w);
    for (int it = F.bid * 8 + F.wid; it < 256 * 32; it += F.G * 8) { const int c = it >> 5;
        float xr = 0.f, xi = 0.f;
        SsmU ub[4];
#pragma unroll
        for (int sb = 0; sb < 4; ++sb) ssm_load_u(U, c * 64 + sb * 16, g, p, ub[sb]);
#pragma unroll
        for (int sb = 0; sb < 4; ++sb) ssm_block16<false>(w, ub[sb], p, xr, xi, XW);
        SEND[(size_t)c * 4096 + g * 64 + p] = xr; SEND[(size_t)c * 4096 + 2048 + g * 64 + p] = xi; }
}
__device__ __forceinline__ void ssm_pass_b(const Frame& F, int b0) {
    float* SEND = (float*)(F.ws + W_SEND); const float* LAM64 = (const float*)(F.ws + W_LAM64);
    const int i = b0 * 512 + F.tid; if (i < 0 || i >= 2048) return;
    const float l6r = LAM64[i], l6i = LAM64[2048 + i]; float xr = 0.f, xi = 0.f;
    float nr_[16], ni_[16];
#pragma unroll
    for (int j = 0; j < 16; ++j) { nr_[j] = SEND[(size_t)j * 4096 + i]; ni_[j] = SEND[(size_t)j * 4096 + 2048 + i]; }
    for (int c0 = 0; c0 < 256; c0 += 16) { float sr[16], si[16];
#pragma unroll
        for (int j = 0; j < 16; ++j) { sr[j] = nr_[j]; si[j] = ni_[j]; }
        if (c0 + 16 < 256) {
#pragma unroll
            for (int j = 0; j < 16; ++j) { nr_[j] = SEND[(size_t)(c0 + 16 + j) * 4096 + i]; ni_[j] = SEND[(size_t)(c0 + 16 + j) * 4096 + 2048 + i]; } }
#pragma unroll
        for (int j = 0; j < 16; ++j) { SEND[(size_t)(c0 + j) * 4096 + i] = xr; SEND[(size_t)(c0 + j) * 4096 + 2048 + i] = xi;
            const float nr = fmaf(l6r, xr, fmaf(-l6i, xi, sr[j])), ni = fmaf(l6r, xi, fmaf(l6i, xr, si[j])); xr = nr; xi = ni; } }
}
__device__ __forceinline__ void ssm_pass_c(const Frame& F) {
    const float* U = F.out; bf16_t* YG = (bf16_t*)((unsigned char*)F.out + 36 * MiB); const float* SEND = (const float*)(F.ws + W_SEND);
    const float* c_re = F.a->in[18]; const float* c_im = F.a->in[19]; const float* dsk = F.a->in[20];
    LAS float* XW = (LAS float*)(F.lds + F.wid * 8448);
    const int p = F.lane, hq = 4 * (F.lane >> 4), tl = F.lane & 15;
    const int g = (F.bid * 8 + F.wid) & 31; SsmW w; ssm_load_w(F, g, p, w);
    bf16x8 cab[4];
#pragma unroll
    for (int ks = 0; ks < 4; ++ks) { const int k = 32 * ks + 8 * (F.lane >> 4); const float* cp = ks < 2 ? c_re + (size_t)(g * 16 + tl) * 64 + k : c_im + (size_t)(g * 16 + tl) * 64 + (k - 64);
        f32x4 a = *(const f32x4*)cp, b = *(const f32x4*)(cp + 4); if (ks >= 2) { a = -a; b = -b; }
        u32x4 w; w.x = cvt_pk_bf16(a[0], a[1]); w.y = cvt_pk_bf16(a[2], a[3]); w.z = cvt_pk_bf16(b[0], b[1]); w.w = cvt_pk_bf16(b[2], b[3]); cab[ks] = *(bf16x8*)&w; }
    const f32x4 ds4 = *(const f32x4*)(dsk + g * 16 + hq);
    for (int it = F.bid * 8 + F.wid; it < 9216; it += F.G * 8) {
        const bool prompt = it < 8192; const int c = prompt ? (it >> 5) : ((it - 8192) >> 5);
        float xr, xi; int tok0, nsb;
        if (prompt) { xr = SEND[(size_t)c * 4096 + g * 64 + p]; xi = SEND[(size_t)c * 4096 + 2048 + g * 64 + p];
            tok0 = c * 64; nsb = 4;
        } else { xr = F.a->in[5][(size_t)(c * 32 + g) * 64 + p]; xi = F.a->in[6][(size_t)(c * 32 + g) * 64 + p]; tok0 = TP + c * 32; nsb = 2; }
        SsmU ub[4]; f32x4 u4a[4];
#pragma unroll
        for (int sb = 0; sb < 4; ++sb) { ssm_load_u(U, tok0 + sb * 16, g, p, ub[sb]); u4a[sb] = *(const f32x4*)(U + (size_t)(tok0 + sb * 16 + tl) * 512 + g * 16 + hq); }
#pragma unroll
        for (int sb = 0; sb < 4; ++sb) { if (sb >= nsb) break; const int tb = tok0 + sb * 16;
            ssm_block16<true>(w, ub[sb], p, xr, xi, XW);
            f32x4 y0 = {0.f, 0.f, 0.f, 0.f}, y1 = {0.f, 0.f, 0.f, 0.f};
#pragma unroll
            for (int ks = 0; ks < 4; ++ks) { const LAS float* xp = XW + tl * 132 + 32 * ks + 8 * (F.lane >> 4); const f32x4 xa = *(const LAS f32x4*)xp, xb = *(const LAS f32x4*)(xp + 4);
                u32x4 w; w.x = cvt_pk_bf16(xa[0], xa[1]); w.y = cvt_pk_bf16(xa[2], xa[3]); w.z = cvt_pk_bf16(xb[0], xb[1]); w.w = cvt_pk_bf16(xb[2], xb[3]); const bf16x8 xf = *(bf16x8*)&w;
                if (ks & 1) y1 = __builtin_amdgcn_mfma_f32_16x16x32_bf16(cab[ks], xf, y1, 0, 0, 0); else y0 = __builtin_amdgcn_mfma_f32_16x16x32_bf16(cab[ks], xf, y0, 0, 0, 0); }
            f32x4 y = y0 + y1 + ds4 * u4a[sb];
#pragma unroll
            for (int j = 0; j < 4; ++j) y[j] = gelu_tanh(y[j]);
            *(u32x2*)(YG + (size_t)(tb + tl) * 512 + g * 16 + hq) = pack4(y);
        }
        if (prompt) { if (c == 255) { F.out[O_SREP + g * 64 + p] = xr; F.out[O_SIMP + g * 64 + p] = xi; } }
        else { F.out[O_SRES + (size_t)(c * 32 + g) * 64 + p] = xr; F.out[O_SIMS + (size_t)(c * 32 + g) * 64 + p] = xi; }
    }
}

__device__ __forceinline__ float wave_sum(float v) {
#pragma unroll
    for (int o = 32; o > 0; o >>= 1) v += __shfl_xor(v, o);
    return v;
}
__device__ __forceinline__ void post_rows(const Frame& F) {
    const float* PQ = (const float*)(F.ws + A_PQ); bf16_t* CQN = (bf16_t*)(F.ws + A_CQN); bf16_t* CKV = (bf16_t*)(F.ws + A_CKV); bf16_t* KPE = (bf16_t*)(F.ws + A_KPE);
    const float* gkv = F.a->in[12];
    const int l = F.lane, rstep = F.G * 8; int row = F.bid * 8 + F.wid;
    f32x4 nq0 = {0.f, 0.f, 0.f, 0.f}, nkv = nq0; u32x2 nq1 = {0u, 0u}; float npe = 0.f;
    if (row < MTOK) { const float* pr = PQ + (size_t)row * 768; nq0 = *(const f32x4*)(pr + 4 * l); nq1 = *(const u32x2*)(pr + 256 + 2 * l); nkv = *(const f32x4*)(pr + 384 + 4 * l); npe = pr[640 + l]; }
    for (; row < MTOK; row += rstep) {
        const f32x4 q0 = nq0, kv = nkv; const u32x2 q1r = nq1; const float pe = npe; const float q10 = __uint_as_float(q1r.x), q11 = __uint_as_float(q1r.y);
        if (row + rstep < MTOK) { const float* pr = PQ + (size_t)(row + rstep) * 768; nq0 = *(const f32x4*)(pr + 4 * l); nq1 = *(const u32x2*)(pr + 256 + 2 * l); nkv = *(const f32x4*)(pr + 384 + 4 * l); npe = pr[640 + l]; }
        const float sq = wave_sum((q0[0] * q0[0] + q0[1] * q0[1]) + (q0[2] * q0[2] + q0[3] * q0[3]) + q10 * q10 + q11 * q11);
        const float skv = wave_sum((kv[0] * kv[0] + kv[1] * kv[1]) + (kv[2] * kv[2] + kv[3] * kv[3]));
        const float rq = rsqrtf(sq * (1.f / 384.f) + EPSN), rkv = rsqrtf(skv * (1.f / 256.f) + EPSN);
        *(u32x2*)(CQN + (size_t)row * 384 + 4 * l) = pack4(q0 * rq); *(unsigned*)(CQN + (size_t)row * 384 + 256 + 2 * l) = cvt_pk_bf16(q10 * rq, q11 * rq);
        const f32x4 g4 = *(const f32x4*)(gkv + 4 * l); const f32x4 kvn = kv * rkv * g4; const int kr = tok_kvrow(row);
        float* oc = row < TP ? F.out + O_CKVP + (size_t)row * 256 : F.out + O_CKVS + (size_t)(row - TP) * 256; float* ok = row < TP ? F.out + O_KPEP + (size_t)row * 64 : F.out + O_KPES + (size_t)(row - TP) * 64;
        *(f32x4*)(oc + 4 * l) = kvn; *(u32x2*)(CKV + (size_t)kr * 256 + 4 * l) = pack4(kvn);
        float c, s; rope_cs(tok_pos(row), l & 31, c, s); const float other = __shfl_xor(pe, 32);
        const float ro = l < 32 ? pe * c - other * s : pe * c + other * s;
        ok[l] = ro; const float ron = __shfl_xor(ro, 1); if ((l & 1) == 0) *(unsigned*)(KPE + (size_t)swap23(kr) * 64 + l) = cvt_pk_bf16(ro, ron); }
}
__device__ __forceinline__ void final_ln(const Frame& F) {
    const float* g = F.a->in[32] + 2048; const float* b = F.a->in[33] + 2048;
    const int rstep = F.G * 8; int row = F.bid * 8 + F.wid; f32x4 nv[4];
#pragma unroll
    for (int i = 0; i < 4; ++i) nv[i] = row < MTOK ? *(const f32x4*)(F.out + O_Y + (size_t)row * 1024 + i * 256 + 4 * F.lane) : (f32x4){0.f, 0.f, 0.f, 0.f};
    for (; row < MTOK; row += rstep) { float* pr = F.out + O_Y + (size_t)row * 1024; f32x4 v[4]; float s = 0.f;
#pragma unroll
        for (int i = 0; i < 4; ++i) { v[i] = nv[i]; s += (v[i][0] + v[i][1]) + (v[i][2] + v[i][3]); }
        if (row + rstep < MTOK) {
#pragma unroll
            for (int i = 0; i < 4; ++i) nv[i] = *(const f32x4*)(pr + (size_t)rstep * 1024 + i * 256 + 4 * F.lane); }
        if (row >= TP) {
            const float* ST2 = (const float*)(F.ws + W_ST2); float mu2, rstd2; ln_stats16(ST2, ST2 + 16 * MTOK, row, mu2, rstd2);
            const float* SL = (const float*)(F.ws + A_R2B) + (size_t)(row - TP) * 1024; s = 0.f;
#pragma unroll
            for (int i = 0; i < 4; ++i) { const int c = i * 256 + 4 * F.lane; const f32x4 g1 = *(const f32x4*)(F.a->in[32] + 1024 + c), b1 = *(const f32x4*)(F.a->in[33] + 1024 + c);
                f32x4 a = (v[i] - mu2) * rstd2 * g1 + b1; a = a * ALPHA;
#pragma unroll
                for (int k = 0; k < 8; ++k) a = a + *(const f32x4*)(SL + (size_t)k * 1024 * 1024 + c);
                v[i] = a; s += (a[0] + a[1]) + (a[2] + a[3]); } }
        const float mu = wave_sum(s) * (1.f / 1024.f); float q = 0.f;
#pragma unroll
        for (int i = 0; i < 4; ++i) { const f32x4 d = v[i] - mu; q += (d[0] * d[0] + d[1] * d[1]) + (d[2] * d[2] + d[3] * d[3]); }
        const float rstd = rsqrtf(wave_sum(q) * (1.f / 1024.f) + EPSN);
#pragma unroll
        for (int i = 0; i < 4; ++i) { const f32x4 g4 = *(const f32x4*)(g + i * 256 + 4 * F.lane), b4 = *(const f32x4*)(b + i * 256 + 4 * F.lane); *(f32x4*)(pr + i * 256 + 4 * F.lane) = (v[i] - mu) * rstd * g4 + b4; } }
}

struct MapId { __device__ __forceinline__ int operator()(int n) const { return n; } };
struct MapWin { __device__ __forceinline__ int operator()(int n) const { return n < 1216 ? n : -1; } };
struct MapWq { __device__ __forceinline__ int operator()(int n) const { if (n < 512) return (n >> 7) * 192 + (n & 127); const int x = n - 512, part = x >> 7, h = (x >> 5) & 3, i = x & 31; return h * 192 + 128 + part * 32 + i; } };
struct MapWk { __device__ __forceinline__ int operator()(int n) const { return (n >> 7) * 256 + (n & 127); } };
struct MapWv { __device__ __forceinline__ int operator()(int n) const { return (n >> 7) * 256 + 128 + (n & 127); } };
struct MapGlu { __device__ __forceinline__ int operator()(int n) const { const int pn = n >> 8, bj = (n >> 7) & 1, x = n & 127; return bj * 512 + pn * 128 + x; } };
template <class CM, bool PERMK = false> __device__ __forceinline__ void wconv(const Frame& F, bf16_t* __restrict__ dst, const float* __restrict__ src, int ld, int K, int N, CM cm, const float* sc0, const float* sc1, int ksplit, int& rot) {
    const int ntn = N >> 5, ntiles = ntn * (K >> 6), tid = F.tid, kr = tid >> 3, nq = tid & 7;
    LAS float* T = (LAS float*)F.lds;
    for (int base = ((F.bid + F.G - rot % F.G) % F.G) * 4; base < ntiles; base += F.G * 4) { f32x4 v[4];
#pragma unroll
        for (int u = 0; u < 4; ++u) { const int tile = base + u; v[u] = (f32x4){0.f, 0.f, 0.f, 0.f};
            if (tile < ntiles) { const int tn = tile % ntn, tk = tile / ntn, col = cm(tn * 32), k = tk * 64 + kr;
                if (col >= 0) { v[u] = *(const f32x4*)(src + (size_t)k * ld + col + 4 * nq); if (sc0) v[u] = v[u] * (k < ksplit ? sc0[k] : sc1[k - ksplit]); } } }
#pragma unroll
        for (int u = 0; u < 4; ++u) {
#pragma unroll
            for (int j = 0; j < 4; ++j) T[u * 2112 + kr * 33 + 4 * nq + j] = v[u][j]; }
        __syncthreads();
        { const int half = tid >> 8, tt = tid & 255, n = tt >> 3, kq = tt & 7;
#pragma unroll
          for (int uu = 0; uu < 2; ++uu) { const int u = half * 2 + uu, tile = base + u;
              if (tile < ntiles) { const int tn = tile % ntn, tk = tile / ntn; float x[8];
#pragma unroll
                  for (int j = 0; j < 8; ++j) { const int pos = 8 * kq + j, kk = PERMK ? ((pos & ~12) | ((pos & 4) << 1) | ((pos & 8) >> 1)) : pos; x[j] = T[u * 2112 + kk * 33 + n]; }
                  u32x4 w; w.x = cvt_pk_bf16(x[0], x[1]); w.y = cvt_pk_bf16(x[2], x[3]); w.z = cvt_pk_bf16(x[4], x[5]); w.w = cvt_pk_bf16(x[6], x[7]);
                  *(u32x4*)(dst + (size_t)(tn * 32 + n) * K + tk * 64 + 8 * kq) = w; } } }
        __syncthreads(); }
    rot += (ntiles + 3) >> 2;
}
__device__ __forceinline__ void cvt_flat(const Frame& F, bf16_t* __restrict__ dst, const float* __restrict__ src, long n8) {
    const long gs = (long)F.G * 512;
    for (long base = (long)F.bid * 512 + F.tid; base < n8; base += 4 * gs) { f32x4 a[4], b[4];
#pragma unroll
        for (int u = 0; u < 4; ++u) { const long i = base + u * gs; const long ii = i < n8 ? i : 0; a[u] = *(const f32x4*)(src + ii * 8); b[u] = *(const f32x4*)(src + ii * 8 + 4); }
#pragma unroll
        for (int u = 0; u < 4; ++u) { const long i = base + u * gs; if (i < n8) { u32x4 w; w.x = cvt_pk_bf16(a[u][0], a[u][1]); w.y = cvt_pk_bf16(a[u][2], a[u][3]); w.z = cvt_pk_bf16(b[u][0], b[u][1]); w.w = cvt_pk_bf16(b[u][2], b[u][3]); *(u32x4*)(dst + i * 8) = w; } } }
}
__device__ __forceinline__ void colsum_job(const Frame& F, const float* W, int N, const float* g, const float* b, float* cs, float* bw, int rotb) {
    LAS float* red = (LAS float*)F.lds;
    const int seg = F.tid >> 4, col = F.tid & 15;
    for (int task = (F.bid + F.G - rotb % F.G) % F.G; task < N / 16; task += F.G) { const int n = task * 16 + col; float s = 0.f, t = 0.f;
#pragma unroll
        for (int j = 0; j < 32; ++j) { const int k = seg * 32 + j; const float w = W[(size_t)k * N + n]; s += bf16_round(w * g[k]); t = fmaf(b[k], w, t); }
        red[F.tid] = s; red[512 + F.tid] = t; __syncthreads();
        if (F.tid < 16) { float a = 0.f, c = 0.f;
#pragma unroll
            for (int i = 0; i < 32; ++i) { a += red[i * 16 + F.tid]; c += red[512 + i * 16 + F.tid]; }
            cs[n] = a; bw[n] = c; }
        __syncthreads(); }
}
__device__ __forceinline__ void ssm_consts(const Frame& F) {
    const int i = F.bid * 512 + F.tid; if (i >= 2048) return;
    const int g = i >> 6; float* LAM = (float*)(F.ws + W_LAM); float* LAM64 = (float*)(F.ws + W_LAM64); float* BB = (float*)(F.ws + W_BB);
    const double ar = F.a->in[14][i], ai = F.a->in[15][i], dt = exp((double)F.a->in[21][g]);
    const double mag = exp(ar * dt), lr = mag * cos(ai * dt), li = mag * sin(ai * dt);
    LAM[i] = (float)lr; LAM[2048 + i] = (float)li;
    double pr = lr, pi = li;
#pragma unroll
    for (int k = 0; k < 6; ++k) { const double nr = pr * pr - pi * pi, ni = 2.0 * pr * pi; pr = nr; pi = ni; }
    LAM64[i] = (float)pr; LAM64[2048 + i] = (float)pi;
    const double nr = lr - 1.0, ni = li, den = ar * ar + ai * ai, fr = (nr * ar + ni * ai) / den, fi = (ni * ar - nr * ai) / den;
#pragma unroll
    for (int h = 0; h < 16; ++h) { const double br = F.a->in[16][(size_t)i * 16 + h], bi = F.a->in[17][(size_t)i * 16 + h];
        BB[(size_t)i * 16 + h] = (float)(fr * br - fi * bi); BB[32768 + (size_t)i * 16 + h] = (float)(fr * bi + fi * br); }
}
__device__ __forceinline__ void cvt_caches(const Frame& F, int b0, int nb) {
    unsigned char* ws = F.ws; { bf16_t* CKV = (bf16_t*)(ws + A_CKV); bf16_t* KPE = (bf16_t*)(ws + A_KPE); const long gs = (long)nb * 512;
#pragma unroll 4
      for (long i = (long)b0 * 512 + F.tid; i < 32L * 1024 * 32; i += gs) { const int c8 = (int)(i & 31), j = (int)((i >> 5) & 1023), bb = (int)(i >> 15);
          const float* s = F.a->in[3] + ((size_t)(bb * 1024 + j) * 256 + c8 * 8); const f32x4 a = *(const f32x4*)s, b = *(const f32x4*)(s + 4);
          u32x4 w; w.x = cvt_pk_bf16(a[0], a[1]); w.y = cvt_pk_bf16(a[2], a[3]); w.z = cvt_pk_bf16(b[0], b[1]); w.w = cvt_pk_bf16(b[2], b[3]);
          *(u32x4*)(CKV + (size_t)(TP + bb * KVS + j) * 256 + c8 * 8) = w; }
#pragma unroll 2
      for (long i = (long)b0 * 512 + F.tid; i < 32L * 1024 * 8; i += gs) { const int c8 = (int)(i & 7), j = (int)((i >> 3) & 1023), bb = (int)(i >> 13);
          const float* s = F.a->in[4] + ((size_t)(bb * 1024 + j) * 64 + c8 * 8); const f32x4 a = *(const f32x4*)s, b = *(const f32x4*)(s + 4);
          u32x4 w; w.x = cvt_pk_bf16(a[0], a[1]); w.y = cvt_pk_bf16(a[2], a[3]); w.z = cvt_pk_bf16(b[0], b[1]); w.w = cvt_pk_bf16(b[2], b[3]);
          *(u32x4*)(KPE + (size_t)swap23(TP + bb * KVS + j) * 64 + c8 * 8) = w; } }
}
#ifndef PRO_DUP
#define PRO_DUP 0
#endif
#define DUPP(j) _Pragma("unroll") for (int rp_ = 0; rp_ < (((PRO_DUP >> (j)) & 1) ? 2 : 1); ++rp_)
__device__ __forceinline__ void prologue(const Frame& F) {
    unsigned char* ws = F.ws;
    DUPP(0) ssm_consts(F);
    int rot = 8;
    DUPP(1) {
    wconv(F, (bf16_t*)(ws + W_WIN), F.a->in[9], 1216, 1024, 1280, MapWin(), nullptr, nullptr, 0, rot);
    }
    DUPP(2) {
    if (F.G > 8) { if (F.bid >= 4) { Frame F2 = F; F2.bid = F.bid - 4; F2.G = F.G - 4; cvt_flat(F2, (bf16_t*)(ws + A_XB), F.a->in[0], (long)TP * 128); } }
    else cvt_flat(F, (bf16_t*)(ws + A_XB), F.a->in[0], (long)TP * 128);
    cvt_flat(F, (bf16_t*)(ws + A_XB) + (size_t)TP * 1024, F.a->in[1], (long)TS * 128);
    cvt_flat(F, (bf16_t*)(ws + W_MEMB), F.a->in[2], 256 * 128);
    }
    DUPP(1) {
    wconv(F, (bf16_t*)(ws + W_WXK), F.a->in[27], 1024, 1024, 1024, MapId(), nullptr, nullptr, 0, rot);
    wconv(F, (bf16_t*)(ws + W_WXV), F.a->in[28], 1024, 1024, 1024, MapId(), nullptr, nullptr, 0, rot);
    wconv(F, (bf16_t*)(ws + W_WQ), F.a->in[11], 768, 384, 768, MapWq(), F.a->in[10], F.a->in[10], 384, rot);
    wconv(F, (bf16_t*)(ws + W_WK), F.a->in[13], 1024, 256, 512, MapWk(), nullptr, nullptr, 0, rot);
    wconv(F, (bf16_t*)(ws + W_WV), F.a->in[13], 1024, 256, 512, MapWv(), nullptr, nullptr, 0, rot);
    wconv(F, (bf16_t*)(ws + W_WGLU), F.a->in[22], 1024, 512, 1024, MapGlu(), nullptr, nullptr, 0, rot);
    wconv(F, (bf16_t*)(ws + W_WO), F.a->in[25], 1024, 1024, 1024, MapId(), F.a->in[23], F.a->in[24], 512, rot);
    wconv(F, (bf16_t*)(ws + W_WXQ), F.a->in[26], 1024, 1024, 1024, MapId(), F.a->in[32], F.a->in[32], 1024, rot);
    wconv(F, (bf16_t*)(ws + W_WXO), F.a->in[29], 1024, 1024, 1024, MapId(), nullptr, nullptr, 0, rot);
    wconv(F, (bf16_t*)(ws + W_WFF1), F.a->in[30], 4096, 1024, 4096, MapId(), F.a->in[32] + 1024, F.a->in[32] + 1024, 1024, rot);
    wconv(F, (bf16_t*)(ws + W_WFF2), F.a->in[31], 1024, 4096, 1024, MapId(), nullptr, nullptr, 0, rot);
    }
    DUPP(4) {
    colsum_job(F, F.a->in[26], 1024, F.a->in[32], F.a->in[33], (float*)(ws + W_CSXQ), (float*)(ws + W_BWXQ), 0);
    colsum_job(F, F.a->in[30], 4096, F.a->in[32] + 1024, F.a->in[33] + 1024, (float*)(ws + W_CSFF1), (float*)(ws + W_BWFF1), 64);
    }
}
__device__ __forceinline__ void cvt_memcache(const Frame& F, int b0, int bstride) {
    bf16_t* XKS = (bf16_t*)(F.ws + A_XKS); bf16_t* XVTS = (bf16_t*)(F.ws + A_XVTS); const float* ck = F.a->in[7]; const float* cv = F.a->in[8];
    const long gs = (long)bstride * 512;
    for (long i = (long)b0 * 512 + F.tid; i < 32L * 256 * 128; i += gs) { const f32x4 a = *(const f32x4*)(ck + i * 8), b = *(const f32x4*)(ck + i * 8 + 4);
        const long rowi = i >> 7, c8 = i & 127; const long drow = (rowi & ~255L) | swap23((int)(rowi & 255));
        u32x4 w; w.x = cvt_pk_bf16(a[0], a[1]); w.y = cvt_pk_bf16(a[2], a[3]); w.z = cvt_pk_bf16(b[0], b[1]); w.w = cvt_pk_bf16(b[2], b[3]); *(u32x4*)(XKS + drow * 1024 + c8 * 8) = w; }
    { Frame F2 = F; F2.bid = b0; F2.G = bstride; int rot = 0;
      for (int bb = 0; bb < 32; ++bb) wconv<MapId, false>(F2, XVTS + (size_t)bb * 262144, cv + (size_t)bb * 262144, 1024, 256, 1024, MapId(), nullptr, nullptr, 0, rot); }
}

#define XB_TMO      128
#define XB_XCNT(j)  (256  + 64 * (j))
#define XB_XSUB(j)  (1280 + 64 * (j))
#define XB_XGEN(j)  (2304 + 64 * (j))
#define XB_TOP      3328
#define XB_TOPGEN   3392
#define XCD_BAR_WORDS 3456
#define XB_SPIN_CAP (1u << 18)

__device__ __forceinline__ unsigned xb_ld(unsigned* p)              { return __hip_atomic_load(p, __ATOMIC_RELAXED, __HIP_MEMORY_SCOPE_AGENT); }
__device__ __forceinline__ unsigned xb_add(unsigned* p, unsigned v) { return __hip_atomic_fetch_add(p, v, __ATOMIC_RELAXED, __HIP_MEMORY_SCOPE_AGENT); }
__device__ __forceinline__ unsigned xb_xcc_id() { return (unsigned)__builtin_amdgcn_s_getreg((3 << 11) | 20) & 0xFu; }
#define XB_SPIN(cond, bar) do { unsigned _sp = 0; while (cond) { __builtin_amdgcn_s_sleep(1); \
    if ((++_sp & 255u) == 0u) { if (xb_ld(&(bar)[XB_TMO])) break; if (_sp > XB_SPIN_CAP) { atomicAdd(&(bar)[XB_TMO], 1u); break; } } } } while (0)

struct XcdBarrier {
    unsigned* bar; unsigned x;
    volatile LAS unsigned* st;
};

__device__ __forceinline__ XcdBarrier xcd_barrier_post(unsigned* bar, volatile LAS unsigned* st) {
    XcdBarrier b; b.bar = bar; b.x = xb_xcc_id(); b.st = st;
    if (threadIdx.x == 0) (void)xb_add(&bar[XB_XCNT(b.x)], 1u);
    return b;
}
__device__ __forceinline__ void xcd_barrier_complete(unsigned* bar, unsigned x, unsigned& nloc, unsigned& nx) {
    const unsigned G = gridDim.x * gridDim.y * gridDim.z;
    unsigned sum, cnt, mine, sp = 0u;
    for (;;) {
        sum = 0u; cnt = 0u; mine = 0u;
#pragma unroll
        for (unsigned j = 0; j < 16; ++j) { const unsigned c = xb_ld(&bar[XB_XCNT(j)]); sum += c; cnt += (c > 0u) ? 1u : 0u; mine = (j == x) ? c : mine; }
        if (sum == G) break;
        __builtin_amdgcn_s_sleep(1);
        if ((++sp & 255u) == 0u) { if (xb_ld(&bar[XB_TMO])) break; if (sp > XB_SPIN_CAP) { atomicAdd(&bar[XB_TMO], 1u); break; } }
    }
    nloc = mine > 0u ? mine : 1u; nx = cnt > 0u ? cnt : 1u;
}

__device__ __forceinline__ void xcd_barrier(const XcdBarrier& b) {
    asm volatile("s_waitcnt vmcnt(0)" ::: "memory");
    __syncthreads();
    if (threadIdx.x == 0) {
        unsigned* bar = b.bar;
        __builtin_amdgcn_s_waitcnt(0);
        unsigned nloc = b.st[0], nx = b.st[1];
        if (nloc == 0u) { xcd_barrier_complete(bar, b.x, nloc, nx); b.st[0] = nloc; b.st[1] = nx; }
        const unsigned old = xb_add(&bar[XB_XSUB(b.x)], 1u);
        const unsigned gen = old / nloc;
        if (old + 1u == (gen + 1u) * nloc) {
            __builtin_amdgcn_fence(__ATOMIC_RELEASE, "agent");
            asm volatile("s_waitcnt vmcnt(0)" ::: "memory");
            const unsigned og = xb_add(&bar[XB_TOP], 1u);
            const unsigned tg = og / nx;
            if (og + 1u == (tg + 1u) * nx) xb_add(&bar[XB_TOPGEN], 1u);
            else XB_SPIN(xb_ld(&bar[XB_TOPGEN]) == tg, bar);
            __builtin_amdgcn_fence(__ATOMIC_ACQUIRE, "agent");
            xb_add(&bar[XB_XGEN(b.x)], 1u);
            asm volatile("s_waitcnt vmcnt(0)" ::: "memory");
        } else {
            XB_SPIN(xb_ld(&bar[XB_XGEN(b.x)]) == gen, bar);
            __builtin_amdgcn_fence(__ATOMIC_ACQUIRE, "agent");
            asm volatile("s_waitcnt vmcnt(0)" ::: "memory");
        }
    }
    __syncthreads();
}

constexpr int NPHASE = 13;
#ifndef PHASE_MASK
#define PHASE_MASK 0x1FFF
#endif
#ifndef SUBMASK
#define SUBMASK 0xFF
#endif
#define SUB(j) if ((SUBMASK >> (j)) & 1)
#ifndef DUP_MASK
#define DUP_MASK 0
#endif
#define DUP(k) _Pragma("unroll") for (int rep_ = 0; rep_ < (((DUP_MASK >> (k)) & 1) ? 2 : 1); ++rep_)
#define PH(k) if (!((PHASE_MASK >> (k)) & 1)) break;
using pg8::Gemm; using pg8::StaticOrder;
#define RUN_GEMM_LN(EPI, gm, e, PS_, PQ_) do { StaticOrder S_; S_.init((gm).M, (gm).N, F.G, F.bid, 0); ln_fill_tab(S_, PS_, PQ_, (LAS float*)(F.lds + 131072)); pg8::gemm_phase<EPI, StaticOrder, true, true>(F.lds, gm, S_, e); } while (0)
#define RUN_GEMM(EPI, gm, e, rot) do { StaticOrder S_; S_.init((gm).M, (gm).N, F.G, F.bid, rot); pg8::gemm_phase<EPI, StaticOrder, true, true>(F.lds, gm, S_, e); } while (0)

#define WS (F.ws)
#define U (F.a->out)
#define YG ((bf16_t*)((unsigned char*)F.a->out + 36 * MiB))
#define STSSM ((float*)(WS + W_STSSM))
#define STMLA ((float*)(WS + W_STMLA))
#define ST1 ((float*)(WS + W_ST1))
#define ST2 ((float*)(WS + W_ST2))
#define KN ((bf16_t*)(WS + A_KN))
#define VT ((bf16_t*)(WS + A_VT))
#define Q ((bf16_t*)(WS + A_Q))
#define KPE ((bf16_t*)(WS + A_KPE))
#define MIX ((bf16_t*)(WS + A_MIX))
#define R (F.a->out + O_Y)
__global__ void __launch_bounds__(512, 2) fwd_kernel(Args a) {
    extern __shared__ __attribute__((aligned(16))) unsigned char lds_raw[];
    Frame F;
    F.a = (const Args*)__builtin_amdgcn_kernarg_segment_ptr();
    F.out = a.out; F.ws = a.ws; F.lds = (LAS unsigned char*)lds_raw; F.tid = threadIdx.x; F.lane = F.tid & 63; F.wid = __builtin_amdgcn_readfirstlane(F.tid >> 6); F.G = gridDim.x; F.bid = blockIdx.x;
    const int lo = a.ph_lo, hi = a.ph_hi;
    volatile LAS unsigned* bst = (volatile LAS unsigned*)(F.lds + LDS_BYTES - 16);
    if (F.tid < 2) bst[F.tid] = 0u;
    __syncthreads();
    (void)xcd_barrier_post((unsigned*)(WS + W_BAR), bst);
    if (hi > 1000) cg::this_grid().sync();
#define GSYNC(k) if ((k) + 1 < hi) { XcdBarrier b_; b_.bar = (unsigned*)(F.a->ws + W_BAR); b_.x = xb_xcc_id(); b_.st = (volatile LAS unsigned*)(F.lds + LDS_BYTES - 16); xcd_barrier(b_); }
        if (((PHASE_MASK >> 0) & 1) && lo <= 0 && 0 < hi) DUP(0) { prologue(F); }
        if (lo <= 0 && 0 < hi) GSYNC(0)
        if (((PHASE_MASK >> 1) & 1) && lo <= 1 && 1 < hi) DUP(1) { {
            SUB(0) { Gemm g{(const bf16_t*)(WS + A_XB), (const bf16_t*)(WS + W_WIN), MTOK, 1280, 1024}; EpiProj e{U, (float*)(WS + A_PQ)}; RUN_GEMM(EpiProj, g, e, 0); }
            SUB(1) { Gemm g{(const bf16_t*)(WS + W_MEMB), (const bf16_t*)(WS + W_WXK), 256, 1024, 1024}; EpiStore<false> e{(bf16_t*)(WS + W_XK0), 1024, F.a->out + O_MKP, 1024, nullptr, 0, 1}; RUN_GEMM(EpiStore<false>, g, e, 172); }
            SUB(2) { Gemm g{(const bf16_t*)(WS + W_WXV), (const bf16_t*)(WS + W_MEMB), 1024, 256, 1024}; EpiStore<false> e{(bf16_t*)(WS + W_XVT0), 256, nullptr, 0, F.a->out + O_MVP, 1024, 0}; RUN_GEMM(EpiStore<false>, g, e, 168); }
            if (F.G > 92) { if (F.bid >= 92) cvt_caches(F, F.bid - 92, F.G - 92); } else cvt_caches(F, F.bid, F.G);
        } }
        if (lo <= 1 && 1 < hi) GSYNC(1)
        if (((PHASE_MASK >> 2) & 1) && lo <= 2 && 2 < hi) DUP(2) { post_rows(F); ssm_pass_a(F); }
        if (lo <= 2 && 2 < hi) GSYNC(2)
        if (((PHASE_MASK >> 3) & 1) && lo <= 3 && 3 < hi) DUP(3) { {
            const bool fuse34 = lo <= 3 && 4 < hi && F.G >= 8; unsigned* cnt3 = (unsigned*)(WS + W_BAR + 14336) + 32;
            SUB(0) ssm_pass_b(F, F.bid - (F.G - 4)); asm volatile("s_waitcnt vmcnt(0)" ::: "memory"); __syncthreads();
            if (fuse34 && F.bid >= F.G - 4 && F.tid == 0) { __builtin_amdgcn_fence(__ATOMIC_RELEASE, "agent"); asm volatile("s_waitcnt vmcnt(0)" ::: "memory"); __hip_atomic_fetch_add(cnt3, 1u, __ATOMIC_RELAXED, __HIP_MEMORY_SCOPE_AGENT); }
            SUB(1) { Gemm g{(const bf16_t*)(WS + A_CQN), (const bf16_t*)(WS + W_WQ), MTOK, 768, 384}; EpiQ e{Q}; RUN_GEMM(EpiQ, g, e, 0); }
            SUB(2) { Gemm g{(const bf16_t*)(WS + A_CKV), (const bf16_t*)(WS + W_WK), KVROWS, 512, 256}; EpiStore<false> e{KN, 512, nullptr, 0, nullptr, 0, 1}; RUN_GEMM(EpiStore<false>, g, e, 52); }
            SUB(3) { Gemm g{(const bf16_t*)(WS + W_WV), (const bf16_t*)(WS + A_CKV), 512, KVROWS, 256}; EpiStore<false> e{VT, KVPAD, nullptr, 0, nullptr, 0, 0}; RUN_GEMM(EpiStore<false>, g, e, 172); }
            if (fuse34) {
                if (F.tid == 0) { unsigned sp = 0; while (__hip_atomic_load(cnt3, __ATOMIC_RELAXED, __HIP_MEMORY_SCOPE_AGENT) < 4u) { __builtin_amdgcn_s_sleep(2); if (++sp > (1u << 22)) break; }
                    __builtin_amdgcn_fence(__ATOMIC_ACQUIRE, "agent"); asm volatile("s_waitcnt vmcnt(0)" ::: "memory"); }
                __syncthreads();
                ssm_pass_c(F); }
        } }
        if (lo <= 3 && 3 < hi && !(lo <= 3 && 4 < hi && F.G >= 8)) GSYNC(3)
        if (((PHASE_MASK >> 4) & 1) && lo <= 4 && 4 < hi && !(lo <= 3 && 4 < hi && F.G >= 8)) DUP(4) { ssm_pass_c(F); }
        if (lo <= 4 && 4 < hi) GSYNC(4)
        if (((PHASE_MASK >> 5) & 1) && lo <= 5 && 5 < hi) DUP(5) { {
            SUB(0) { Gemm g{YG, (const bf16_t*)(WS + W_WGLU), MTOK, 1024, 512}; EpiGlu e{MIX, STSSM}; RUN_GEMM(EpiGlu, g, e, 0); }
            SUB(1) DUP(13) for (int it = F.bid; it < 256; it += F.G) { const int y = it >> 2, h = it & 3;
                for (int pass = 0; pass < 2; ++pass) { const int x = pass ? y : 127 - y, q0 = x * 128, rg = F.wid & 3;
                    attn_unit<192, 128, 128, false>(F.lds, Q + (size_t)q0 * 768 + h * 192, 768, KN + h * 128, 512, KPE, VT + (size_t)(h * 128) * KVPAD, KVPAD,
                                                    (q0 >> 6) + 2, 64 * ((q0 >> 6) + (rg >> 1) + 1), MIX + (size_t)q0 * 1024 + 512 + h * 128, 1024, STMLA + (size_t)h * MTOK + q0, 128); } }
            SUB(2) DUP(14) for (int it = F.G - 1 - F.bid; it < 128; it += F.G) { const int b = it >> 2, h = it & 3, q0 = TP + b * 32, k0 = TP + b * KVS, rg = F.wid & 3;
                attn_unit<192, 128, 128, false>(F.lds, Q + (size_t)q0 * 768 + h * 192, 768, KN + (size_t)k0 * 512 + h * 128, 512, KPE + (size_t)k0 * 64, VT + (size_t)(h * 128) * KVPAD + k0, KVPAD,
                                                17, rg == 0 ? KVS : 0, MIX + (size_t)q0 * 1024 + 512 + h * 128, 1024, STMLA + (size_t)h * MTOK + q0, 32); }
        } }
        if (lo <= 5 && 5 < hi) GSYNC(5)
        if (((PHASE_MASK >> 6) & 1) && lo <= 6 && 6 < hi) DUP(6) { {
            { Gemm g{MIX, (const bf16_t*)(WS + W_WO), MTOK, 1024, 1024};
              LAS float* tab = (LAS float*)(F.lds + 131072);
              EpiRes<0> e{F.a->in[0], F.a->in[1], R, (bf16_t*)(WS + A_R1B), nullptr, nullptr, nullptr, nullptr, ST1, ST1 + 16 * MTOK, tab};
              StaticOrder S_; S_.init(g.M, g.N, F.G, F.bid, 0); Unit u0;
              if (S_.next(0, u0)) wo_fill_tab(u0, STSSM, STMLA, tab);
              if (S_.next(1, u0)) wo_fill_tab(u0, STSSM, STMLA, tab);
              __syncthreads();
              pg8::gemm_phase<EpiRes<0>, StaticOrder, true, true>(F.lds, g, S_, e); }
            if (F.G > 16) { if (F.bid >= 16) cvt_memcache(F, F.bid - 16, F.G - 16); } else cvt_memcache(F, F.bid, F.G);
        } }
        if (lo <= 6 && 6 < hi) GSYNC(6)
        if (((PHASE_MASK >> 7) & 1) && lo <= 7 && 7 < hi) DUP(7) { { Gemm g{(const bf16_t*)(WS + A_R1B), (const bf16_t*)(WS + W_WXQ), (F.G >= 80) ? TP : MTOK, 1024, 1024};
            EpiLnAct<0> e{(const LAS float*)(F.lds + 131072), (const float*)(WS + W_CSXQ), (const float*)(WS + W_BWXQ), (bf16_t*)(WS + A_XQ), 1024}; RUN_GEMM_LN(EpiLnAct<0>, g, e, ST1, ST1 + 16 * MTOK); } }
        if (lo <= 7 && 7 < hi) GSYNC(7)
        if (((PHASE_MASK >> 8) & 1) && lo <= 8 && 8 < hi) DUP(8) { {
            const bf16_t* XQ = (const bf16_t*)(WS + A_XQ); bf16_t* XO = (bf16_t*)(WS + A_XO); unsigned* cnt2 = (unsigned*)(WS + W_BAR + 14336) + 16;
            if (F.G >= 80 && F.bid >= F.G - 16) {
                const int u = F.bid - (F.G - 16), pm = TP / 256 + (u >> 2); LAS float* tab = (LAS float*)(F.lds + 131072);
                if (F.tid < 256) { float mu, rstd; ln_stats16(ST1, ST1 + 16 * MTOK, pm * 256 + F.tid, mu, rstd); tab[F.tid] = mu; tab[256 + F.tid] = rstd; }
                __syncthreads();
                Gemm gx{(const bf16_t*)(WS + A_R1B), (const bf16_t*)(WS + W_WXQ), MTOK, 1024, 1024}; pg8::OneUnitOrder Sx{pm, u & 3};
                EpiLnAct<0> ex{tab, (const float*)(WS + W_CSXQ), (const float*)(WS + W_BWXQ), (bf16_t*)(WS + A_XQ), 1024};
                pg8::gemm_phase<EpiLnAct<0>, pg8::OneUnitOrder, true, true>(F.lds, gx, Sx, ex);
                asm volatile("s_waitcnt vmcnt(0)" ::: "memory"); __syncthreads();
                if (F.tid == 0) { __builtin_amdgcn_fence(__ATOMIC_RELEASE, "agent"); asm volatile("s_waitcnt vmcnt(0)" ::: "memory"); __hip_atomic_fetch_add(cnt2, 1u, __ATOMIC_RELAXED, __HIP_MEMORY_SCOPE_AGENT); }
                __syncthreads(); }
            for (int it = F.bid; it < 640; it += F.G) {
                if (it >= 512 && F.G >= 80) {
                    if (F.tid == 0) { unsigned sp = 0; while (__hip_atomic_load(cnt2, __ATOMIC_RELAXED, __HIP_MEMORY_SCOPE_AGENT) < 16u) { __builtin_amdgcn_s_sleep(2); if (++sp > (1u << 22)) break; }
                        __builtin_amdgcn_fence(__ATOMIC_ACQUIRE, "agent"); asm volatile("s_waitcnt vmcnt(0)" ::: "memory"); }
                    __syncthreads(); }
                if (it < 512) { const int x = it >> 2, h = it & 3, q0 = x * 128;
                    attn_unit<256, 256, 256, true>(F.lds, XQ + (size_t)q0 * 1024 + h * 256, 1024, (const bf16_t*)(WS + W_XK0) + h * 256, 1024, nullptr, (const bf16_t*)(WS + W_XVT0) + (size_t)h * 65536, 256,
                                                   4, 256, XO + (size_t)q0 * 1024 + h * 256, 1024, nullptr, 128); }
                else { const int b = (it - 512) >> 2, h = it & 3, q0 = TP + b * 32, rg = F.wid & 3;
                    attn_unit<256, 256, 256, true>(F.lds, XQ + (size_t)q0 * 1024 + h * 256, 1024, (const bf16_t*)(WS + A_XKS) + (size_t)b * 262144 + h * 256, 1024, nullptr,
                                                   (const bf16_t*)(WS + A_XVTS) + (size_t)(b * 4 + h) * 65536, 256, 4, rg == 0 ? 256 : 0, XO + (size_t)q0 * 1024 + h * 256, 1024, nullptr, 32); } }
        } }
        if (lo <= 8 && 8 < hi) GSYNC(8)
        if (((PHASE_MASK >> 9) & 1) && lo <= 9 && 9 < hi) DUP(9) { { Gemm g{(const bf16_t*)(WS + A_XO), (const bf16_t*)(WS + W_WXO), (F.G >= 80) ? TP : MTOK, 1024, 1024};
            EpiRes<1> e{nullptr, nullptr, R, (bf16_t*)(WS + A_R2B), nullptr, nullptr, F.a->in[32], F.a->in[33], ST2, ST2 + 16 * MTOK, (const LAS float*)(F.lds + 131072)}; RUN_GEMM_LN(EpiRes<1>, g, e, ST1, ST1 + 16 * MTOK); } }
        if (lo <= 9 && 9 < hi) GSYNC(9)
        if (((PHASE_MASK >> 10) & 1) && lo <= 10 && 10 < hi) DUP(10) { {
            LAS float* tab = (LAS float*)(F.lds + 131072); unsigned* cnt = (unsigned*)(WS + W_BAR + 14336);
            if (F.G >= 80 && F.bid >= F.G - 16) { const int u = F.bid - (F.G - 16); const int pm = TP / 256 + (u >> 2);
                if (F.tid < 256) { float mu, rstd; ln_stats16(ST1, ST1 + 16 * MTOK, pm * 256 + F.tid, mu, rstd); tab[F.tid] = mu; tab[256 + F.tid] = rstd; }
                __syncthreads();
                Gemm gx{(const bf16_t*)(WS + A_XO), (const bf16_t*)(WS + W_WXO), MTOK, 1024, 1024}; pg8::OneUnitOrder Sx{pm, u & 3};
                EpiRes<1> ex{nullptr, nullptr, R, (bf16_t*)(WS + A_R2B), nullptr, nullptr, F.a->in[32], F.a->in[33], ST2, ST2 + 16 * MTOK, tab};
                pg8::gemm_phase<EpiRes<1>, pg8::OneUnitOrder, true, true>(F.lds, gx, Sx, ex);
                asm volatile("s_waitcnt vmcnt(0)" ::: "memory"); __syncthreads();
                if (F.tid == 0) { __builtin_amdgcn_fence(__ATOMIC_RELEASE, "agent"); asm volatile("s_waitcnt vmcnt(0)" ::: "memory"); __hip_atomic_fetch_add(cnt, 1u, __ATOMIC_RELAXED, __HIP_MEMORY_SCOPE_AGENT); }
                __syncthreads(); }
            EpiLnAct<1> e{tab, (const float*)(WS + W_CSFF1), (const float*)(WS + W_BWFF1), (bf16_t*)(WS + A_Z), 4096};
            { Gemm g{(const bf16_t*)(WS + A_R2B), (const bf16_t*)(WS + W_WFF1), (F.G >= 80) ? TP : MTOK, 4096, 1024}; RUN_GEMM_LN(EpiLnAct<1>, g, e, ST2, ST2 + 16 * MTOK); }
            if (F.G >= 80 && F.bid < 64) {
                if (F.tid == 0) { unsigned sp = 0; while (__hip_atomic_load(cnt, __ATOMIC_RELAXED, __HIP_MEMORY_SCOPE_AGENT) < 16u) { __builtin_amdgcn_s_sleep(2); if (++sp > (1u << 22)) break; }
                    __builtin_amdgcn_fence(__ATOMIC_ACQUIRE, "agent"); asm volatile("s_waitcnt vmcnt(0)" ::: "memory"); }
                __syncthreads();
                const int pm = TP / 256 + (F.bid >> 4);
                if (F.tid < 256) { float mu, rstd; ln_stats16(ST2, ST2 + 16 * MTOK, pm * 256 + F.tid, mu, rstd); tab[F.tid] = mu; tab[256 + F.tid] = rstd; }
                __syncthreads();
                Gemm gs{(const bf16_t*)(WS + A_R2B), (const bf16_t*)(WS + W_WFF1), MTOK, 4096, 1024}; pg8::OneUnitOrder Ss{pm, F.bid & 15};
                pg8::gemm_phase<EpiLnAct<1>, pg8::OneUnitOrder, true, true>(F.lds, gs, Ss, e); } } }
        if (lo <= 10 && 10 < hi) GSYNC(10)
        if (((PHASE_MASK >> 11) & 1) && lo <= 11 && 11 < hi) DUP(11) { { Gemm g{(const bf16_t*)(WS + A_Z), (const bf16_t*)(WS + W_WFF2), TP, 1024, 4096};
            EpiRes<1> e{nullptr, nullptr, R, nullptr, nullptr, nullptr, F.a->in[32] + 1024, F.a->in[33] + 1024, ST1, ST1 + 16 * MTOK, (const LAS float*)(F.lds + 131072)}; RUN_GEMM_LN(EpiRes<1>, g, e, ST2, ST2 + 16 * MTOK); }
          { Gemm g{(const bf16_t*)(WS + A_Z) + (size_t)TP * 4096, (const bf16_t*)(WS + W_WFF2), TS, 1024, 512, 4096};
            pg8::SplitKOrder S_{16, 4, 8, 512, F.G, F.bid}; EpiSlab e{(float*)(WS + A_R2B)}; pg8::gemm_phase<EpiSlab, pg8::SplitKOrder, true, true>(F.lds, g, S_, e); } }
        if (lo <= 11 && 11 < hi) GSYNC(11)
        if (((PHASE_MASK >> 12) & 1) && lo <= 12 && 12 < hi) DUP(12) { final_ln(F); }
}

#undef WS
#undef U
#undef YG
#undef STSSM
#undef STMLA
#undef ST1
#undef ST2
#undef KN
#undef VT
#undef Q
#undef KPE
#undef MIX
#undef R
extern "C" void kernel_launch(void* const* d_in, const int* in_sizes, int n_in, void* d_out, int out_size, void* d_ws, size_t ws_size, hipStream_t stream) {
    static int grid = 0;
    if (grid == 0) {
        int dev = 0, cus = 0, per_cu = 0;
        (void)hipGetDevice(&dev); (void)hipDeviceGetAttribute(&cus, hipDeviceAttributeMultiprocessorCount, dev);
        if (hipFuncSetAttribute((const void*)fwd_kernel, hipFuncAttributeMaxDynamicSharedMemorySize, LDS_BYTES) != hipSuccess) fprintf(stderr, "kernel_launch: hipFuncSetAttribute failed\n");
        if (hipOccupancyMaxActiveBlocksPerMultiprocessor(&per_cu, (const void*)fwd_kernel, 512, LDS_BYTES) != hipSuccess || per_cu < 1) { fprintf(stderr, "kernel_launch: occupancy query says %d\n", per_cu); per_cu = 1; }
        (void)hipGetLastError();
        grid = cus > 0 ? cus : 256;
        if (n_in != 34 || ws_size < WS_END) fprintf(stderr, "kernel_launch: unexpected n_in %d / ws_size %zu (need %zu)\n", n_in, ws_size, (size_t)WS_END);
    }
    if (hipMemsetAsync((char*)d_ws + W_BAR, 0, BAR_BYTES, stream) != hipSuccess) fprintf(stderr, "kernel_launch: memset failed\n");
    Args a{};
    for (int i = 0; i < 34; ++i) a.in[i] = (const float*)d_in[i];
    a.out = (float*)d_out; a.ws = (unsigned char*)d_ws;
#if N_LAUNCH_MODE == 1
    a.ph_lo = 0; a.ph_hi = NPHASE;
    void* args[] = {&a};
    hipError_t e = hipLaunchCooperativeKernel((const void*)fwd_kernel, dim3(grid), dim3(512), args, LDS_BYTES, stream);
    if (e != hipSuccess) fprintf(stderr, "cooperative launch failed: %s (grid %d)\n", hipGetErrorString(e), grid);
#else
    for (int ph = 0; ph < NPHASE; ++ph) { a.ph_lo = ph; a.ph_hi = ph + 1; hipLaunchKernelGGL(fwd_kernel, dim3(grid), dim3(512), LDS_BYTES, stream, a); }
#endif
}
```

```cpp
#include <hip/hip_runtime.h>
#include <hip/hip_cooperative_groups.h>
#include <cstdio>
#include <cstdint>
namespace cg = cooperative_groups;

#ifndef N_LAUNCH_MODE
#define N_LAUNCH_MODE 1
#endif

#define LAS __attribute__((address_space(3)))
#define PG8_LAS LAS
typedef unsigned short bf16_t;
typedef short bf16x8 __attribute__((ext_vector_type(8)));
typedef float f32x4 __attribute__((ext_vector_type(4)));
typedef float f32x16 __attribute__((ext_vector_type(16)));
typedef unsigned u32x4 __attribute__((ext_vector_type(4)));
typedef unsigned u32x2 __attribute__((ext_vector_type(2)));

constexpr int TP = 16384, TS = 1024, MTOK = TP + TS;
constexpr int DM = 1024, NPAST = 1024, KVS = 1056;
constexpr int KVROWS = TP + 32 * KVS;
constexpr int KVPAD = KVROWS + 64;
constexpr float EPSN = 1e-5f;
constexpr float ALPHA = 1.189207115002721f;
constexpr float LOG2E = 1.4426950408889634f;
constexpr float QSCALE = 0.07216878364870322f * LOG2E;
constexpr float XSCALE = 0.0625f * LOG2E;

constexpr size_t O_Y = 0, O_CKVP = 17825792, O_KPEP = 22020096, O_SREP = 23068672, O_SIMP = 23070720, O_MKP = 23072768,
                 O_MVP = 23334912, O_CKVS = 23597056, O_KPES = 23859200, O_SRES = 23924736, O_SIMS = 23990272;

constexpr size_t MiB = 1u << 20;
constexpr size_t al256(size_t x) { return (x + 255) & ~(size_t)255; }
constexpr size_t W_WIN = 0;
constexpr size_t W_WQ = W_WIN + al256(1280 * 1024 * 2);
constexpr size_t W_WK = W_WQ + al256(768 * 384 * 2);
constexpr size_t W_WV = W_WK + al256(512 * 256 * 2);
constexpr size_t W_WGLU = W_WV + al256(512 * 256 * 2);
constexpr size_t W_WO = W_WGLU + al256(1024 * 512 * 2);
constexpr size_t W_WXQ = W_WO + 2 * MiB;
constexpr size_t W_WXK = W_WXQ + 2 * MiB;
constexpr size_t W_WXV = W_WXK + 2 * MiB;
constexpr size_t W_WXO = W_WXV + 2 * MiB;
constexpr size_t W_WFF1 = W_WXO + 2 * MiB;
constexpr size_t W_WFF2 = W_WFF1 + 8 * MiB;
constexpr size_t W_CSXQ = W_WFF2 + 8 * MiB;
constexpr size_t W_BWXQ = W_CSXQ + 4096;
constexpr size_t W_CSFF1 = W_BWXQ + 4096;
constexpr size_t W_BWFF1 = W_CSFF1 + 16384;
constexpr size_t W_LAM = W_BWFF1 + 16384;
constexpr size_t W_LAM64 = W_LAM + 16384;
constexpr size_t W_BB = W_LAM64 + 16384;
constexpr size_t W_MEMB = W_BB + 2 * 32 * 64 * 16 * 4;
constexpr size_t W_XK0 = W_MEMB + 256 * 1024 * 2;
constexpr size_t W_XVT0 = W_XK0 + 256 * 1024 * 2;
constexpr size_t W_STSSM = W_XVT0 + 256 * 1024 * 2;
constexpr size_t W_STMLA = W_STSSM + al256(16 * MTOK * 4);
constexpr size_t W_ST1 = W_STMLA + al256(4 * MTOK * 4);
constexpr size_t W_ST2 = W_ST1 + al256(32 * MTOK * 4);
constexpr size_t W_SEND = W_ST2 + al256(32 * MTOK * 4);
constexpr size_t W_BAR = W_SEND + 256 * 2 * 2048 * 4;
constexpr size_t BAR_BYTES = 16384;
constexpr size_t W_ACT = (W_BAR + BAR_BYTES + MiB - 1) / MiB * MiB;
constexpr size_t A_KN = W_ACT, A_VT = W_ACT + 50 * MiB, A_Q = W_ACT + 100 * MiB, A_KPE = W_ACT + 126 * MiB, A_CKV = W_ACT + 133 * MiB,
                 A_CQN = W_ACT + 158 * MiB, A_MIX = W_ACT + 171 * MiB, A_PQ = W_ACT, A_XB = W_ACT + 51 * MiB, A_R1B = W_ACT,
                 A_XQ = W_ACT + 34 * MiB, A_XKS = W_ACT + 68 * MiB, A_XVTS = W_ACT + 84 * MiB, A_XO = W_ACT + 101 * MiB,
                 A_R2B = W_ACT + 140 * MiB, A_Z = W_ACT, WS_END = W_ACT + 205 * MiB;
static_assert(WS_END <= 256 * MiB, "workspace");
static_assert((size_t)KVPAD * 512 * 2 <= 50 * MiB && (size_t)MTOK * 768 * 2 <= 26 * MiB && (size_t)KVPAD * 64 * 2 <= 7 * MiB && (size_t)KVPAD * 256 * 2 <= 25 * MiB &&
              (size_t)MTOK * 384 * 2 <= 13 * MiB && (size_t)MTOK * 1024 * 2 <= 34 * MiB && (size_t)MTOK * 768 * 4 <= 51 * MiB && (size_t)MTOK * 4096 * 2 <= 136 * MiB, "regions");

constexpr int LDS_BYTES = 141312 + 64;

__constant__ double c_invrev[32] = {0.15915494309189535,0.11934937021124886,0.089499401608891013,0.067115083005227255,0.050329212104487035,0.037741584717419771,0.028302195830623399,0.02122365276477766,0.015915494309189534,0.011934937021124886,0.0089499401608891024,0.0067115083005227253,0.0050329212104487037,0.0037741584717419772,0.0028302195830623399,0.0021223652764777662,0.0015915494309189536,0.0011934937021124885,0.00089499401608891024,0.0006711508300522726,0.00050329212104487033,0.00037741584717419774,0.00028302195830623395,0.00021223652764777661,0.00015915494309189535,0.00011934937021124886,8.9499401608891018e-05,6.7115083005227254e-05,5.0329212104487035e-05,3.7741584717419777e-05,2.8302195830623396e-05,2.1223652764777659e-05};

__device__ __forceinline__ unsigned cvt_pk_bf16(float lo, float hi) { unsigned r; asm volatile("v_cvt_pk_bf16_f32 %0, %1, %2" : "=v"(r) : "v"(lo), "v"(hi)); return r; }
__device__ __forceinline__ u32x2 pack4(f32x4 v) { u32x2 w; w.x = cvt_pk_bf16(v[0], v[1]); w.y = cvt_pk_bf16(v[2], v[3]); return w; }
__device__ __forceinline__ float bf16_round(float x) { return __uint_as_float(cvt_pk_bf16(x, 0.f) << 16); }
__device__ __forceinline__ void rope_cs(int pos, int i, float& c, float& s) {
    double rev = (double)pos * c_invrev[i]; rev -= __builtin_floor(rev); const float r = (float)rev;
    s = __builtin_amdgcn_sinf(r); c = __builtin_amdgcn_cosf(r);
}
__device__ __forceinline__ int tok_pos(int row) { return row < TP ? row : NPAST + ((row - TP) & 31); }
__device__ __forceinline__ int swap23(int r) { return (r & ~12) | ((r & 4) << 1) | ((r & 8) >> 1); }
__device__ __forceinline__ int tok_kvrow(int row) { return row < TP ? row : TP + ((row - TP) >> 5) * KVS + NPAST + ((row - TP) & 31); }

struct Args { const float* in[34]; float* out; unsigned char* ws; int ph_lo, ph_hi; };
struct Frame {
    const Args* a; float* out; unsigned char* ws; LAS unsigned char* lds;
    int tid, lane, wid, G, bid;
};

namespace pg8 {
constexpr int BM = 256, BK = 64, HALF = 128, HTB = HALF * BK * 2, STAGE_BYTES = 8 * HTB, NXCD = 8, WGM = 8;
__host__ __device__ __forceinline__ int lds_byte(int r, int c) { const int st = (r >> 4) * 2 + (c >> 5), rr = r & 15, cc = c & 31, ob = rr * 64 + cc * 2; return st * 1024 + (ob ^ (((ob >> 9) & 1) << 5)); }
__host__ __device__ __forceinline__ void stage_rc(int b, int& R, int& C) { const int st = b / 1024, sb = b % 1024, swz = sb ^ (((sb >> 9) & 1) << 5); R = (st >> 1) * 16 + swz / 64; C = (st & 1) * 32 + (swz % 64) / 2; }
__host__ __device__ __forceinline__ int perm32(int rho) { const int n = rho >> 4, i = rho & 15; return 8 * (i >> 2) + 4 * n + (i & 3); }
struct Unit { int pm, pn, idx, ko; };
struct Gemm { const bf16_t* A; const bf16_t* Bt; int M, N, K, LD; };
struct StaticOrder {
    int nM, nN, nwg, G, c;
    __device__ __forceinline__ void init(int M, int N, int G_, int c_, int rot) { nM = M / BM; nN = N / BM; nwg = nM * nN; G = G_; c = (c_ + rot) % G_; }
    __device__ __forceinline__ bool next(int i, Unit& u) const {
        const long L = (long)i * G + c; if (L >= nwg) return false;
        int wgid = (int)L; { const int q = nwg / NXCD, r = nwg % NXCD, xcd = wgid % NXCD, off = wgid / NXCD; wgid = (xcd < r ? xcd * (q + 1) : r * (q + 1) + (xcd - r) * q) + off; }
        const int nig = WGM * nN, gid = wgid / nig, fm = gid * WGM, gsz = (nM - fm) < WGM ? (nM - fm) : WGM;
        u.pm = fm + ((wgid % nig) % gsz); u.pn = (wgid % nig) / gsz; u.idx = i; u.ko = 0; return true;
    }
    __device__ __forceinline__ void a_ready(const Unit&) const {}
    __device__ __forceinline__ void done(const Unit&) const {}
};
struct OneUnitOrder {
    int pm, pn;
    __device__ __forceinline__ bool next(int i, Unit& u) const { if (i > 0) return false; u.pm = pm; u.pn = pn; u.idx = 0; u.ko = 0; return true; }
    __device__ __forceinline__ void a_ready(const Unit&) const {}
    __device__ __forceinline__ void done(const Unit&) const {}
};
struct SplitKOrder {
    int nt, nN, ns, ks, G, c;
    __device__ __forceinline__ bool next(int i, Unit& u) const { const int L = i * G + c; if (L >= nt * ns) return false; const int t = L % nt, s = L / nt; u.pm = t / nN; u.pn = t % nN; u.idx = i; u.ko = s * ks; return true; }
    __device__ __forceinline__ void a_ready(const Unit&) const {}
    __device__ __forceinline__ void done(const Unit&) const {}
};
template <class Epi, class Sched, bool ALIGN_EPI = false, bool SP2 = false>
__device__ __forceinline__ void gemm_phase(PG8_LAS unsigned char* lds, const Gemm g, const Sched& S, const Epi& E) {
    const int tid = threadIdx.x, wid = __builtin_amdgcn_readfirstlane(tid >> 6), lane = tid & 63, wr = wid >> 2, wc = wid & 3, fr = lane & 15, fq = lane >> 4;
    int K_ = g.K; asm volatile("" : "+s"(K_)); const int K = K_, nt = K / BK, LD = g.LD ? g.LD : K;
    unsigned voffA[2], voffB[2];
#pragma unroll
    for (int i = 0; i < 2; ++i) { int R, C; stage_rc(tid * 16 + i * 8192, R, C); const int Rb = Epi::PERM ? ((R & ~31) + perm32(R & 31)) : R;
        voffA[i] = (unsigned)(R * LD + C) * 2u; voffB[i] = (unsigned)(Rb * LD + C) * 2u; }
    const size_t kstep = (size_t)(BK * 2);
    const size_t hstep = (size_t)HALF * LD * 2;
    const size_t tstep = 2 * hstep;
    const unsigned ldsw = (unsigned)wid * 1024u;
    const int aoff = lds_byte(wr * 64 + fr, fq * 8), boff = lds_byte(wc * 32 + fr, fq * 8);
#define PG8_SA(b, h) (((b) * 2 + (h)) * HTB)
#define PG8_SB(b, h) ((4 + (b) * 2 + (h)) * HTB)
#define PG8_STAGE(bufoff, gbase, voff) do { _Pragma("unroll") for (int _i = 0; _i < 2; ++_i) \
        __builtin_amdgcn_global_load_lds((const unsigned*)((const char*)(gbase) + (voff)[_i]), (PG8_LAS unsigned*)(lds + (bufoff) + ldsw + _i * 8192), 16, 0, 0); } while (0)
#define PG8_LDA(dst, b, h) do { _Pragma("unroll") for (int m = 0; m < 4; ++m) _Pragma("unroll") for (int k = 0; k < 2; ++k) dst[m][k] = *(const PG8_LAS bf16x8*)(lds + PG8_SA(b, h) + aoff + m * 2048 + k * 1024); } while (0)
#define PG8_LDB(dst, b, h) do { _Pragma("unroll") for (int n = 0; n < 2; ++n) _Pragma("unroll") for (int k = 0; k < 2; ++k) dst[n][k] = *(const PG8_LAS bf16x8*)(lds + PG8_SB(b, h) + boff + n * 2048 + k * 1024); } while (0)
#define PG8_MMA(ai, bj, At, Bt) do { __builtin_amdgcn_s_setprio(1); _Pragma("unroll") for (int m = 0; m < 4; ++m) _Pragma("unroll") for (int n = 0; n < 2; ++n) _Pragma("unroll") for (int k = 0; k < 2; ++k) \
        acc[ai][bj][m][n] = __builtin_amdgcn_mfma_f32_16x16x32_bf16(Bt[n][k], At[m][k], acc[ai][bj][m][n], 0, 0, 0); __builtin_amdgcn_s_setprio(0); } while (0)
#define PG8_WAIT_V(n) asm volatile("s_waitcnt vmcnt(" #n ")" ::: "memory")
#define PG8_WAIT_L(n) asm volatile("s_waitcnt lgkmcnt(" #n ")" ::: "memory")
#define PG8_BAR __builtin_amdgcn_s_barrier()
#define PG8_SCHED __builtin_amdgcn_sched_barrier(0)
    Unit cur, nxt; int ui = 0;
    if (!S.next(0, cur)) return;
    f32x4 acc[2][2][4][2];
#pragma unroll
    for (int a = 0; a < 2; ++a)
#pragma unroll
        for (int b = 0; b < 2; ++b)
#pragma unroll
            for (int m = 0; m < 4; ++m)
#pragma unroll
                for (int n = 0; n < 2; ++n) acc[a][b][m][n] = (f32x4){0.f, 0.f, 0.f, 0.f};
    bf16x8 At[4][2], B0[2][2], B1[2][2];
    const char* cA = (const char*)g.A + (size_t)cur.pm * tstep + (size_t)cur.ko * 2; const char* cB = (const char*)g.Bt + (size_t)cur.pn * tstep + (size_t)cur.ko * 2;
    S.a_ready(cur);
    if constexpr (SP2) {
        PG8_STAGE(PG8_SB(0, 0), cB, voffB); PG8_STAGE(PG8_SB(0, 1), cB + hstep, voffB); PG8_STAGE(PG8_SA(0, 0), cA, voffA); PG8_STAGE(PG8_SA(0, 1), cA + hstep, voffA);
        if (wr == 1) PG8_BAR;
        PG8_WAIT_V(2); PG8_BAR;
        PG8_STAGE(PG8_SB(1, 0), cB + kstep, voffB); PG8_STAGE(PG8_SA(1, 0), cA + kstep, voffA); PG8_STAGE(PG8_SB(1, 1), cB + hstep + kstep, voffB);
        PG8_WAIT_V(6); PG8_BAR;
    } else {
        PG8_STAGE(PG8_SB(0, 0), cB, voffB); PG8_STAGE(PG8_SA(0, 0), cA, voffA); PG8_STAGE(PG8_SB(0, 1), cB + hstep, voffB); PG8_STAGE(PG8_SA(0, 1), cA + hstep, voffA);
        if (wr == 1) PG8_BAR;
        PG8_WAIT_V(4); PG8_BAR;
        PG8_STAGE(PG8_SB(1, 0), cB + kstep, voffB); PG8_STAGE(PG8_SA(1, 0), cA + kstep, voffA); PG8_STAGE(PG8_SB(1, 1), cB + hstep + kstep, voffB);
        PG8_WAIT_V(6); PG8_BAR;
    }
    for (;;) {
        const bool has_next = S.next(ui + 1, nxt);
        const char* nA = has_next ? (const char*)g.A + (size_t)nxt.pm * tstep + (size_t)nxt.ko * 2 : cA; const char* nB = has_next ? (const char*)g.Bt + (size_t)nxt.pn * tstep + (size_t)nxt.ko * 2 : cB;
        for (int t = 0; t < nt; t += 2) {
            const bool last = (t == nt - 2);
            if constexpr (Epi::MIDK) { if (t == (nt >> 1)) E.mid(acc, cur, wr, fr); }
            const char* a1 = cA + (size_t)(t + 1) * kstep;
            const char* a2 = last ? nA : cA + (size_t)(t + 2) * kstep; const char* b2 = last ? nB : cB + (size_t)(t + 2) * kstep;
            const char* a3 = a2 + kstep; const char* b3 = b2 + kstep;
            if (last && has_next) S.a_ready(nxt);
            if constexpr (SP2) {
            PG8_LDB(B0, 0, 0); PG8_LDB(B1, 0, 1); PG8_SCHED; PG8_LDA(At, 0, 0); PG8_STAGE(PG8_SA(1, 1), a1 + hstep, voffA);
            PG8_WAIT_V(8); PG8_WAIT_L(0); PG8_BAR; PG8_MMA(0, 0, At, B0); PG8_MMA(0, 1, At, B1); PG8_BAR; PG8_SCHED;
            PG8_LDA(At, 0, 1); PG8_STAGE(PG8_SB(0, 0), b2, voffB); PG8_STAGE(PG8_SB(0, 1), b2 + hstep, voffB); PG8_STAGE(PG8_SA(0, 0), a2, voffA);
            PG8_WAIT_V(8); PG8_WAIT_L(0); PG8_BAR; PG8_MMA(1, 0, At, B0); PG8_MMA(1, 1, At, B1); PG8_BAR; PG8_SCHED;
            PG8_LDB(B0, 1, 0); PG8_LDB(B1, 1, 1); PG8_SCHED; PG8_LDA(At, 1, 0); PG8_STAGE(PG8_SA(0, 1), a2 + hstep, voffA);
            PG8_WAIT_V(8); PG8_WAIT_L(0); PG8_BAR; PG8_MMA(0, 0, At, B0); PG8_MMA(0, 1, At, B1); PG8_BAR; PG8_SCHED;
            PG8_LDA(At, 1, 1); PG8_STAGE(PG8_SB(1, 0), b3, voffB); PG8_STAGE(PG8_SB(1, 1), b3 + hstep, voffB); PG8_STAGE(PG8_SA(1, 0), a3, voffA);
            PG8_WAIT_V(8); PG8_WAIT_L(0); PG8_BAR; PG8_MMA(1, 0, At, B0); PG8_MMA(1, 1, At, B1); PG8_BAR; PG8_SCHED;
            } else {
            PG8_LDB(B0, 0, 0); PG8_SCHED; PG8_LDA(At, 0, 0); PG8_STAGE(PG8_SA(1, 1), a1 + hstep, voffA);
            PG8_WAIT_L(8); PG8_BAR; PG8_WAIT_L(0); PG8_MMA(0, 0, At, B0); PG8_BAR; PG8_SCHED;
            PG8_LDB(B1, 0, 1); PG8_STAGE(PG8_SB(0, 0), b2, voffB);
            PG8_BAR; PG8_WAIT_L(0); PG8_MMA(0, 1, At, B1); PG8_BAR;
            PG8_LDA(At, 0, 1); PG8_STAGE(PG8_SA(0, 0), a2, voffA);
            PG8_BAR; PG8_WAIT_L(0); PG8_MMA(1, 0, At, B0); PG8_BAR; PG8_SCHED;
            PG8_STAGE(PG8_SB(0, 1), b2 + hstep, voffB);
            PG8_WAIT_V(6); PG8_BAR; PG8_MMA(1, 1, At, B1); PG8_BAR;
            PG8_LDB(B0, 1, 0); PG8_SCHED; PG8_LDA(At, 1, 0); PG8_STAGE(PG8_SA(0, 1), a2 + hstep, voffA);
            PG8_WAIT_L(8); PG8_BAR; PG8_WAIT_L(0); PG8_MMA(0, 0, At, B0); PG8_BAR; PG8_SCHED;
            PG8_LDB(B1, 1, 1); PG8_STAGE(PG8_SB(1, 0), b3, voffB);
            PG8_BAR; PG8_WAIT_L(0); PG8_MMA(0, 1, At, B1); PG8_BAR;
            PG8_LDA(At, 1, 1); PG8_STAGE(PG8_SA(1, 0), a3, voffA);
            PG8_BAR; PG8_WAIT_L(0); PG8_MMA(1, 0, At, B0); PG8_BAR; PG8_SCHED;
            PG8_STAGE(PG8_SB(1, 1), b3 + hstep, voffB);
            PG8_WAIT_V(6); PG8_BAR; PG8_MMA(1, 1, At, B1); PG8_BAR;
            }
        }
        if constexpr (ALIGN_EPI) { if (wr == 0) PG8_BAR; }
        if constexpr (!Epi::AFTER_DRAIN) { E(acc, cur, wr, wc, fr, fq); S.done(cur); }
        if (!has_next) break;
#pragma unroll
        for (int a = 0; a < 2; ++a)
#pragma unroll
            for (int b = 0; b < 2; ++b)
#pragma unroll
                for (int m = 0; m < 4; ++m)
#pragma unroll
                    for (int n = 0; n < 2; ++n) acc[a][b][m][n] = (f32x4){0.f, 0.f, 0.f, 0.f};
        cur = nxt; cA = nA; cB = nB; ++ui;
        if constexpr (ALIGN_EPI) { if (wr == 1) PG8_BAR; }
    }
    PG8_WAIT_V(0);
    if constexpr (!ALIGN_EPI) { if (wr == 0) PG8_BAR; }
    PG8_BAR;
    if constexpr (Epi::AFTER_DRAIN) { E.fused(acc, cur, wr, wc, fr, fq, lds, wid, lane); S.done(cur); }
#undef PG8_SA
#undef PG8_SB
#undef PG8_STAGE
#undef PG8_LDA
#undef PG8_LDB
#undef PG8_MMA
#undef PG8_WAIT_V
#undef PG8_WAIT_L
#undef PG8_BAR
#undef PG8_SCHED
}
}
using pg8::Unit;
typedef f32x4 Acc[2][2][4][2];
#define EPI_ROWS _Pragma("unroll") for (int ai = 0; ai < 2; ++ai) _Pragma("unroll") for (int m = 0; m < 4; ++m)
#define EPI_COLS _Pragma("unroll") for (int bj = 0; bj < 2; ++bj) _Pragma("unroll") for (int n = 0; n < 2; ++n)

struct EpiProj {
    static constexpr bool PERM = false, AFTER_DRAIN = false, MIDK = false;
    float* U; float* PQ;
    __device__ __forceinline__ void operator()(const Acc& acc, const Unit& u, int wr, int wc, int fr, int fq) const {
        const bool isu = u.pn < 2; float* base = isu ? U : PQ; const int ld = isu ? 512 : 768; const int c0 = (isu ? u.pn : u.pn - 2) * 256 + wc * 32 + 4 * fq;
        EPI_ROWS { const int row = u.pm * 256 + ai * 128 + wr * 64 + m * 16 + fr; float* rp = base + (size_t)row * ld + c0;
            EPI_COLS *(f32x4*)(rp + bj * 128 + n * 16) = acc[ai][bj][m][n]; }
    }
};
struct EpiSlab {
    static constexpr bool PERM = false, AFTER_DRAIN = false, MIDK = false;
    float* S;
    __device__ __forceinline__ void operator()(const Acc& acc, const Unit& u, int wr, int wc, int fr, int fq) const {
        float* base = S + (size_t)(u.ko >> 9) * 1024 * 1024 + u.pn * 256 + wc * 32 + 4 * fq;
        EPI_ROWS { const int row = u.pm * 256 + ai * 128 + wr * 64 + m * 16 + fr;
            EPI_COLS *(f32x4*)(base + (size_t)row * 1024 + bj * 128 + n * 16) = acc[ai][bj][m][n]; }
    }
};
template <bool VT> struct EpiStore {
    static constexpr bool PERM = !VT, AFTER_DRAIN = false, MIDK = false;
    bf16_t* O; int ldc; float* F32; int ldf; float* F32T; int ldt; int rowswap;
    __device__ __forceinline__ void operator()(const Acc& acc, const Unit& u, int wr, int wc, int fr, int fq) const {
        if constexpr (VT) { const int sw = ((fq & 1) << 1) | (fq >> 1);
            EPI_ROWS { const int row = u.pm * 256 + ai * 128 + wr * 64 + m * 16 + fr;
                EPI_COLS { const int cb = u.pn * 256 + bj * 128 + wc * 32 + n * 16; const f32x4 v = acc[ai][bj][m][n];
                    *(u32x2*)(O + (size_t)row * ldc + cb + 4 * sw) = pack4(v);
                    if (F32) *(f32x4*)(F32 + (size_t)row * ldf + cb + 4 * fq) = v;
                    if (F32T) { _Pragma("unroll") for (int j = 0; j < 4; ++j) F32T[(size_t)(cb + 4 * fq + j) * ldt + row] = v[j]; } } }
        } else {
            EPI_ROWS { const int row = u.pm * 256 + ai * 128 + wr * 64 + m * 16 + fr;
                _Pragma("unroll") for (int bj = 0; bj < 2; ++bj) { const int cb = u.pn * 256 + bj * 128 + wc * 32 + 8 * fq; const f32x4 v0 = acc[ai][bj][m][0], v1 = acc[ai][bj][m][1];
                    const u32x2 h0 = pack4(v0), h1 = pack4(v1); u32x4 w; w.x = h0.x; w.y = h0.y; w.z = h1.x; w.w = h1.y;
                    *(u32x4*)(O + (size_t)(rowswap ? swap23(row) : row) * ldc + cb) = w;
                    if (F32) { *(f32x4*)(F32 + (size_t)row * ldf + cb) = v0; *(f32x4*)(F32 + (size_t)row * ldf + cb + 4) = v1; }
                    if (F32T) { _Pragma("unroll") for (int j = 0; j < 4; ++j) { F32T[(size_t)(cb + j) * ldt + row] = v0[j]; F32T[(size_t)(cb + 4 + j) * ldt + row] = v1[j]; } } } }
        }
    }
};
struct EpiQ {
    static constexpr bool PERM = false, AFTER_DRAIN = false, MIDK = false;
    bf16_t* Q;
    __device__ __forceinline__ void operator()(const Acc& acc, const Unit& u, int wr, int wc, int fr, int fq) const {
        EPI_ROWS { const int row = u.pm * 256 + ai * 128 + wr * 64 + m * 16 + fr; bf16_t* qp = Q + (size_t)row * 768;
            if (u.pn < 2) { EPI_COLS { const int h = 2 * u.pn + bj, d = wc * 32 + n * 16 + 4 * fq; *(u32x2*)(qp + h * 192 + d) = pack4(acc[ai][bj][m][n] * QSCALE); } }
            else { const int pos = tok_pos(row);
                _Pragma("unroll") for (int n = 0; n < 2; ++n) { f32x4 o1, o2;
                    _Pragma("unroll") for (int j = 0; j < 4; ++j) { float c, s; rope_cs(pos, n * 16 + 4 * fq + j, c, s); const float x1 = acc[ai][0][m][n][j], x2 = acc[ai][1][m][n][j];
                        o1[j] = (x1 * c - x2 * s) * QSCALE; o2[j] = (x2 * c + x1 * s) * QSCALE; }
                    *(u32x2*)(qp + wc * 192 + 128 + n * 16 + 4 * fq) = pack4(o1); *(u32x2*)(qp + wc * 192 + 160 + n * 16 + 4 * fq) = pack4(o2); } }
        }
    }
};
struct EpiGlu {
    static constexpr bool PERM = true, AFTER_DRAIN = false, MIDK = false;
    bf16_t* MIX; float* ST;
    __device__ __forceinline__ void operator()(const Acc& acc, const Unit& u, int wr, int wc, int fr, int fq) const {
        EPI_ROWS { const int row = u.pm * 256 + ai * 128 + wr * 64 + m * 16 + fr; float q = 0.f; u32x2 h[2];
            _Pragma("unroll") for (int n = 0; n < 2; ++n) { const f32x4 v = acc[ai][0][m][n], g = acc[ai][1][m][n]; f32x4 o;
                _Pragma("unroll") for (int j = 0; j < 4; ++j) { o[j] = v[j] * __builtin_amdgcn_rcpf(1.f + __builtin_amdgcn_exp2f(-g[j] * LOG2E)); q += o[j] * o[j]; }
                h[n] = pack4(o); }
            u32x4 w; w.x = h[0].x; w.y = h[0].y; w.z = h[1].x; w.w = h[1].y;
            *(u32x4*)(MIX + (size_t)row * 1024 + u.pn * 128 + wc * 32 + 8 * fq) = w;
            q += __shfl_xor(q, 16); q += __shfl_xor(q, 32);
            if (fq == 0) ST[(size_t)(u.pn * 4 + wc) * MTOK + row] = q; }
    }
};
__device__ __forceinline__ void ln_stats16(const float* PS, const float* PQ, int row, float& mu, float& rstd) {
    float s = 0.f, q = 0.f;
#pragma unroll
    for (int i = 0; i < 16; ++i) { s += PS[(size_t)i * MTOK + row]; q += PQ[(size_t)i * MTOK + row]; }
    mu = s * (1.f / 1024.f); const float var = q * (1.f / 1024.f) - mu * mu; rstd = rsqrtf(var + EPSN);
}
template <int MODE> struct EpiRes {
    static constexpr bool PERM = true, AFTER_DRAIN = false, MIDK = (MODE == 0);
    const float* xp; const float* xs; float* R; bf16_t* Rb; const float* PSin; const float* PQin; const float* g; const float* b; float* PSout; float* PQout; const LAS float* tab;
    __device__ __forceinline__ void mid(Acc& acc, const Unit& u, int wr, int fr) const {
        EPI_ROWS { const float ratio = tab[(u.idx & 1) * 512 + ai * 128 + wr * 64 + m * 16 + fr];
            EPI_COLS acc[ai][bj][m][n] *= ratio; }
    }
    __device__ __forceinline__ void operator()(const Acc& acc, const Unit& u, int wr, int wc, int fr, int fq) const {
        const int c0 = u.pn * 256 + wc * 32 + 8 * fq;
        EPI_ROWS { const int row = u.pm * 256 + ai * 128 + wr * 64 + m * 16 + fr; float rowscale = 1.f, mu = 0.f, rstd = 1.f;
            if (MODE == 0) rowscale = tab[(u.idx & 1) * 512 + 256 + ai * 128 + wr * 64 + m * 16 + fr]; else { mu = tab[u.idx * 512 + ai * 128 + wr * 64 + m * 16 + fr]; rstd = tab[u.idx * 512 + 256 + ai * 128 + wr * 64 + m * 16 + fr]; }
            const float* rsrc = MODE == 0 ? (row < TP ? xp + (size_t)row * 1024 : xs + (size_t)(row - TP) * 1024) : R + (size_t)row * 1024;
            float s = 0.f, q = 0.f;
            _Pragma("unroll") for (int bj = 0; bj < 2; ++bj) { u32x2 hb[2];
                _Pragma("unroll") for (int n = 0; n < 2; ++n) { const int col = c0 + bj * 128 + n * 4; f32x4 res = *(const f32x4*)(rsrc + col);
                    if (MODE == 1) { const f32x4 g4 = *(const f32x4*)(g + col), b4 = *(const f32x4*)(b + col); res = (res - mu) * rstd * g4 + b4; }
                    const f32x4 v = res * ALPHA + acc[ai][bj][m][n] * rowscale;
                    s += (v[0] + v[1]) + (v[2] + v[3]); q += (v[0] * v[0] + v[1] * v[1]) + (v[2] * v[2] + v[3] * v[3]);
                    *(f32x4*)(R + (size_t)row * 1024 + col) = v; hb[n] = pack4(v); }
                if (Rb) { u32x4 w; w.x = hb[0].x; w.y = hb[0].y; w.z = hb[1].x; w.w = hb[1].y; *(u32x4*)(Rb + (size_t)row * 1024 + c0 + bj * 128) = w; } }
            s += __shfl_xor(s, 16); s += __shfl_xor(s, 32); q += __shfl_xor(q, 16); q += __shfl_xor(q, 32);
            if (fq == 0) { PSout[(size_t)(u.pn * 4 + wc) * MTOK + row] = s; PQout[(size_t)(u.pn * 4 + wc) * MTOK + row] = q; } }
    }
};
template <int ACT> struct EpiLnAct {
    static constexpr bool PERM = true, AFTER_DRAIN = false, MIDK = false;
    const LAS float* tab; const float* cs; const float* bw; bf16_t* O; int ldc;
    __device__ __forceinline__ void operator()(const Acc& acc, const Unit& u, int wr, int wc, int fr, int fq) const {
        const int c0 = u.pn * 256 + wc * 32 + 8 * fq; f32x4 cs4[2][2], bw4[2][2];
        EPI_COLS { cs4[bj][n] = *(const f32x4*)(cs + c0 + bj * 128 + n * 4); bw4[bj][n] = *(const f32x4*)(bw + c0 + bj * 128 + n * 4); }
        EPI_ROWS { const int row = u.pm * 256 + ai * 128 + wr * 64 + m * 16 + fr; const float mu = tab[u.idx * 512 + ai * 128 + wr * 64 + m * 16 + fr], rstd = tab[u.idx * 512 + 256 + ai * 128 + wr * 64 + m * 16 + fr];
            _Pragma("unroll") for (int bj = 0; bj < 2; ++bj) { u32x2 h[2];
                _Pragma("unroll") for (int n = 0; n < 2; ++n) { f32x4 v = (acc[ai][bj][m][n] - cs4[bj][n] * mu) * rstd + bw4[bj][n];
                    if (ACT == 0) v = v * XSCALE; else { _Pragma("unroll") for (int j = 0; j < 4; ++j) { const float r = fmaxf(v[j], 0.f); v[j] = r * r; } }
                    h[n] = pack4(v); }
                u32x4 w; w.x = h[0].x; w.y = h[0].y; w.z = h[1].x; w.w = h[1].y;
                *(u32x4*)(O + (size_t)row * ldc + c0 + bj * 128) = w; } }
    }
};

__device__ __forceinline__ void wo_fill_tab(const Unit& u, const float* STssm, const float* STmla, LAS float* tab) {
    const int t = threadIdx.x;
    if (t < 256) { const int row = u.pm * 256 + t; float s1 = 0.f, s2 = 0.f;
#pragma unroll
        for (int i = 0; i < 16; ++i) s1 += STssm[(size_t)i * MTOK + row];
#pragma unroll
        for (int i = 0; i < 4; ++i) s2 += STmla[(size_t)i * MTOK + row];
        const float r1 = rsqrtf(s1 * (1.f / 512.f) + EPSN), r2 = rsqrtf(s2 * (1.f / 512.f) + EPSN);
        tab[(u.idx & 1) * 512 + t] = r1 / r2; tab[(u.idx & 1) * 512 + 256 + t] = r2; }
}

__device__ __forceinline__ void ln_fill_tab(const pg8::StaticOrder& S, const float* PS, const float* PQ, LAS float* tab) {
    const int t = threadIdx.x; Unit u;
    if (t < 256) {
#pragma unroll 1
        for (int i = 0; i < 5; ++i) if (S.next(i, u)) { float mu, rstd; ln_stats16(PS, PQ, u.pm * 256 + t, mu, rstd); tab[i * 512 + t] = mu; tab[i * 512 + 256 + t] = rstd; } }
    __syncthreads();
}

template <int DQK, int DKN, int DV, bool SPLITDV>
__device__ __forceinline__ void attn_unit(LAS unsigned char* lds, const bf16_t* Qp, int ldq, const bf16_t* Kn, int ldkn, const bf16_t* Kpe, const bf16_t* Vt, int ldvt,
                                          int ntiles, int kvlim, bf16_t* Op, int ldo, float* statp, int nrows) {
    constexpr int NS = DQK / 16, KROWB = DQK * 2 + 16, VROWB = 144, KTILE = 64 * KROWB, VTILE = DV * VROWB, STAGE = KTILE + VTILE;
    constexpr int CPR = DQK / 8, KCH = 64 * CPR / 512, VCH = DV * 8 / 512, NKH = SPLITDV ? 2 : 1, NDB = 4;
    static_assert((SPLITDV ? DV / 64 : DV / 32) == NDB, "value tiling");
    int tid_ = threadIdx.x; asm volatile("" : "+v"(tid_));
    const int tid = tid_, wid = __builtin_amdgcn_readfirstlane(tid >> 6), lane = tid & 63, r32 = lane & 31, hi = lane >> 5, rg = wid & 3, grp = wid >> 2;
    const int keyoff = SPLITDV ? 0 : 32 * grp, dbase = SPLITDV ? grp * (DV / 2) : 0;
    const bool wact = kvlim > 0;
    bf16x8 qf[NS];
    { const bf16_t* qrow = Qp + (size_t)(rg * 32 + r32) * ldq + hi * 8;
#pragma unroll
      for (int s = 0; s < NS; ++s) qf[s] = wact ? *(const bf16x8*)(qrow + 16 * s) : (bf16x8){0, 0, 0, 0, 0, 0, 0, 0}; }
    constexpr bool KREG = (CPR == 32) && (DKN == DQK);
    const bf16_t* kp[KREG ? 1 : KCH]; int kst[KREG ? 1 : KCH], kld[KREG ? 1 : KCH];
    if constexpr (KREG) { const int row = tid >> 5, cc = tid & 31; kp[0] = Kn + (size_t)row * ldkn + cc * 8; kst[0] = 64 * ldkn; kld[0] = row * KROWB + cc * 16; }
    else {
#pragma unroll
        for (int i = 0; i < KCH; ++i) { const int c = tid + 512 * i, row = c / CPR, cc = c - row * CPR;
            if (cc < DKN / 8) { kp[i] = Kn + (size_t)row * ldkn + cc * 8; kst[i] = 64 * ldkn; } else { kp[i] = Kpe + (size_t)row * 64 + (cc - DKN / 8) * 8; kst[i] = 64 * 64; }
            kld[i] = row * KROWB + cc * 16; } }
    const bf16_t* vp0 = Vt + (size_t)(tid >> 3) * ldvt + (tid & 7) * 8; const int vld0 = KTILE + (tid >> 3) * VROWB + (tid & 7) * 16;
#define KP(i) (KREG ? kp[0] + (size_t)(i) * 16 * ldkn : kp[KREG ? 0 : (i)])
#define KST(i) kst[KREG ? 0 : (i)]
#define KLD(i) (KREG ? kld[0] + (i) * 16 * KROWB : kld[KREG ? 0 : (i)])
    u32x4 sk[KCH], sv[VCH];
#define AT_ISSUE_K(t) do { _Pragma("unroll") for (int i = 0; i < KCH; ++i) sk[i] = *(const u32x4*)(KP(i) + (size_t)(t) * KST(i)); } while (0)
#define AT_ISSUE_V(t) do { _Pragma("unroll") for (int i = 0; i < VCH; ++i) sv[i] = *(const u32x4*)(vp0 + (size_t)(i) * 64 * ldvt + (size_t)(t) * 64); } while (0)
#define AT_ISSUE(t) do { AT_ISSUE_K(t); AT_ISSUE_V(t); } while (0)
#define AT_WRITE(st) do { _Pragma("unroll") for (int i = 0; i < KCH; ++i) *(LAS u32x4*)(lds + (st) * STAGE + KLD(i)) = sk[i]; \
                          _Pragma("unroll") for (int i = 0; i < VCH; ++i) *(LAS u32x4*)(lds + (st) * STAGE + vld0 + (i) * 64 * VROWB) = sv[i]; } while (0)
    f32x16 o[NDB];
#pragma unroll
    for (int d = 0; d < NDB; ++d)
#pragma unroll
        for (int r = 0; r < 16; ++r) o[d][r] = 0.f;
    float mrun = -1e30f, lrun = 0.f;
    const int kboff = (keyoff + r32) * KROWB + hi * 16, vboff = KTILE + (dbase + r32) * VROWB + keyoff * 2 + hi * 16;
    AT_ISSUE(0); AT_WRITE(0); __syncthreads();
    if (!SPLITDV && ntiles > 1) AT_ISSUE(1);
    for (int t = 0; t < ntiles; ++t) {
        const int st = t & 1;
        if (SPLITDV) { if (t + 1 < ntiles) AT_ISSUE_K(t + 1); }
        else if (grp == 1) { if (t + 1 < ntiles) AT_WRITE(st ^ 1); if (t + 2 < ntiles) AT_ISSUE(t + 2); }
        if (t * 64 + keyoff < kvlim) {
            f32x16 p[NKH];
            const LAS unsigned char* kb = lds + st * STAGE + kboff;
#pragma unroll
            for (int kh = 0; kh < NKH; ++kh) {
#pragma unroll
                for (int r = 0; r < 16; ++r) p[kh][r] = 0.f;
#pragma unroll
                for (int s = 0; s < NS; ++s) { const bf16x8 kf = *(const LAS bf16x8*)(kb + kh * 32 * KROWB + s * 32); p[kh] = __builtin_amdgcn_mfma_f32_32x32x16_bf16(kf, qf[s], p[kh], 0, 0, 0); }
            }
            float tmax = p[0][0];
#pragma unroll
            for (int kh = 0; kh < NKH; ++kh)
#pragma unroll
                for (int r = 0; r < 16; ++r) tmax = fmaxf(tmax, p[kh][r]);
            { auto rr = __builtin_amdgcn_permlane32_swap(__float_as_uint(tmax), __float_as_uint(tmax), false, false); tmax = fmaxf(__uint_as_float(rr[0]), __uint_as_float(rr[1])); }
            const float mnew = fmaxf(mrun, tmax);
            if (__any(mnew > mrun)) { const float alpha = __builtin_amdgcn_exp2f(mrun - mnew); lrun *= alpha; mrun = mnew;
#pragma unroll
                for (int d = 0; d < NDB; ++d)
#pragma unroll
                    for (int r = 0; r < 16; ++r) o[d][r] *= alpha; }
            float ls = 0.f;
#pragma unroll
            for (int kh = 0; kh < NKH; ++kh)
#pragma unroll
                for (int r = 0; r < 16; ++r) { p[kh][r] = __builtin_amdgcn_exp2f(p[kh][r] - mrun); ls += p[kh][r]; }
            lrun += ls;
            bf16x8 pf[NKH * 2];
#pragma unroll
            for (int kh = 0; kh < NKH; ++kh)
#pragma unroll
                for (int s2 = 0; s2 < 2; ++s2) { u32x4 w; w.x = cvt_pk_bf16(p[kh][8 * s2 + 0], p[kh][8 * s2 + 1]); w.y = cvt_pk_bf16(p[kh][8 * s2 + 2], p[kh][8 * s2 + 3]);
                    w.z = cvt_pk_bf16(p[kh][8 * s2 + 4], p[kh][8 * s2 + 5]); w.w = cvt_pk_bf16(p[kh][8 * s2 + 6], p[kh][8 * s2 + 7]); pf[kh * 2 + s2] = *(bf16x8*)&w; }
            if (SPLITDV && t + 1 < ntiles) AT_ISSUE_V(t + 1);
            const LAS unsigned char* vb = lds + st * STAGE + vboff;
#pragma unroll
            for (int d = 0; d < NDB; ++d)
#pragma unroll
                for (int ks = 0; ks < NKH * 2; ++ks) { const bf16x8 vf = *(const LAS bf16x8*)(vb + d * 32 * VROWB + ks * 32); o[d] = __builtin_amdgcn_mfma_f32_32x32x16_bf16(vf, pf[ks], o[d], 0, 0, 0); }
        } else if (SPLITDV && t + 1 < ntiles) AT_ISSUE_V(t + 1);
        if (SPLITDV && t + 1 < ntiles) AT_WRITE(st ^ 1);
        if (!SPLITDV && grp == 0) { if (t + 1 < ntiles) AT_WRITE(st ^ 1); if (t + 2 < ntiles) AT_ISSUE(t + 2); }
        __syncthreads();
    }
#undef AT_ISSUE
#undef AT_ISSUE_K
#undef AT_ISSUE_V
#undef KP
#undef KST
#undef KLD
#undef AT_WRITE
    lrun += __shfl_xor(lrun, 32);
    if (!SPLITDV) {
        LAS float* MO = (LAS float*)lds; LAS float* MM = (LAS float*)(lds + 65536); LAS float* ML = (LAS float*)(lds + 65536 + 1024);
        if (grp == 1) {
#pragma unroll
            for (int d = 0; d < NDB; ++d)
#pragma unroll
                for (int r = 0; r < 16; ++r) MO[(rg * 64 + d * 16 + r) * 64 + lane] = o[d][r];
            MM[rg * 64 + lane] = mrun; ML[rg * 64 + lane] = lrun;
        }
        __syncthreads();
        if (grp == 0) {
            const float m1 = MM[rg * 64 + lane], l1 = ML[rg * 64 + lane], ms = fmaxf(mrun, m1);
            const float a0 = __builtin_amdgcn_exp2f(mrun - ms), a1 = __builtin_amdgcn_exp2f(m1 - ms);
            lrun = lrun * a0 + l1 * a1;
#pragma unroll
            for (int d = 0; d < NDB; ++d)
#pragma unroll
                for (int r = 0; r < 16; ++r) o[d][r] = o[d][r] * a0 + MO[(rg * 64 + d * 16 + r) * 64 + lane] * a1;
        }
    }
    if (SPLITDV || grp == 0) {
        const float inv = __builtin_amdgcn_rcpf(lrun); const int row = rg * 32 + r32; const bool ok = wact && row < nrows; float ss = 0.f;
        bf16_t* orow = Op + (size_t)row * ldo + dbase + 4 * hi;
#pragma unroll
        for (int d = 0; d < NDB; ++d)
#pragma unroll
            for (int g4 = 0; g4 < 4; ++g4) { f32x4 v; v[0] = o[d][4 * g4] * inv; v[1] = o[d][4 * g4 + 1] * inv; v[2] = o[d][4 * g4 + 2] * inv; v[3] = o[d][4 * g4 + 3] * inv;
                ss += (v[0] * v[0] + v[1] * v[1]) + (v[2] * v[2] + v[3] * v[3]);
                if (ok) *(u32x2*)(orow + 32 * d + 8 * g4) = pack4(v); }
        ss += __shfl_xor(ss, 32);
        if (statp && ok && hi == 0) statp[row] = ss;
    }
    __syncthreads();
}


__device__ __forceinline__ float gelu_tanh(float x) { const float z2 = 1.5957691216057308f * (x + 0.044715f * x * x * x); return x * __builtin_amdgcn_rcpf(1.f + __builtin_amdgcn_exp2f(-z2 * LOG2E)); }
struct SsmU { bf16x8 hi, lo; };
__device__ __forceinline__ void split_hilo(f32x4 a, f32x4 b, u32x4& hi, u32x4& lo) {
    hi.x = cvt_pk_bf16(a[0], a[1]); hi.y = cvt_pk_bf16(a[2], a[3]); hi.z = cvt_pk_bf16(b[0], b[1]); hi.w = cvt_pk_bf16(b[2], b[3]);
    lo.x = cvt_pk_bf16(a[0] - __uint_as_float(hi.x << 16), a[1] - __uint_as_float(hi.x & 0xffff0000u)); lo.y = cvt_pk_bf16(a[2] - __uint_as_float(hi.y << 16), a[3] - __uint_as_float(hi.y & 0xffff0000u));
    lo.z = cvt_pk_bf16(b[0] - __uint_as_float(hi.z << 16), b[1] - __uint_as_float(hi.z & 0xffff0000u)); lo.w = cvt_pk_bf16(b[2] - __uint_as_float(hi.w << 16), b[3] - __uint_as_float(hi.w & 0xffff0000u));
}
struct SsmW { float lr, li; bf16x8 ab[8]; };
__device__ __forceinline__ void ssm_load_w(const Frame& F, int g, int lane, SsmW& w) {
    const float* LAM = (const float*)(F.ws + W_LAM); const float* BB = (const float*)(F.ws + W_BB);
    w.lr = LAM[g * 64 + lane]; w.li = LAM[2048 + g * 64 + lane];
    const int q = lane >> 4;
#pragma unroll
    for (int blk = 0; blk < 8; ++blk) { const int row = 16 * blk + (lane & 15);
        const float* bp = (row < 64 ? BB + (size_t)(g * 64 + row) * 16 : BB + 32768 + (size_t)(g * 64 + row - 64) * 16) + 8 * (q & 1);
        u32x4 hi, lo; split_hilo(*(const f32x4*)bp, *(const f32x4*)(bp + 4), hi, lo); const u32x4 sel = q < 2 ? hi : lo; w.ab[blk] = *(const bf16x8*)&sel; }
}
__device__ __forceinline__ void ssm_load_u(const float* U, int tb, int g, int lane, SsmU& ub) {
    const int q = lane >> 4; const float* up = U + (size_t)(tb + (lane & 15)) * 512 + g * 16 + 8 * (q & 1);
    u32x4 hi, lo; split_hilo(*(const f32x4*)up, *(const f32x4*)(up + 4), hi, lo); if (q >= 2) lo = (u32x4){0u, 0u, 0u, 0u};
    ub.hi = *(const bf16x8*)&hi; ub.lo = *(const bf16x8*)&lo;
}
template <bool WR> __device__ __forceinline__ void ssm_block16(const SsmW& w, const SsmU& ub, int lane, float& xr, float& xi, LAS float* XW) {
#pragma unroll
    for (int blk = 0; blk < 8; ++blk) { f32x4 d = {0.f, 0.f, 0.f, 0.f};
        d = __builtin_amdgcn_mfma_f32_16x16x32_bf16(w.ab[blk], ub.hi, d, 0, 0, 0); d = __builtin_amdgcn_mfma_f32_16x16x32_bf16(w.ab[blk], ub.lo, d, 0, 0, 0);
        *(LAS f32x4*)(XW + (lane & 15) * 132 + 16 * blk + 4 * (lane >> 4)) = d; }
    float br[16], bi[16];
#pragma unroll
    for (int t = 0; t < 16; ++t) { br[t] = XW[t * 132 + lane]; bi[t] = XW[t * 132 + 64 + lane]; }
#pragma unroll
    for (int t = 0; t < 16; ++t) { const float nr = fmaf(w.lr, xr, fmaf(-w.li, xi, br[t])), ni = fmaf(w.lr, xi, fmaf(w.li, xr, bi[t])); xr = nr; xi = ni;
        if (WR) { XW[t * 132 + lane] = xr; XW[t * 132 + 64 + lane] = xi; } }
}
__device__ __forceinline__ void ssm_pass_a(const Frame& F) {
    const float* U = F.out; float* SEND = (float*)(F.ws + W_SEND); LAS float* XW = (LAS float*)(F.lds + F.wid * 8448);
    const int g = (F.bid * 8 + F.wid) & 31, p = F.lane; SsmW w; ssm_load_w(F, g, p, w);
    for (int it = F.bid * 8 + F.wid; it < 256 * 32; it += F.G * 8) { const int c = it >> 5;
        float xr = 0.f, xi = 0.f;
        SsmU ub[4];
#pragma unroll
        for (int sb = 0; sb < 4; ++sb) ssm_load_u(U, c * 64 + sb * 16, g, p, ub[sb]);
#pragma unroll
        for (int sb = 0; sb < 4; ++sb) ssm_block16<false>(w, ub[sb], p, xr, xi, XW);
        SEND[(size_t)c * 4096 + g * 64 + p] = xr; SEND[(size_t)c * 4096 + 2048 + g * 64 + p] = xi; }
}
__device__ __forceinline__ void ssm_pass_b(const Frame& F, int b0) {
    float* SEND = (float*)(F.ws + W_SEND); const float* LAM64 = (const float*)(F.ws + W_LAM64);
    const int i = b0 * 512 + F.tid; if (i < 0 || i >= 2048) return;
    const float l6r = LAM64[i], l6i = LAM64[2048 + i]; float xr = 0.f, xi = 0.f;
    float nr_[16], ni_[16];
#pragma unroll
    for (int j = 0; j < 16; ++j) { nr_[j] = SEND[(size_t)j * 4096 + i]; ni_[j] = SEND[(size_t)j * 4096 + 2048 + i]; }
    for (int c0 = 0; c0 < 256; c0 += 16) { float sr[16], si[16];
#pragma unroll
        for (int j = 0; j < 16; ++j) { sr[j] = nr_[j]; si[j] = ni_[j]; }
        if (c0 + 16 < 256) {
#pragma unroll
            for (int j = 0; j < 16; ++j) { nr_[j] = SEND[(size_t)(c0 + 16 + j) * 4096 + i]; ni_[j] = SEND[(size_t)(c0 + 16 + j) * 4096 + 2048 + i]; } }
#pragma unroll
        for (int j = 0; j < 16; ++j) { SEND[(size_t)(c0 + j) * 4096 + i] = xr; SEND[(size_t)(c0 + j) * 4096 + 2048 + i] = xi;
            const float nr = fmaf(l6r, xr, fmaf(-l6i, xi, sr[j])), ni = fmaf(l6r, xi, fmaf(l6i, xr, si[j])); xr = nr; xi = ni; } }
}
__device__ __forceinline__ void ssm_pass_c(const Frame& F) {
    const float* U = F.out; bf16_t* YG = (bf16_t*)((unsigned char*)F.out + 36 * MiB); const float* SEND = (const float*)(F.ws + W_SEND);
    const float* c_re = F.a->in[18]; const float* c_im = F.a->in[19]; const float* dsk = F.a->in[20];
    LAS float* XW = (LAS float*)(F.lds + F.wid * 8448);
    const int p = F.lane, hq = 4 * (F.lane >> 4), tl = F.lane & 15;
    const int g = (F.bid * 8 + F.wid) & 31; SsmW w; ssm_load_w(F, g, p, w);
    bf16x8 cab[4];
#pragma unroll
    for (int ks = 0; ks < 4; ++ks) { const int k = 32 * ks + 8 * (F.lane >> 4); const float* cp = ks < 2 ? c_re + (size_t)(g * 16 + tl) * 64 + k : c_im + (size_t)(g * 16 + tl) * 64 + (k - 64);
        f32x4 a = *(const f32x4*)cp, b = *(const f32x4*)(cp + 4); if (ks >= 2) { a = -a; b = -b; }
        u32x4 w; w.x = cvt_pk_bf16(a[0], a[1]); w.y = cvt_pk_bf16(a[2], a[3]); w.z = cvt_pk_bf16(b[0], b[1]); w.w = cvt_pk_bf16(b[2], b[3]); cab[ks] = *(bf16x8*)&w; }
    const f32x4 ds4 = *(const f32x4*)(dsk + g * 16 + hq);
    for (int it = F.bid * 8 + F.wid; it < 9216; it += F.G * 8) {
        const bool prompt = it < 8192; const int c = prompt ? (it >> 5) : ((it - 8192) >> 5);
        float xr, xi; int tok0, nsb;
        if (prompt) { xr = SEND[(size_t)c * 4096 + g * 64 + p]; xi = SEND[(size_t)c * 4096 + 2048 + g * 64 + p];
            tok0 = c * 64; nsb = 4;
        } else { xr = F.a->in[5][(size_t)(c * 32 + g) * 64 + p]; xi = F.a->in[6][(size_t)(c * 32 + g) * 64 + p]; tok0 = TP + c * 32; nsb = 2; }
        SsmU ub[4]; f32x4 u4a[4];
#pragma unroll
        for (int sb = 0; sb < 4; ++sb) { ssm_load_u(U, tok0 + sb * 16, g, p, ub[sb]); u4a[sb] = *(const f32x4*)(U + (size_t)(tok0 + sb * 16 + tl) * 512 + g * 16 + hq); }
#pragma unroll
        for (int sb = 0; sb < 4; ++sb) { if (sb >= nsb) break; const int tb = tok0 + sb * 16;
            ssm_block16<true>(w, ub[sb], p, xr, xi, XW);
            f32x4 y0 = {0.f, 0.f, 0.f, 0.f}, y1 = {0.f, 0.f, 0.f, 0.f};
#pragma unroll
            for (int ks = 0; ks < 4; ++ks) { const LAS float* xp = XW + tl * 132 + 32 * ks + 8 * (F.lane >> 4); const f32x4 xa = *(const LAS f32x4*)xp, xb = *(const LAS f32x4*)(xp + 4);
                u32x4 w; w.x = cvt_pk_bf16(xa[0], xa[1]); w.y = cvt_pk_bf16(xa[2], xa[3]); w.z = cvt_pk_bf16(xb[0], xb[1]); w.w = cvt_pk_bf16(xb[2], xb[3]); const bf16x8 xf = *(bf16x8*)&w;
                if (ks & 1) y1 = __builtin_amdgcn_mfma_f32_16x16x32_bf16(cab[ks], xf, y1, 0, 0, 0); else y0 = __builtin_amdgcn_mfma_f32_16x16x32_bf16(cab[ks], xf, y0, 0, 0, 0); }
            f32x4 y = y0 + y1 + ds4 * u4a[sb];
#pragma unroll
            for (int j = 0; j < 4; ++j) y[j] = gelu_tanh(y[j]);
            *(u32x2*)(YG + (size_t)(tb + tl) * 512 + g * 16 + hq) = pack4(y);
        }
        if (prompt) { if (c == 255) { F.out[O_SREP + g * 64 + p] = xr; F.out[O_SIMP + g * 64 + p] = xi; } }
        else { F.out[O_SRES + (size_t)(c * 32 + g) * 64 + p] = xr; F.out[O_SIMS + (size_t)(c * 32 + g) * 64 + p] = xi; }
    }
}

__device__ __forceinline__ float wave_sum(float v) {
#pragma unroll
    for (int o = 32; o > 0; o >>= 1) v += __shfl_xor(v, o);
    return v;
}
__device__ __forceinline__ void post_rows(const Frame& F) {
    const float* PQ = (const float*)(F.ws + A_PQ); bf16_t* CQN = (bf16_t*)(F.ws + A_CQN); bf16_t* CKV = (bf16_t*)(F.ws + A_CKV); bf16_t* KPE = (bf16_t*)(F.ws + A_KPE);
    const float* gkv = F.a->in[12];
    const int l = F.lane, rstep = F.G * 8; int row = F.bid * 8 + F.wid;
    f32x4 nq0 = {0.f, 0.f, 0.f, 0.f}, nkv = nq0; u32x2 nq1 = {0u, 0u}; float npe = 0.f;
    if (row < MTOK) { const float* pr = PQ + (size_t)row * 768; nq0 = *(const f32x4*)(pr + 4 * l); nq1 = *(const u32x2*)(pr + 256 + 2 * l); nkv = *(const f32x4*)(pr + 384 + 4 * l); npe = pr[640 + l]; }
    for (; row < MTOK; row += rstep) {
        const f32x4 q0 = nq0, kv = nkv; const u32x2 q1r = nq1; const float pe = npe; const float q10 = __uint_as_float(q1r.x), q11 = __uint_as_float(q1r.y);
        if (row + rstep < MTOK) { const float* pr = PQ + (size_t)(row + rstep) * 768; nq0 = *(const f32x4*)(pr + 4 * l); nq1 = *(const u32x2*)(pr + 256 + 2 * l); nkv = *(const f32x4*)(pr + 384 + 4 * l); npe = pr[640 + l]; }
        const float sq = wave_sum((q0[0] * q0[0] + q0[1] * q0[1]) + (q0[2] * q0[2] + q0[3] * q0[3]) + q10 * q10 + q11 * q11);
        const float skv = wave_sum((kv[0] * kv[0] + kv[1] * kv[1]) + (kv[2] * kv[2] + kv[3] * kv[3]));
        const float rq = rsqrtf(sq * (1.f / 384.f) + EPSN), rkv = rsqrtf(skv * (1.f / 256.f) + EPSN);
        *(u32x2*)(CQN + (size_t)row * 384 + 4 * l) = pack4(q0 * rq); *(unsigned*)(CQN + (size_t)row * 384 + 256 + 2 * l) = cvt_pk_bf16(q10 * rq, q11 * rq);
        const f32x4 g4 = *(const f32x4*)(gkv + 4 * l); const f32x4 kvn = kv * rkv * g4; const int kr = tok_kvrow(row);
        float* oc = row < TP ? F.out + O_CKVP + (size_t)row * 256 : F.out + O_CKVS + (size_t)(row - TP) * 256; float* ok = row < TP ? F.out + O_KPEP + (size_t)row * 64 : F.out + O_KPES + (size_t)(row - TP) * 64;
        *(f32x4*)(oc + 4 * l) = kvn; *(u32x2*)(CKV + (size_t)kr * 256 + 4 * l) = pack4(kvn);
        float c, s; rope_cs(tok_pos(row), l & 31, c, s); const float other = __shfl_xor(pe, 32);
        const float ro = l < 32 ? pe * c - other * s : pe * c + other * s;
        ok[l] = ro; const float ron = __shfl_xor(ro, 1); if ((l & 1) == 0) *(unsigned*)(KPE + (size_t)swap23(kr) * 64 + l) = cvt_pk_bf16(ro, ron); }
}
__device__ __forceinline__ void final_ln(const Frame& F) {
    const float* g = F.a->in[32] + 2048; const float* b = F.a->in[33] + 2048;
    const int rstep = F.G * 8; int row = F.bid * 8 + F.wid; f32x4 nv[4];
#pragma unroll
    for (int i = 0; i < 4; ++i) nv[i] = row < MTOK ? *(const f32x4*)(F.out + O_Y + (size_t)row * 1024 + i * 256 + 4 * F.lane) : (f32x4){0.f, 0.f, 0.f, 0.f};
    for (; row < MTOK; row += rstep) { float* pr = F.out + O_Y + (size_t)row * 1024; f32x4 v[4]; float s = 0.f;
#pragma unroll
        for (int i = 0; i < 4; ++i) { v[i] = nv[i]; s += (v[i][0] + v[i][1]) + (v[i][2] + v[i][3]); }
        if (row + rstep < MTOK) {
#pragma unroll
            for (int i = 0; i < 4; ++i) nv[i] = *(const f32x4*)(pr + (size_t)rstep * 1024 + i * 256 + 4 * F.lane); }
        if (row >= TP) {
            const float* ST2 = (const float*)(F.ws + W_ST2); float mu2, rstd2; ln_stats16(ST2, ST2 + 16 * MTOK, row, mu2, rstd2);
            const float* SL = (const float*)(F.ws + A_R2B) + (size_t)(row - TP) * 1024; s = 0.f;
#pragma unroll
            for (int i = 0; i < 4; ++i) { const int c = i * 256 + 4 * F.lane; const f32x4 g1 = *(const f32x4*)(F.a->in[32] + 1024 + c), b1 = *(const f32x4*)(F.a->in[33] + 1024 + c);
                f32x4 a = (v[i] - mu2) * rstd2 * g1 + b1; a = a * ALPHA;
#pragma unroll
                for (int k = 0; k < 8; ++k) a = a + *(const f32x4*)(SL + (size_t)k * 1024 * 1024 + c);
                v[i] = a; s += (a[0] + a[1]) + (a[2] + a[3]); } }
        const float mu = wave_sum(s) * (1.f / 1024.f); float q = 0.f;
#pragma unroll
        for (int i = 0; i < 4; ++i) { const f32x4 d = v[i] - mu; q += (d[0] * d[0] + d[1] * d[1]) + (d[2] * d[2] + d[3] * d[3]); }
        const float rstd = rsqrtf(wave_sum(q) * (1.f / 1024.f) + EPSN);
#pragma unroll
        for (int i = 0; i < 4; ++i) { const f32x4 g4 = *(const f32x4*)(g + i * 256 + 4 * F.lane), b4 = *(const f32x4*)(b + i * 256 + 4 * F.lane); *(f32x4*)(pr + i * 256 + 4 * F.lane) = (v[i] - mu) * rstd * g4 + b4; } }
}

struct MapId { __device__ __forceinline__ int operator()(int n) const { return n; } };
struct MapWin { __device__ __forceinline__ int operator()(int n) const { return n < 1216 ? n : -1; } };
struct MapWq { __device__ __forceinline__ int operator()(int n) const { if (n < 512) return (n >> 7) * 192 + (n & 127); const int x = n - 512, part = x >> 7, h = (x >> 5) & 3, i = x & 31; return h * 192 + 128 + part * 32 + i; } };
struct MapWk { __device__ __forceinline__ int operator()(int n) const { return (n >> 7) * 256 + (n & 127); } };
struct MapWv { __device__ __forceinline__ int operator()(int n) const { return (n >> 7) * 256 + 128 + (n & 127); } };
struct MapGlu { __device__ __forceinline__ int operator()(int n) const { const int pn = n >> 8, bj = (n >> 7) & 1, x = n & 127; return bj * 512 + pn * 128 + x; } };
template <class CM, bool PERMK = false> __device__ __forceinline__ void wconv(const Frame& F, bf16_t* __restrict__ dst, const float* __restrict__ src, int ld, int K, int N, CM cm, const float* sc0, const float* sc1, int ksplit, int& rot) {
    const int ntn = N >> 5, ntiles = ntn * (K >> 6), tid = F.tid, kr = tid >> 3, nq = tid & 7;
    LAS float* T = (LAS float*)F.lds;
    for (int base = ((F.bid + F.G - rot % F.G) % F.G) * 4; base < ntiles; base += F.G * 4) { f32x4 v[4];
#pragma unroll
        for (int u = 0; u < 4; ++u) { const int tile = base + u; v[u] = (f32x4){0.f, 0.f, 0.f, 0.f};
            if (tile < ntiles) { const int tn = tile % ntn, tk = tile / ntn, col = cm(tn * 32), k = tk * 64 + kr;
                if (col >= 0) { v[u] = *(const f32x4*)(src + (size_t)k * ld + col + 4 * nq); if (sc0) v[u] = v[u] * (k < ksplit ? sc0[k] : sc1[k - ksplit]); } } }
#pragma unroll
        for (int u = 0; u < 4; ++u) {
#pragma unroll
            for (int j = 0; j < 4; ++j) T[u * 2112 + kr * 33 + 4 * nq + j] = v[u][j]; }
        __syncthreads();
        { const int half = tid >> 8, tt = tid & 255, n = tt >> 3, kq = tt & 7;
#pragma unroll
          for (int uu = 0; uu < 2; ++uu) { const int u = half * 2 + uu, tile = base + u;
              if (tile < ntiles) { const int tn = tile % ntn, tk = tile / ntn; float x[8];
#pragma unroll
                  for (int j = 0; j < 8; ++j) { const int pos = 8 * kq + j, kk = PERMK ? ((pos & ~12) | ((pos & 4) << 1) | ((pos & 8) >> 1)) : pos; x[j] = T[u * 2112 + kk * 33 + n]; }
                  u32x4 w; w.x = cvt_pk_bf16(x[0], x[1]); w.y = cvt_pk_bf16(x[2], x[3]); w.z = cvt_pk_bf16(x[4], x[5]); w.w = cvt_pk_bf16(x[6], x[7]);
                  *(u32x4*)(dst + (size_t)(tn * 32 + n) * K + tk * 64 + 8 * kq) = w; } } }
        __syncthreads(); }
    rot += (ntiles + 3) >> 2;
}
__device__ __forceinline__ void cvt_flat(const Frame& F, bf16_t* __restrict__ dst, const float* __restrict__ src, long n8) {
    const long gs = (long)F.G * 512;
    for (long base = (long)F.bid * 512 + F.tid; base < n8; base += 4 * gs) { f32x4 a[4], b[4];
#pragma unroll
        for (int u = 0; u < 4; ++u) { const long i = base + u * gs; const long ii = i < n8 ? i : 0; a[u] = *(const f32x4*)(src + ii * 8); b[u] = *(const f32x4*)(src + ii * 8 + 4); }
#pragma unroll
        for (int u = 0; u < 4; ++u) { const long i = base + u * gs; if (i < n8) { u32x4 w; w.x = cvt_pk_bf16(a[u][0], a[u][1]); w.y = cvt_pk_bf16(a[u][2], a[u][3]); w.z = cvt_pk_bf16(b[u][0], b[u][1]); w.w = cvt_pk_bf16(b[u][2], b[u][3]); *(u32x4*)(dst + i * 8) = w; } } }
}
__device__ __forceinline__ void colsum_job(const Frame& F, const float* W, int N, const float* g, const float* b, float* cs, float* bw, int rotb) {
    LAS float* red = (LAS float*)F.lds;
    const int seg = F.tid >> 4, col = F.tid & 15;
    for (int task = (F.bid + F.G - rotb % F.G) % F.G; task < N / 16; task += F.G) { const int n = task * 16 + col; float s = 0.f, t = 0.f;
#pragma unroll
        for (int j = 0; j < 32; ++j) { const int k = seg * 32 + j; const float w = W[(size_t)k * N + n]; s += bf16_round(w * g[k]); t = fmaf(b[k], w, t); }
        red[F.tid] = s; red[512 + F.tid] = t; __syncthreads();
        if (F.tid < 16) { float a = 0.f, c = 0.f;
#pragma unroll
            for (int i = 0; i < 32; ++i) { a += red[i * 16 + F.tid]; c += red[512 + i * 16 + F.tid]; }
            cs[n] = a; bw[n] = c; }
        __syncthreads(); }
}
__device__ __forceinline__ void ssm_consts(const Frame& F) {
    const int i = F.bid * 512 + F.tid; if (i >= 2048) return;
    const int g = i >> 6; float* LAM = (float*)(F.ws + W_LAM); float* LAM64 = (float*)(F.ws + W_LAM64); float* BB = (float*)(F.ws + W_BB);
    const double ar = F.a->in[14][i], ai = F.a->in[15][i], dt = exp((double)F.a->in[21][g]);
    const double mag = exp(ar * dt), lr = mag * cos(ai * dt), li = mag * sin(ai * dt);
    LAM[i] = (float)lr; LAM[2048 + i] = (float)li;
    double pr = lr, pi = li;
#pragma unroll
    for (int k = 0; k < 6; ++k) { const double nr = pr * pr - pi * pi, ni = 2.0 * pr * pi; pr = nr; pi = ni; }
    LAM64[i] = (float)pr; LAM64[2048 + i] = (float)pi;
    const double nr = lr - 1.0, ni = li, den = ar * ar + ai * ai, fr = (nr * ar + ni * ai) / den, fi = (ni * ar - nr * ai) / den;
#pragma unroll
    for (int h = 0; h < 16; ++h) { const double br = F.a->in[16][(size_t)i * 16 + h], bi = F.a->in[17][(size_t)i * 16 + h];
        BB[(size_t)i * 16 + h] = (float)(fr * br - fi * bi); BB[32768 + (size_t)i * 16 + h] = (float)(fr * bi + fi * br); }
}
__device__ __forceinline__ void cvt_caches(const Frame& F, int b0, int nb) {
    unsigned char* ws = F.ws; { bf16_t* CKV = (bf16_t*)(ws + A_CKV); bf16_t* KPE = (bf16_t*)(ws + A_KPE); const long gs = (long)nb * 512;
#pragma unroll 4
      for (long i = (long)b0 * 512 + F.tid; i < 32L * 1024 * 32; i += gs) { const int c8 = (int)(i & 31), j = (int)((i >> 5) & 1023), bb = (int)(i >> 15);
          const float* s = F.a->in[3] + ((size_t)(bb * 1024 + j) * 256 + c8 * 8); const f32x4 a = *(const f32x4*)s, b = *(const f32x4*)(s + 4);
          u32x4 w; w.x = cvt_pk_bf16(a[0], a[1]); w.y = cvt_pk_bf16(a[2], a[3]); w.z = cvt_pk_bf16(b[0], b[1]); w.w = cvt_pk_bf16(b[2], b[3]);
          *(u32x4*)(CKV + (size_t)(TP + bb * KVS + j) * 256 + c8 * 8) = w; }
#pragma unroll 2
      for (long i = (long)b0 * 512 + F.tid; i < 32L * 1024 * 8; i += gs) { const int c8 = (int)(i & 7), j = (int)((i >> 3) & 1023), bb = (int)(i >> 13);
          const float* s = F.a->in[4] + ((size_t)(bb * 1024 + j) * 64 + c8 * 8); const f32x4 a = *(const f32x4*)s, b = *(const f32x4*)(s + 4);
          u32x4 w; w.x = cvt_pk_bf16(a[0], a[1]); w.y = cvt_pk_bf16(a[2], a[3]); w.z = cvt_pk_bf16(b[0], b[1]); w.w = cvt_pk_bf16(b[2], b[3]);
          *(u32x4*)(KPE + (size_t)swap23(TP + bb * KVS + j) * 64 + c8 * 8) = w; } }
}
#ifndef PRO_DUP
#define PRO_DUP 0
#endif
#define DUPP(j) _Pragma("unroll") for (int rp_ = 0; rp_ < (((PRO_DUP >> (j)) & 1) ? 2 : 1); ++rp_)
__device__ __forceinline__ void prologue(const Frame& F) {
    unsigned char* ws = F.ws;
    DUPP(0) ssm_consts(F);
    int rot = 8;
    DUPP(1) {
    wconv(F, (bf16_t*)(ws + W_WIN), F.a->in[9], 1216, 1024, 1280, MapWin(), nullptr, nullptr, 0, rot);
    }
    DUPP(2) {
    if (F.G > 8) { if (F.bid >= 4) { Frame F2 = F; F2.bid = F.bid - 4; F2.G = F.G - 4; cvt_flat(F2, (bf16_t*)(ws + A_XB), F.a->in[0], (long)TP * 128); } }
    else cvt_flat(F, (bf16_t*)(ws + A_XB), F.a->in[0], (long)TP * 128);
    cvt_flat(F, (bf16_t*)(ws + A_XB) + (size_t)TP * 1024, F.a->in[1], (long)TS * 128);
    cvt_flat(F, (bf16_t*)(ws + W_MEMB), F.a->in[2], 256 * 128);
    }
    DUPP(1) {
    wconv(F, (bf16_t*)(ws + W_WXK), F.a->in[27], 1024, 1024, 1024, MapId(), nullptr, nullptr, 0, rot);
    wconv(F, (bf16_t*)(ws + W_WXV), F.a->in[28], 1024, 1024, 1024, MapId(), nullptr, nullptr, 0, rot);
    wconv(F, (bf16_t*)(ws + W_WQ), F.a->in[11], 768, 384, 768, MapWq(), F.a->in[10], F.a->in[10], 384, rot);
    wconv(F, (bf16_t*)(ws + W_WK), F.a->in[13], 1024, 256, 512, MapWk(), nullptr, nullptr, 0, rot);
    wconv(F, (bf16_t*)(ws + W_WV), F.a->in[13], 1024, 256, 512, MapWv(), nullptr, nullptr, 0, rot);
    wconv(F, (bf16_t*)(ws + W_WGLU), F.a->in[22], 1024, 512, 1024, MapGlu(), nullptr, nullptr, 0, rot);
    wconv(F, (bf16_t*)(ws + W_WO), F.a->in[25], 1024, 1024, 1024, MapId(), F.a->in[23], F.a->in[24], 512, rot);
    wconv(F, (bf16_t*)(ws + W_WXQ), F.a->in[26], 1024, 1024, 1024, MapId(), F.a->in[32], F.a->in[32], 1024, rot);
    wconv(F, (bf16_t*)(ws + W_WXO), F.a->in[29], 1024, 1024, 1024, MapId(), nullptr, nullptr, 0, rot);
    wconv(F, (bf16_t*)(ws + W_WFF1), F.a->in[30], 4096, 1024, 4096, MapId(), F.a->in[32] + 1024, F.a->in[32] + 1024, 1024, rot);
    wconv(F, (bf16_t*)(ws + W_WFF2), F.a->in[31], 1024, 4096, 1024, MapId(), nullptr, nullptr, 0, rot);
    }
    DUPP(4) {
    colsum_job(F, F.a->in[26], 1024, F.a->in[32], F.a->in[33], (float*)(ws + W_CSXQ), (float*)(ws + W_BWXQ), 0);
    colsum_job(F, F.a->in[30], 4096, F.a->in[32] + 1024, F.a->in[33] + 1024, (float*)(ws + W_CSFF1), (float*)(ws + W_BWFF1), 64);
    }
}
__device__ __forceinline__ void cvt_memcache(const Frame& F, int b0, int bstride) {
    bf16_t* XKS = (bf16_t*)(F.ws + A_XKS); bf16_t* XVTS = (bf16_t*)(F.ws + A_XVTS); const float* ck = F.a->in[7]; const float* cv = F.a->in[8];
    const long gs = (long)bstride * 512;
    for (long i = (long)b0 * 512 + F.tid; i < 32L * 256 * 128; i += gs) { const f32x4 a = *(const f32x4*)(ck + i * 8), b = *(const f32x4*)(ck + i * 8 + 4);
        const long rowi = i >> 7, c8 = i & 127; const long drow = (rowi & ~255L) | swap23((int)(rowi & 255));
        u32x4 w; w.x = cvt_pk_bf16(a[0], a[1]); w.y = cvt_pk_bf16(a[2], a[3]); w.z = cvt_pk_bf16(b[0], b[1]); w.w = cvt_pk_bf16(b[2], b[3]); *(u32x4*)(XKS + drow * 1024 + c8 * 8) = w; }
    { Frame F2 = F; F2.bid = b0; F2.G = bstride; int rot = 0;
      for (int bb = 0; bb < 32; ++bb) wconv<MapId, false>(F2, XVTS + (size_t)bb * 262144, cv + (size_t)bb * 262144, 1024, 256, 1024, MapId(), nullptr, nullptr, 0, rot); }
}

#define XB_TMO      128
#define XB_XCNT(j)  (256  + 64 * (j))
#define XB_XSUB(j)  (1280 + 64 * (j))
#define XB_XGEN(j)  (2304 + 64 * (j))
#define XB_TOP      3328
#define XB_TOPGEN   3392
#define XCD_BAR_WORDS 3456
#define XB_SPIN_CAP (1u << 18)

__device__ __forceinline__ unsigned xb_ld(unsigned* p)              { return __hip_atomic_load(p, __ATOMIC_RELAXED, __HIP_MEMORY_SCOPE_AGENT); }
__device__ __forceinline__ unsigned xb_add(unsigned* p, unsigned v) { return __hip_atomic_fetch_add(p, v, __ATOMIC_RELAXED, __HIP_MEMORY_SCOPE_AGENT); }
__device__ __forceinline__ unsigned xb_xcc_id() { return (unsigned)__builtin_amdgcn_s_getreg((3 << 11) | 20) & 0xFu; }
#define XB_SPIN(cond, bar) do { unsigned _sp = 0; while (cond) { __builtin_amdgcn_s_sleep(1); \
    if ((++_sp & 255u) == 0u) { if (xb_ld(&(bar)[XB_TMO])) break; if (_sp > XB_SPIN_CAP) { atomicAdd(&(bar)[XB_TMO], 1u); break; } } } } while (0)

struct XcdBarrier {
    unsigned* bar; unsigned x;
    volatile LAS unsigned* st;
};

__device__ __forceinline__ XcdBarrier xcd_barrier_post(unsigned* bar, volatile LAS unsigned* st) {
    XcdBarrier b; b.bar = bar; b.x = xb_xcc_id(); b.st = st;
    if (threadIdx.x == 0) (void)xb_add(&bar[XB_XCNT(b.x)], 1u);
    return b;
}
__device__ __forceinline__ void xcd_barrier_complete(unsigned* bar, unsigned x, unsigned& nloc, unsigned& nx) {
    const unsigned G = gridDim.x * gridDim.y * gridDim.z;
    unsigned sum, cnt, mine, sp = 0u;
    for (;;) {
        sum = 0u; cnt = 0u; mine = 0u;
#pragma unroll
        for (unsigned j = 0; j < 16; ++j) { const unsigned c = xb_ld(&bar[XB_XCNT(j)]); sum += c; cnt += (c > 0u) ? 1u : 0u; mine = (j == x) ? c : mine; }
        if (sum == G) break;
        __builtin_amdgcn_s_sleep(1);
        if ((++sp & 255u) == 0u) { if (xb_ld(&bar[XB_TMO])) break; if (sp > XB_SPIN_CAP) { atomicAdd(&bar[XB_TMO], 1u); break; } }
    }
    nloc = mine > 0u ? mine : 1u; nx = cnt > 0u ? cnt : 1u;
}

__device__ __forceinline__ void xcd_barrier(const XcdBarrier& b) {
    asm volatile("s_waitcnt vmcnt(0)" ::: "memory");
    __syncthreads();
    if (threadIdx.x == 0) {
        unsigned* bar = b.bar;
        __builtin_amdgcn_s_waitcnt(0);
        unsigned nloc = b.st[0], nx = b.st[1];
        if (nloc == 0u) { xcd_barrier_complete(bar, b.x, nloc, nx); b.st[0] = nloc; b.st[1] = nx; }
        const unsigned old = xb_add(&bar[XB_XSUB(b.x)], 1u);
        const unsigned gen = old / nloc;
        if (old + 1u == (gen + 1u) * nloc) {
            __builtin_amdgcn_fence(__ATOMIC_RELEASE, "agent");
            asm volatile("s_waitcnt vmcnt(0)" ::: "memory");
            const unsigned og = xb_add(&bar[XB_TOP], 1u);
            const unsigned tg = og / nx;
            if (og + 1u == (tg + 1u) * nx) xb_add(&bar[XB_TOPGEN], 1u);
            else XB_SPIN(xb_ld(&bar[XB_TOPGEN]) == tg, bar);
            __builtin_amdgcn_fence(__ATOMIC_ACQUIRE, "agent");
            xb_add(&bar[XB_XGEN(b.x)], 1u);
            asm volatile("s_waitcnt vmcnt(0)" ::: "memory");
        } else {
            XB_SPIN(xb_ld(&bar[XB_XGEN(b.x)]) == gen, bar);
            __builtin_amdgcn_fence(__ATOMIC_ACQUIRE, "agent");
            asm volatile("s_waitcnt vmcnt(0)" ::: "memory");
        }
    }
    __syncthreads();
}

constexpr int NPHASE = 13;
#ifndef PHASE_MASK
#define PHASE_MASK 0x1FFF
#endif
#ifndef SUBMASK
#define SUBMASK 0xFF
#endif
#define SUB(j) if ((SUBMASK >> (j)) & 1)
#ifndef DUP_MASK
#define DUP_MASK 0
#endif
#define DUP(k) _Pragma("unroll") for (int rep_ = 0; rep_ < (((DUP_MASK >> (k)) & 1) ? 2 : 1); ++rep_)
#define PH(k) if (!((PHASE_MASK >> (k)) & 1)) break;
using pg8::Gemm; using pg8::StaticOrder;
#define RUN_GEMM_LN(EPI, gm, e, PS_, PQ_) do { StaticOrder S_; S_.init((gm).M, (gm).N, F.G, F.bid, 0); ln_fill_tab(S_, PS_, PQ_, (LAS float*)(F.lds + 131072)); pg8::gemm_phase<EPI, StaticOrder, true, true>(F.lds, gm, S_, e); } while (0)
#define RUN_GEMM(EPI, gm, e, rot) do { StaticOrder S_; S_.init((gm).M, (gm).N, F.G, F.bid, rot); pg8::gemm_phase<EPI, StaticOrder, true, true>(F.lds, gm, S_, e); } while (0)

#define WS (F.ws)
#define U (F.a->out)
#define YG ((bf16_t*)((unsigned char*)F.a->out + 36 * MiB))
#define STSSM ((float*)(WS + W_STSSM))
#define STMLA ((float*)(WS + W_STMLA))
#define ST1 ((float*)(WS + W_ST1))
#define ST2 ((float*)(WS + W_ST2))
#define KN ((bf16_t*)(WS + A_KN))
#define VT ((bf16_t*)(WS + A_VT))
#define Q ((bf16_t*)(WS + A_Q))
#define KPE ((bf16_t*)(WS + A_KPE))
#define MIX ((bf16_t*)(WS + A_MIX))
#define R (F.a->out + O_Y)
__global__ void __launch_bounds__(512, 2) fwd_kernel(Args a) {
    extern __shared__ __attribute__((aligned(16))) unsigned char lds_raw[];
    Frame F;
    F.a = (const Args*)__builtin_amdgcn_kernarg_segment_ptr();
    F.out = a.out; F.ws = a.ws; F.lds = (LAS unsigned char*)lds_raw; F.tid = threadIdx.x; F.lane = F.tid & 63; F.wid = __builtin_amdgcn_readfirstlane(F.tid >> 6); F.G = gridDim.x; F.bid = blockIdx.x;
    const int lo = a.ph_lo, hi = a.ph_hi;
    volatile LAS unsigned* bst = (volatile LAS unsigned*)(F.lds + LDS_BYTES - 16);
    if (F.tid < 2) bst[F.tid] = 0u;
    __syncthreads();
    (void)xcd_barrier_post((unsigned*)(WS + W_BAR), bst);
    if (hi > 1000) cg::this_grid().sync();
#define GSYNC(k) if ((k) + 1 < hi) { XcdBarrier b_; b_.bar = (unsigned*)(F.a->ws + W_BAR); b_.x = xb_xcc_id(); b_.st = (volatile LAS unsigned*)(F.lds + LDS_BYTES - 16); xcd_barrier(b_); }
        if (((PHASE_MASK >> 0) & 1) && lo <= 0 && 0 < hi) DUP(0) { prologue(F); }
        if (lo <= 0 && 0 < hi) GSYNC(0)
        if (((PHASE_MASK >> 1) & 1) && lo <= 1 && 1 < hi) DUP(1) { {
            SUB(0) { Gemm g{(const bf16_t*)(WS + A_XB), (const bf16_t*)(WS + W_WIN), MTOK, 1280, 1024}; EpiProj e{U, (float*)(WS + A_PQ)}; RUN_GEMM(EpiProj, g, e, 0); }
            SUB(1) { Gemm g{(const bf16_t*)(WS + W_MEMB), (const bf16_t*)(WS + W_WXK), 256, 1024, 1024}; EpiStore<false> e{(bf16_t*)(WS + W_XK0), 1024, F.a->out + O_MKP, 1024, nullptr, 0, 1}; RUN_GEMM(EpiStore<false>, g, e, 172); }
            SUB(2) { Gemm g{(const bf16_t*)(WS + W_WXV), (const bf16_t*)(WS + W_MEMB), 1024, 256, 1024}; EpiStore<false> e{(bf16_t*)(WS + W_XVT0), 256, nullptr, 0, F.a->out + O_MVP, 1024, 0}; RUN_GEMM(EpiStore<false>, g, e, 168); }
            if (F.G > 92) { if (F.bid >= 92) cvt_caches(F, F.bid - 92, F.G - 92); } else cvt_caches(F, F.bid, F.G);
        } }
        if (lo <= 1 && 1 < hi) GSYNC(1)
        if (((PHASE_MASK >> 2) & 1) && lo <= 2 && 2 < hi) DUP(2) { post_rows(F); ssm_pass_a(F); }
        if (lo <= 2 && 2 < hi) GSYNC(2)
        if (((PHASE_MASK >> 3) & 1) && lo <= 3 && 3 < hi) DUP(3) { {
            const bool fuse34 = lo <= 3 && 4 < hi && F.G >= 8; unsigned* cnt3 = (unsigned*)(WS + W_BAR + 14336) + 32;
            SUB(0) ssm_pass_b(F, F.bid - (F.G - 4)); asm volatile("s_waitcnt vmcnt(0)" ::: "memory"); __syncthreads();
            if (fuse34 && F.bid >= F.G - 4 && F.tid == 0) { __builtin_amdgcn_fence(__ATOMIC_RELEASE, "agent"); asm volatile("s_waitcnt vmcnt(0)" ::: "memory"); __hip_atomic_fetch_add(cnt3, 1u, __ATOMIC_RELAXED, __HIP_MEMORY_SCOPE_AGENT); }
            SUB(1) { Gemm g{(const bf16_t*)(WS + A_CQN), (const bf16_t*)(WS + W_WQ), MTOK, 768, 384}; EpiQ e{Q}; RUN_GEMM(EpiQ, g, e, 0); }
            SUB(2) { Gemm g{(const bf16_t*)(WS + A_CKV), (const bf16_t*)(WS + W_WK), KVROWS, 512, 256}; EpiStore<false> e{KN, 512, nullptr, 0, nullptr, 0, 1}; RUN_GEMM(EpiStore<false>, g, e, 52); }
            SUB(3) { Gemm g{(const bf16_t*)(WS + W_WV), (const bf16_t*)(WS + A_CKV), 512, KVROWS, 256}; EpiStore<false> e{VT, KVPAD, nullptr, 0, nullptr, 0, 0}; RUN_GEMM(EpiStore<false>, g, e, 172); }
            if (fuse34) {
                if (F.tid == 0) { unsigned sp = 0; while (__hip_atomic_load(cnt3, __ATOMIC_RELAXED, __HIP_MEMORY_SCOPE_AGENT) < 4u) { __builtin_amdgcn_s_sleep(2); if (++sp > (1u << 22)) break; }
                    __builtin_amdgcn_fence(__ATOMIC_ACQUIRE, "agent"); asm volatile("s_waitcnt vmcnt(0)" ::: "memory"); }
                __syncthreads();
                ssm_pass_c(F); }
        } }
        if (lo <= 3 && 3 < hi && !(lo <= 3 && 4 < hi && F.G >= 8)) GSYNC(3)
        if (((PHASE_MASK >> 4) & 1) && lo <= 4 && 4 < hi && !(lo <= 3 && 4 < hi && F.G >= 8)) DUP(4) { ssm_pass_c(F); }
        if (lo <= 4 && 4 < hi) GSYNC(4)
        if (((PHASE_MASK >> 5) & 1) && lo <= 5 && 5 < hi) DUP(5) { {
            SUB(0) { Gemm g{YG, (const bf16_t*)(WS + W_WGLU), MTOK, 1024, 512}; EpiGlu e{MIX, STSSM}; RUN_GEMM(EpiGlu, g, e, 0); }
            SUB(1) DUP(13) for (int it = F.bid; it < 256; it += F.G) { const int y = it >> 2, h = it & 3;
                for (int pass = 0; pass < 2; ++pass) { const int x = pass ? y : 127 - y, q0 = x * 128, rg = F.wid & 3;
                    attn_unit<192, 128, 128, false>(F.lds, Q + (size_t)q0 * 768 + h * 192, 768, KN + h * 128, 512, KPE, VT + (size_t)(h * 128) * KVPAD, KVPAD,
                                                    (q0 >> 6) + 2, 64 * ((q0 >> 6) + (rg >> 1) + 1), MIX + (size_t)q0 * 1024 + 512 + h * 128, 1024, STMLA + (size_t)h * MTOK + q0, 128); } }
            SUB(2) DUP(14) for (int it = F.G - 1 - F.bid; it < 128; it += F.G) { const int b = it >> 2, h = it & 3, q0 = TP + b * 32, k0 = TP + b * KVS, rg = F.wid & 3;
                attn_unit<192, 128, 128, false>(F.lds, Q + (size_t)q0 * 768 + h * 192, 768, KN + (size_t)k0 * 512 + h * 128, 512, KPE + (size_t)k0 * 64, VT + (size_t)(h * 128) * KVPAD + k0, KVPAD,
                                                17, rg == 0 ? KVS : 0, MIX + (size_t)q0 * 1024 + 512 + h * 128, 1024, STMLA + (size_t)h * MTOK + q0, 32); }
        } }
        if (lo <= 5 && 5 < hi) GSYNC(5)
        if (((PHASE_MASK >> 6) & 1) && lo <= 6 && 6 < hi) DUP(6) { {
            { Gemm g{MIX, (const bf16_t*)(WS + W_WO), MTOK, 1024, 1024};
              LAS float* tab = (LAS float*)(F.lds + 131072);
              EpiRes<0> e{F.a->in[0], F.a->in[1], R, (bf16_t*)(WS + A_R1B), nullptr, nullptr, nullptr, nullptr, ST1, ST1 + 16 * MTOK, tab};
              StaticOrder S_; S_.init(g.M, g.N, F.G, F.bid, 0); Unit u0;
              if (S_.next(0, u0)) wo_fill_tab(u0, STSSM, STMLA, tab);
              if (S_.next(1, u0)) wo_fill_tab(u0, STSSM, STMLA, tab);
              __syncthreads();
              pg8::gemm_phase<EpiRes<0>, StaticOrder, true, true>(F.lds, g, S_, e); }
            if (F.G > 16) { if (F.bid >= 16) cvt_memcache(F, F.bid - 16, F.G - 16); } else cvt_memcache(F, F.bid, F.G);
        } }
        if (lo <= 6 && 6 < hi) GSYNC(6)
        if (((PHASE_MASK >> 7) & 1) && lo <= 7 && 7 < hi) DUP(7) { { Gemm g{(const bf16_t*)(WS + A_R1B), (const bf16_t*)(WS + W_WXQ), (F.G >= 80) ? TP : MTOK, 1024, 1024};
            EpiLnAct<0> e{(const LAS float*)(F.lds + 131072), (const float*)(WS + W_CSXQ), (const float*)(WS + W_BWXQ), (bf16_t*)(WS + A_XQ), 1024}; RUN_GEMM_LN(EpiLnAct<0>, g, e, ST1, ST1 + 16 * MTOK); } }
        if (lo <= 7 && 7 < hi) GSYNC(7)
        if (((PHASE_MASK >> 8) & 1) && lo <= 8 && 8 < hi) DUP(8) { {
            const bf16_t* XQ = (const bf16_t*)(WS + A_XQ); bf16_t* XO = (bf16_t*)(WS + A_XO); unsigned* cnt2 = (unsigned*)(WS + W_BAR + 14336) + 16;
            if (F.G >= 80 && F.bid >= F.G - 16) {
                const int u = F.bid - (F.G - 16), pm = TP / 256 + (u >> 2); LAS float* tab = (LAS float*)(F.lds + 131072);
                if (F.tid < 256) { float mu, rstd; ln_stats16(ST1, ST1 + 16 * MTOK, pm * 256 + F.tid, mu, rstd); tab[F.tid] = mu; tab[256 + F.tid] = rstd; }
                __syncthreads();
                Gemm gx{(const bf16_t*)(WS + A_R1B), (const bf16_t*)(WS + W_WXQ), MTOK, 1024, 1024}; pg8::OneUnitOrder Sx{pm, u & 3};
                EpiLnAct<0> ex{tab, (const float*)(WS + W_CSXQ), (const float*)(WS + W_BWXQ), (bf16_t*)(WS + A_XQ), 1024};
                pg8::gemm_phase<EpiLnAct<0>, pg8::OneUnitOrder, true, true>(F.lds, gx, Sx, ex);
                asm volatile("s_waitcnt vmcnt(0)" ::: "memory"); __syncthreads();
                if (F.tid == 0) { __builtin_amdgcn_fence(__ATOMIC_RELEASE, "agent"); asm volatile("s_waitcnt vmcnt(0)" ::: "memory"); __hip_atomic_fetch_add(cnt2, 1u, __ATOMIC_RELAXED, __HIP_MEMORY_SCOPE_AGENT); }
                __syncthreads(); }
            for (int it = F.bid; it < 640; it += F.G) {
                if (it >= 512 && F.G >= 80) {
                    if (F.tid == 0) { unsigned sp = 0; while (__hip_atomic_load(cnt2, __ATOMIC_RELAXED, __HIP_MEMORY_SCOPE_AGENT) < 16u) { __builtin_amdgcn_s_sleep(2); if (++sp > (1u << 22)) break; }
                        __builtin_amdgcn_fence(__ATOMIC_ACQUIRE, "agent"); asm volatile("s_waitcnt vmcnt(0)" ::: "memory"); }
                    __syncthreads(); }
                if (it < 512) { const int x = it >> 2, h = it & 3, q0 = x * 128;
                    attn_unit<256, 256, 256, true>(F.lds, XQ + (size_t)q0 * 1024 + h * 256, 1024, (const bf16_t*)(WS + W_XK0) + h * 256, 1024, nullptr, (const bf16_t*)(WS + W_XVT0) + (size_t)h * 65536, 256,
                                                   4, 256, XO + (size_t)q0 * 1024 + h * 256, 1024, nullptr, 128); }
                else { const int b = (it - 512) >> 2, h = it & 3, q0 = TP + b * 32, rg = F.wid & 3;
                    attn_unit<256, 256, 256, true>(F.lds, XQ + (size_t)q0 * 1024 + h * 256, 1024, (const bf16_t*)(WS + A_XKS) + (size_t)b * 262144 + h * 256, 1024, nullptr,
                                                   (const bf16_t*)(WS + A_XVTS) + (size_t)(b * 4 + h) * 65536, 256, 4, rg == 0 ? 256 : 0, XO + (size_t)q0 * 1024 + h * 256, 1024, nullptr, 32); } }
        } }
        if (lo <= 8 && 8 < hi) GSYNC(8)
        if (((PHASE_MASK >> 9) & 1) && lo <= 9 && 9 < hi) DUP(9) { { Gemm g{(const bf16_t*)(WS + A_XO), (const bf16_t*)(WS + W_WXO), (F.G >= 80) ? TP : MTOK, 1024, 1024};
            EpiRes<1> e{nullptr, nullptr, R, (bf16_t*)(WS + A_R2B), nullptr, nullptr, F.a->in[32], F.a->in[33], ST2, ST2 + 16 * MTOK, (const LAS float*)(F.lds + 131072)}; RUN_GEMM_LN(EpiRes<1>, g, e, ST1, ST1 + 16 * MTOK); } }
        if (lo <= 9 && 9 < hi) GSYNC(9)
        if (((PHASE_MASK >> 10) & 1) && lo <= 10 && 10 < hi) DUP(10) { {
            LAS float* tab = (LAS float*)(F.lds + 131072); unsigned* cnt = (unsigned*)(WS + W_BAR + 14336);
            if (F.G >= 80 && F.bid >= F.G - 16) { const int u = F.bid - (F.G - 16); const int pm = TP / 256 + (u >> 2);
                if (F.tid < 256) { float mu, rstd; ln_stats16(ST1, ST1 + 16 * MTOK, pm * 256 + F.tid, mu, rstd); tab[F.tid] = mu; tab[256 + F.tid] = rstd; }
                __syncthreads();
                Gemm gx{(const bf16_t*)(WS + A_XO), (const bf16_t*)(WS + W_WXO), MTOK, 1024, 1024}; pg8::OneUnitOrder Sx{pm, u & 3};
                EpiRes<1> ex{nullptr, nullptr, R, (bf16_t*)(WS + A_R2B), nullptr, nullptr, F.a->in[32], F.a->in[33], ST2, ST2 + 16 * MTOK, tab};
                pg8::gemm_phase<EpiRes<1>, pg8::OneUnitOrder, true, true>(F.lds, gx, Sx, ex);
                asm volatile("s_waitcnt vmcnt(0)" ::: "memory"); __syncthreads();
                if (F.tid == 0) { __builtin_amdgcn_fence(__ATOMIC_RELEASE, "agent"); asm volatile("s_waitcnt vmcnt(0)" ::: "memory"); __hip_atomic_fetch_add(cnt, 1u, __ATOMIC_RELAXED, __HIP_MEMORY_SCOPE_AGENT); }
                __syncthreads(); }
            EpiLnAct<1> e{tab, (const float*)(WS + W_CSFF1), (const float*)(WS + W_BWFF1), (bf16_t*)(WS + A_Z), 4096};
            { Gemm g{(const bf16_t*)(WS + A_R2B), (const bf16_t*)(WS + W_WFF1), (F.G >= 80) ? TP : MTOK, 4096, 1024}; RUN_GEMM_LN(EpiLnAct<1>, g, e, ST2, ST2 + 16 * MTOK); }
            if (F.G >= 80 && F.bid < 64) {
                if (F.tid == 0) { unsigned sp = 0; while (__hip_atomic_load(cnt, __ATOMIC_RELAXED, __HIP_MEMORY_SCOPE_AGENT) < 16u) { __builtin_amdgcn_s_sleep(2); if (++sp > (1u << 22)) break; }
                    __builtin_amdgcn_fence(__ATOMIC_ACQUIRE, "agent"); asm volatile("s_waitcnt vmcnt(0)" ::: "memory"); }
                __syncthreads();
                const int pm = TP / 256 + (F.bid >> 4);
                if (F.tid < 256) { float mu, rstd; ln_stats16(ST2, ST2 + 16 * MTOK, pm * 256 + F.tid, mu, rstd); tab[F.tid] = mu; tab[256 + F.tid] = rstd; }
                __syncthreads();
                Gemm gs{(const bf16_t*)(WS + A_R2B), (const bf16_t*)(WS + W_WFF1), MTOK, 4096, 1024}; pg8::OneUnitOrder Ss{pm, F.bid & 15};
                pg8::gemm_phase<EpiLnAct<1>, pg8::OneUnitOrder, true, true>(F.lds, gs, Ss, e); } } }
        if (lo <= 10 && 10 < hi) GSYNC(10)
        if (((PHASE_MASK >> 11) & 1) && lo <= 11 && 11 < hi) DUP(11) { { Gemm g{(const bf16_t*)(WS + A_Z), (const bf16_t*)(WS + W_WFF2), TP, 1024, 4096};
            EpiRes<1> e{nullptr, nullptr, R, nullptr, nullptr, nullptr, F.a->in[32] + 1024, F.a->in[33] + 1024, ST1, ST1 + 16 * MTOK, (const LAS float*)(F.lds + 131072)}; RUN_GEMM_LN(EpiRes<1>, g, e, ST2, ST2 + 16 * MTOK); }
          { Gemm g{(const bf16_t*)(WS + A_Z) + (size_t)TP * 4096, (const bf16_t*)(WS + W_WFF2), TS, 1024, 512, 4096};
            pg8::SplitKOrder S_{16, 4, 8, 512, F.G, F.bid}; EpiSlab e{(float*)(WS + A_R2B)}; pg8::gemm_phase<EpiSlab, pg8::SplitKOrder, true, true>(F.lds, g, S_, e); } }
        if (lo <= 11 && 11 < hi) GSYNC(11)
        if (((PHASE_MASK >> 12) & 1) && lo <= 12 && 12 < hi) DUP(12) { final_ln(F); }
}

#undef WS
#undef U
#undef YG
#undef STSSM
#undef STMLA
#undef ST1
#undef ST2
#undef KN
#undef VT
#undef Q
#undef KPE
#undef MIX
#undef R
extern "C" void kernel_launch(void* const* d_in, const int* in_sizes, int n_in, void* d_out, int out_size, void* d_ws, size_t ws_size, hipStream_t stream) {
    static int grid = 0;
    if (grid == 0) {
        int dev = 0, cus = 0, per_cu = 0;
        (void)hipGetDevice(&dev); (void)hipDeviceGetAttribute(&cus, hipDeviceAttributeMultiprocessorCount, dev);
        if (hipFuncSetAttribute((const void*)fwd_kernel, hipFuncAttributeMaxDynamicSharedMemorySize, LDS_BYTES) != hipSuccess) fprintf(stderr, "kernel_launch: hipFuncSetAttribute failed\n");
        if (hipOccupancyMaxActiveBlocksPerMultiprocessor(&per_cu, (const void*)fwd_kernel, 512, LDS_BYTES) != hipSuccess || per_cu < 1) { fprintf(stderr, "kernel_launch: occupancy query says %d\n", per_cu); per_cu = 1; }
        (void)hipGetLastError();
        grid = cus > 0 ? cus : 256;
        if (n_in != 34 || ws_size < WS_END) fprintf(stderr, "kernel_launch: unexpected n_in %d / ws_size %zu (need %zu)\n", n_in, ws_size, (size_t)WS_END);
    }
    if (hipMemsetAsync((char*)d_ws + W_BAR, 0, BAR_BYTES, stream) != hipSuccess) fprintf(stderr, "kernel_launch: memset failed\n");
    Args a{};
    for (int i = 0; i < 34; ++i) a.in[i] = (const float*)d_in[i];
    a.out = (float*)d_out; a.ws = (unsigned char*)d_ws;
#if N_LAUNCH_MODE == 1
    a.ph_lo = 0; a.ph_hi = NPHASE;
    void* args[] = {&a};
    hipError_t e = hipLaunchCooperativeKernel((const void*)fwd_kernel, dim3(grid), dim3(512), args, LDS_BYTES, stream);
    if (e != hipSuccess) fprintf(stderr, "cooperative launch failed: %s (grid %d)\n", hipGetErrorString(e), grid);
#else
    for (int ph = 0; ph < NPHASE; ++ph) { a.ph_lo = ph; a.ph_hi = ph + 1; hipLaunchKernelGGL(fwd_kernel, dim3(grid), dim3(512), LDS_BYTES, stream, a); }
#endif
}
```

```cpp
#include <hip/hip_runtime.h>
#include <hip/hip_cooperative_groups.h>
#include <cstdio>
#include <cstdint>
namespace cg = cooperative_groups;

#ifndef N_LAUNCH_MODE
#define N_LAUNCH_MODE 1
#endif

#define LAS __attribute__((address_space(3)))
#define PG8_LAS LAS
typedef unsigned short bf16_t;
typedef short bf16x8 __attribute__((ext_vector_type(8)));
typedef float f32x4 __attribute__((ext_vector_type(4)));
typedef float f32x16 __attribute__((ext_vector_type(16)));
typedef unsigned u32x4 __attribute__((ext_vector_type(4)));
typedef unsigned u32x2 __attribute__((ext_vector_type(2)));

constexpr int TP = 16384, TS = 1024, MTOK = TP + TS;
constexpr int DM = 1024, NPAST = 1024, KVS = 1056;
constexpr int KVROWS = TP + 32 * KVS;
constexpr int KVPAD = KVROWS + 64;
constexpr float EPSN = 1e-5f;
constexpr float ALPHA = 1.189207115002721f;
constexpr float LOG2E = 1.4426950408889634f;
constexpr float QSCALE = 0.07216878364870322f * LOG2E;
constexpr float XSCALE = 0.0625f * LOG2E;

constexpr size_t O_Y = 0, O_CKVP = 17825792, O_KPEP = 22020096, O_SREP = 23068672, O_SIMP = 23070720, O_MKP = 23072768,
                 O_MVP = 23334912, O_CKVS = 23597056, O_KPES = 23859200, O_SRES = 23924736, O_SIMS = 23990272;

constexpr size_t MiB = 1u << 20;
constexpr size_t al256(size_t x) { return (x + 255) & ~(size_t)255; }
constexpr size_t W_WIN = 0;
constexpr size_t W_WQ = W_WIN + al256(1280 * 1024 * 2);
constexpr size_t W_WK = W_WQ + al256(768 * 384 * 2);
constexpr size_t W_WV = W_WK + al256(512 * 256 * 2);
constexpr size_t W_WGLU = W_WV + al256(512 * 256 * 2);
constexpr size_t W_WO = W_WGLU + al256(1024 * 512 * 2);
constexpr size_t W_WXQ = W_WO + 2 * MiB;
constexpr size_t W_WXK = W_WXQ + 2 * MiB;
constexpr size_t W_WXV = W_WXK + 2 * MiB;
constexpr size_t W_WXO = W_WXV + 2 * MiB;
constexpr size_t W_WFF1 = W_WXO + 2 * MiB;
constexpr size_t W_WFF2 = W_WFF1 + 8 * MiB;
constexpr size_t W_CSXQ = W_WFF2 + 8 * MiB;
constexpr size_t W_BWXQ = W_CSXQ + 4096;
constexpr size_t W_CSFF1 = W_BWXQ + 4096;
constexpr size_t W_BWFF1 = W_CSFF1 + 16384;
constexpr size_t W_LAM = W_BWFF1 + 16384;
constexpr size_t W_LAM64 = W_LAM + 16384;
constexpr size_t W_BB = W_LAM64 + 16384;
constexpr size_t W_MEMB = W_BB + 2 * 32 * 64 * 16 * 4;
constexpr size_t W_XK0 = W_MEMB + 256 * 1024 * 2;
constexpr size_t W_XVT0 = W_XK0 + 256 * 1024 * 2;
constexpr size_t W_STSSM = W_XVT0 + 256 * 1024 * 2;
constexpr size_t W_STMLA = W_STSSM + al256(16 * MTOK * 4);
constexpr size_t W_ST1 = W_STMLA + al256(4 * MTOK * 4);
constexpr size_t W_ST2 = W_ST1 + al256(32 * MTOK * 4);
constexpr size_t W_SEND = W_ST2 + al256(32 * MTOK * 4);
constexpr size_t W_BAR = W_SEND + 256 * 2 * 2048 * 4;
constexpr size_t BAR_BYTES = 16384;
constexpr size_t W_ACT = (W_BAR + BAR_BYTES + MiB - 1) / MiB * MiB;
constexpr size_t A_KN = W_ACT, A_VT = W_ACT + 50 * MiB, A_Q = W_ACT + 100 * MiB, A_KPE = W_ACT + 126 * MiB, A_CKV = W_ACT + 133 * MiB,
                 A_CQN = W_ACT + 158 * MiB, A_MIX = W_ACT + 171 * MiB, A_PQ = W_ACT, A_XB = W_ACT + 51 * MiB, A_R1B = W_ACT,
                 A_XQ = W_ACT + 34 * MiB, A_XKS = W_ACT + 68 * MiB, A_XVTS = W_ACT + 84 * MiB, A_XO = W_ACT + 101 * MiB,
                 A_R2B = W_ACT + 140 * MiB, A_Z = W_ACT, WS_END = W_ACT + 205 * MiB;
static_assert(WS_END <= 256 * MiB, "workspace");
static_assert((size_t)KVPAD * 512 * 2 <= 50 * MiB && (size_t)MTOK * 768 * 2 <= 26 * MiB && (size_t)KVPAD * 64 * 2 <= 7 * MiB && (size_t)KVPAD * 256 * 2 <= 25 * MiB &&
              (size_t)MTOK * 384 * 2 <= 13 * MiB && (size_t)MTOK * 1024 * 2 <= 34 * MiB && (size_t)MTOK * 768 * 4 <= 51 * MiB && (size_t)MTOK * 4096 * 2 <= 136 * MiB, "regions");

constexpr int LDS_BYTES = 141312 + 64;

__constant__ double c_invrev[32] = {0.15915494309189535,0.11934937021124886,0.089499401608891013,0.067115083005227255,0.050329212104487035,0.037741584717419771,0.028302195830623399,0.02122365276477766,0.015915494309189534,0.011934937021124886,0.0089499401608891024,0.0067115083005227253,0.0050329212104487037,0.0037741584717419772,0.0028302195830623399,0.0021223652764777662,0.0015915494309189536,0.0011934937021124885,0.00089499401608891024,0.0006711508300522726,0.00050329212104487033,0.00037741584717419774,0.00028302195830623395,0.00021223652764777661,0.00015915494309189535,0.00011934937021124886,8.9499401608891018e-05,6.7115083005227254e-05,5.0329212104487035e-05,3.7741584717419777e-05,2.8302195830623396e-05,2.1223652764777659e-05};

__device__ __forceinline__ unsigned cvt_pk_bf16(float lo, float hi) { unsigned r; asm volatile("v_cvt_pk_bf16_f32 %0, %1, %2" : "=v"(r) : "v"(lo), "v"(hi)); return r; }
__device__ __forceinline__ u32x2 pack4(f32x4 v) { u32x2 w; w.x = cvt_pk_bf16(v[0], v[1]); w.y = cvt_pk_bf16(v[2], v[3]); return w; }
__device__ __forceinline__ float bf16_round(float x) { return __uint_as_float(cvt_pk_bf16(x, 0.f) << 16); }
__device__ __forceinline__ void rope_cs(int pos, int i, float& c, float& s) {
    double rev = (double)pos * c_invrev[i]; rev -= __builtin_floor(rev); const float r = (float)rev;
    s = __builtin_amdgcn_sinf(r); c = __builtin_amdgcn_cosf(r);
}
__device__ __forceinline__ int tok_pos(int row) { return row < TP ? row : NPAST + ((row - TP) & 31); }
__device__ __forceinline__ int swap23(int r) { return (r & ~12) | ((r & 4) << 1) | ((r & 8) >> 1); }
__device__ __forceinline__ int tok_kvrow(int row) { return row < TP ? row : TP + ((row - TP) >> 5) * KVS + NPAST + ((row - TP) & 31); }

struct Args { const float* in[34]; float* out; unsigned char* ws; int ph_lo, ph_hi; };
struct Frame {
    const Args* a; float* out; unsigned char* ws; LAS unsigned char* lds;
    int tid, lane, wid, G, bid;
};

namespace pg8 {
constexpr int BM = 256, BK = 64, HALF = 128, HTB = HALF * BK * 2, STAGE_BYTES = 8 * HTB, NXCD = 8, WGM = 8;
__host__ __device__ __forceinline__ int lds_byte(int r, int c) { const int st = (r >> 4) * 2 + (c >> 5), rr = r & 15, cc = c & 31, ob = rr * 64 + cc * 2; return st * 1024 + (ob ^ (((ob >> 9) & 1) << 5)); }
__host__ __device__ __forceinline__ void stage_rc(int b, int& R, int& C) { const int st = b / 1024, sb = b % 1024, swz = sb ^ (((sb >> 9) & 1) << 5); R = (st >> 1) * 16 + swz / 64; C = (st & 1) * 32 + (swz % 64) / 2; }
__host__ __device__ __forceinline__ int perm32(int rho) { const int n = rho >> 4, i = rho & 15; return 8 * (i >> 2) + 4 * n + (i & 3); }
struct Unit { int pm, pn, idx, ko; };
struct Gemm { const bf16_t* A; const bf16_t* Bt; int M, N, K, LD; };
struct StaticOrder {
    int nM, nN, nwg, G, c;
    __device__ __forceinline__ void init(int M, int N, int G_, int c_, int rot) { nM = M / BM; nN = N / BM; nwg = nM * nN; G = G_; c = (c_ + rot) % G_; }
    __device__ __forceinline__ bool next(int i, Unit& u) const {
        const long L = (long)i * G + c; if (L >= nwg) return false;
        int wgid = (int)L; { const int q = nwg / NXCD, r = nwg % NXCD, xcd = wgid % NXCD, off = wgid / NXCD; wgid = (xcd < r ? xcd * (q + 1) : r * (q + 1) + (xcd - r) * q) + off; }
        const int nig = WGM * nN, gid = wgid / nig, fm = gid * WGM, gsz = (nM - fm) < WGM ? (nM - fm) : WGM;
        u.pm = fm + ((wgid % nig) % gsz); u.pn = (wgid % nig) / gsz; u.idx = i; u.ko = 0; return true;
    }
    __device__ __forceinline__ void a_ready(const Unit&) const {}
    __device__ __forceinline__ void done(const Unit&) const {}
};
struct OneUnitOrder {
    int pm, pn;
    __device__ __forceinline__ bool next(int i, Unit& u) const { if (i > 0) return false; u.pm = pm; u.pn = pn; u.idx = 0; u.ko = 0; return true; }
    __device__ __forceinline__ void a_ready(const Unit&) const {}
    __device__ __forceinline__ void done(const Unit&) const {}
};
struct SplitKOrder {
    int nt, nN, ns, ks, G, c;
    __device__ __forceinline__ bool next(int i, Unit& u) const { const int L = i * G + c; if (L >= nt * ns) return false; const int t = L % nt, s = L / nt; u.pm = t / nN; u.pn = t % nN; u.idx = i; u.ko = s * ks; return true; }
    __device__ __forceinline__ void a_ready(const Unit&) const {}
    __device__ __forceinline__ void done(const Unit&) const {}
};
template <class Epi, class Sched, bool ALIGN_EPI = false, bool SP2 = false>
__device__ __forceinline__ void gemm_phase(PG8_LAS unsigned char* lds, const Gemm g, const Sched& S, const Epi& E) {
    const int tid = threadIdx.x, wid = __builtin_amdgcn_readfirstlane(tid >> 6), lane = tid & 63, wr = wid >> 2, wc = wid & 3, fr = lane & 15, fq = lane >> 4;
    int K_ = g.K; asm volatile("" : "+s"(K_)); const int K = K_, nt = K / BK, LD = g.LD ? g.LD : K;
    unsigned voffA[2], voffB[2];
#pragma unroll
    for (int i = 0; i < 2; ++i) { int R, C; stage_rc(tid * 16 + i * 8192, R, C); const int Rb = Epi::PERM ? ((R & ~31) + perm32(R & 31)) : R;
        voffA[i] = (unsigned)(R * LD + C) * 2u; voffB[i] = (unsigned)(Rb * LD + C) * 2u; }
    const size_t kstep = (size_t)(BK * 2);
    const size_t hstep = (size_t)HALF * LD * 2;
    const size_t tstep = 2 * hstep;
    const unsigned ldsw = (unsigned)wid * 1024u;
    const int aoff = lds_byte(wr * 64 + fr, fq * 8), boff = lds_byte(wc * 32 + fr, fq * 8);
#define PG8_SA(b, h) (((b) * 2 + (h)) * HTB)
#define PG8_SB(b, h) ((4 + (b) * 2 + (h)) * HTB)
#define PG8_STAGE(bufoff, gbase, voff) do { _Pragma("unroll") for (int _i = 0; _i < 2; ++_i) \
        __builtin_amdgcn_global_load_lds((const unsigned*)((const char*)(gbase) + (voff)[_i]), (PG8_LAS unsigned*)(lds + (bufoff) + ldsw + _i * 8192), 16, 0, 0); } while (0)
#define PG8_LDA(dst, b, h) do { _Pragma("unroll") for (int m = 0; m < 4; ++m) _Pragma("unroll") for (int k = 0; k < 2; ++k) dst[m][k] = *(const PG8_LAS bf16x8*)(lds + PG8_SA(b, h) + aoff + m * 2048 + k * 1024); } while (0)
#define PG8_LDB(dst, b, h) do { _Pragma("unroll") for (int n = 0; n < 2; ++n) _Pragma("unroll") for (int k = 0; k < 2; ++k) dst[n][k] = *(const PG8_LAS bf16x8*)(lds + PG8_SB(b, h) + boff + n * 2048 + k * 1024); } while (0)
#define PG8_MMA(ai, bj, At, Bt) do { __builtin_amdgcn_s_setprio(1); _Pragma("unroll") for (int m = 0; m < 4; ++m) _Pragma("unroll") for (int n = 0; n < 2; ++n) _Pragma("unroll") for (int k = 0; k < 2; ++k) \
        acc[ai][bj][m][n] = __builtin_amdgcn_mfma_f32_16x16x32_bf16(Bt[n][k], At[m][k], acc[ai][bj][m][n], 0, 0, 0); __builtin_amdgcn_s_setprio(0); } while (0)
#define PG8_WAIT_V(n) asm volatile("s_waitcnt vmcnt(" #n ")" ::: "memory")
#define PG8_WAIT_L(n) asm volatile("s_waitcnt lgkmcnt(" #n ")" ::: "memory")
#define PG8_BAR __builtin_amdgcn_s_barrier()
#define PG8_SCHED __builtin_amdgcn_sched_barrier(0)
    Unit cur, nxt; int ui = 0;
    if (!S.next(0, cur)) return;
    f32x4 acc[2][2][4][2];
#pragma unroll
    for (int a = 0; a < 2; ++a)
#pragma unroll
        for (int b = 0; b < 2; ++b)
#pragma unroll
            for (int m = 0; m < 4; ++m)
#pragma unroll
                for (int n = 0; n < 2; ++n) acc[a][b][m][n] = (f32x4){0.f, 0.f, 0.f, 0.f};
    bf16x8 At[4][2], B0[2][2], B1[2][2];
    const char* cA = (const char*)g.A + (size_t)cur.pm * tstep + (size_t)cur.ko * 2; const char* cB = (const char*)g.Bt + (size_t)cur.pn * tstep + (size_t)cur.ko * 2;
    S.a_ready(cur);
    if constexpr (SP2) {
        PG8_STAGE(PG8_SB(0, 0), cB, voffB); PG8_STAGE(PG8_SB(0, 1), cB + hstep, voffB); PG8_STAGE(PG8_SA(0, 0), cA, voffA); PG8_STAGE(PG8_SA(0, 1), cA + hstep, voffA);
        if (wr == 1) PG8_BAR;
        PG8_WAIT_V(2); PG8_BAR;
        PG8_STAGE(PG8_SB(1, 0), cB + kstep, voffB); PG8_STAGE(PG8_SA(1, 0), cA + kstep, voffA); PG8_STAGE(PG8_SB(1, 1), cB + hstep + kstep, voffB);
        PG8_WAIT_V(6); PG8_BAR;
    } else {
        PG8_STAGE(PG8_SB(0, 0), cB, voffB); PG8_STAGE(PG8_SA(0, 0), cA, voffA); PG8_STAGE(PG8_SB(0, 1), cB + hstep, voffB); PG8_STAGE(PG8_SA(0, 1), cA + hstep, voffA);
        if (wr == 1) PG8_BAR;
        PG8_WAIT_V(4); PG8_BAR;
        PG8_STAGE(PG8_SB(1, 0), cB + kstep, voffB); PG8_STAGE(PG8_SA(1, 0), cA + kstep, voffA); PG8_STAGE(PG8_SB(1, 1), cB + hstep + kstep, voffB);
        PG8_WAIT_V(6); PG8_BAR;
    }
    for (;;) {
        const bool has_next = S.next(ui + 1, nxt);
        const char* nA = has_next ? (const char*)g.A + (size_t)nxt.pm * tstep + (size_t)nxt.ko * 2 : cA; const char* nB = has_next ? (const char*)g.Bt + (size_t)nxt.pn * tstep + (size_t)nxt.ko * 2 : cB;
        for (int t = 0; t < nt; t += 2) {
            const bool last = (t == nt - 2);
            if constexpr (Epi::MIDK) { if (t == (nt >> 1)) E.mid(acc, cur, wr, fr); }
            const char* a1 = cA + (size_t)(t + 1) * kstep;
            const char* a2 = last ? nA : cA + (size_t)(t + 2) * kstep; const char* b2 = last ? nB : cB + (size_t)(t + 2) * kstep;
            const char* a3 = a2 + kstep; const char* b3 = b2 + kstep;
            if (last && has_next) S.a_ready(nxt);
            if constexpr (SP2) {
            PG8_LDB(B0, 0, 0); PG8_LDB(B1, 0, 1); PG8_SCHED; PG8_LDA(At, 0, 0); PG8_STAGE(PG8_SA(1, 1), a1 + hstep, voffA);
            PG8_WAIT_V(8); PG8_WAIT_L(0); PG8_BAR; PG8_MMA(0, 0, At, B0); PG8_MMA(0, 1, At, B1); PG8_BAR; PG8_SCHED;
            PG8_LDA(At, 0, 1); PG8_STAGE(PG8_SB(0, 0), b2, voffB); PG8_STAGE(PG8_SB(0, 1), b2 + hstep, voffB); PG8_STAGE(PG8_SA(0, 0), a2, voffA);
            PG8_WAIT_V(8); PG8_WAIT_L(0); PG8_BAR; PG8_MMA(1, 0, At, B0); PG8_MMA(1, 1, At, B1); PG8_BAR; PG8_SCHED;
            PG8_LDB(B0, 1, 0); PG8_LDB(B1, 1, 1); PG8_SCHED; PG8_LDA(At, 1, 0); PG8_STAGE(PG8_SA(0, 1), a2 + hstep, voffA);
            PG8_WAIT_V(8); PG8_WAIT_L(0); PG8_BAR; PG8_MMA(0, 0, At, B0); PG8_MMA(0, 1, At, B1); PG8_BAR; PG8_SCHED;
            PG8_LDA(At, 1, 1); PG8_STAGE(PG8_SB(1, 0), b3, voffB); PG8_STAGE(PG8_SB(1, 1), b3 + hstep, voffB); PG8_STAGE(PG8_SA(1, 0), a3, voffA);
            PG8_WAIT_V(8); PG8_WAIT_L(0); PG8_BAR; PG8_MMA(1, 0, At, B0); PG8_MMA(1, 1, At, B1); PG8_BAR; PG8_SCHED;
            } else {
            PG8_LDB(B0, 0, 0); PG8_SCHED; PG8_LDA(At, 0, 0); PG8_STAGE(PG8_SA(1, 1), a1 + hstep, voffA);
            PG8_WAIT_L(8); PG8_BAR; PG8_WAIT_L(0); PG8_MMA(0, 0, At, B0); PG8_BAR; PG8_SCHED;
            PG8_LDB(B1, 0, 1); PG8_STAGE(PG8_SB(0, 0), b2, voffB);
            PG8_BAR; PG8_WAIT_L(0); PG8_MMA(0, 1, At, B1); PG8_BAR;
            PG8_LDA(At, 0, 1); PG8_STAGE(PG8_SA(0, 0), a2, voffA);
            PG8_BAR; PG8_WAIT_L(0); PG8_MMA(1, 0, At, B0); PG8_BAR; PG8_SCHED;
            PG8_STAGE(PG8_SB(0, 1), b2 + hstep, voffB);
            PG8_WAIT_V(6); PG8_BAR; PG8_MMA(1, 1, At, B1); PG8_BAR;
            PG8_LDB(B0, 1, 0); PG8_SCHED; PG8_LDA(At, 1, 0); PG8_STAGE(PG8_SA(0, 1), a2 + hstep, voffA);
            PG8_WAIT_L(8); PG8_BAR; PG8_WAIT_L(0); PG8_MMA(0, 0, At, B0); PG8_BAR; PG8_SCHED;
            PG8_LDB(B1, 1, 1); PG8_STAGE(PG8_SB(1, 0), b3, voffB);
            PG8_BAR; PG8_WAIT_L(0); PG8_MMA(0, 1, At, B1); PG8_BAR;
            PG8_LDA(At, 1, 1); PG8_STAGE(PG8_SA(1, 0), a3, voffA);
            PG8_BAR; PG8_WAIT_L(0); PG8_MMA(1, 0, At, B0); PG8_BAR; PG8_SCHED;
            PG8_STAGE(PG8_SB(1, 1), b3 + hstep, voffB);
            PG8_WAIT_V(6); PG8_BAR; PG8_MMA(1, 1, At, B1); PG8_BAR;
            }
        }
        if constexpr (ALIGN_EPI) { if (wr == 0) PG8_BAR; }
        if constexpr (!Epi::AFTER_DRAIN) { E(acc, cur, wr, wc, fr, fq); S.done(cur); }
        if (!has_next) break;
#pragma unroll
        for (int a = 0; a < 2; ++a)
#pragma unroll
            for (int b = 0; b < 2; ++b)
#pragma unroll
                for (int m = 0; m < 4; ++m)
#pragma unroll
                    for (int n = 0; n < 2; ++n) acc[a][b][m][n] = (f32x4){0.f, 0.f, 0.f, 0.f};
        cur = nxt; cA = nA; cB = nB; ++ui;
        if constexpr (ALIGN_EPI) { if (wr == 1) PG8_BAR; }
    }
    PG8_WAIT_V(0);
    if constexpr (!ALIGN_EPI) { if (wr == 0) PG8_BAR; }
    PG8_BAR;
    if constexpr (Epi::AFTER_DRAIN) { E.fused(acc, cur, wr, wc, fr, fq, lds, wid, lane); S.done(cur); }
#undef PG8_SA
#undef PG8_SB
#undef PG8_STAGE
#undef PG8_LDA
#undef PG8_LDB
#undef PG8_MMA
#undef PG8_WAIT_V
#undef PG8_WAIT_L
#undef PG8_BAR
#undef PG8_SCHED
}
}
using pg8::Unit;
typedef f32x4 Acc[2][2][4][2];
#define EPI_ROWS _Pragma("unroll") for (int ai = 0; ai < 2; ++ai) _Pragma("unroll") for (int m = 0; m < 4; ++m)
#define EPI_COLS _Pragma("unroll") for (int bj = 0; bj < 2; ++bj) _Pragma("unroll") for (int n = 0; n < 2; ++n)

struct EpiProj {
    static constexpr bool PERM = false, AFTER_DRAIN = false, MIDK = false;
    float* U; float* PQ;
    __device__ __forceinline__ void operator()(const Acc& acc, const Unit& u, int wr, int wc, int fr, int fq) const {
        const bool isu = u.pn < 2; float* base = isu ? U : PQ; const int ld = isu ? 512 : 768; const int c0 = (isu ? u.pn : u.pn - 2) * 256 + wc * 32 + 4 * fq;
        EPI_ROWS { const int row = u.pm * 256 + ai * 128 + wr * 64 + m * 16 + fr; float* rp = base + (size_t)row * ld + c0;
            EPI_COLS *(f32x4*)(rp + bj * 128 + n * 16) = acc[ai][bj][m][n]; }
    }
};
struct EpiSlab {
    static constexpr bool PERM = false, AFTER_DRAIN = false, MIDK = false;
    float* S;
    __device__ __forceinline__ void operator()(const Acc& acc, const Unit& u, int wr, int wc, int fr, int fq) const {
        float* base = S + (size_t)(u.ko >> 9) * 1024 * 1024 + u.pn * 256 + wc * 32 + 4 * fq;
        EPI_ROWS { const int row = u.pm * 256 + ai * 128 + wr * 64 + m * 16 + fr;
            EPI_COLS *(f32x4*)(base + (size_t)row * 1024 + bj * 128 + n * 16) = acc[ai][bj][m][n]; }
    }
};
template <bool VT> struct EpiStore {
    static constexpr bool PERM = !VT, AFTER_DRAIN = false, MIDK = false;
    bf16_t* O; int ldc; float* F32; int ldf; float* F32T; int ldt; int rowswap;
    __device__ __forceinline__ void operator()(const Acc& acc, const Unit& u, int wr, int wc, int fr, int fq) const {
        if constexpr (VT) { const int sw = ((fq & 1) << 1) | (fq >> 1);
            EPI_ROWS { const int row = u.pm * 256 + ai * 128 + wr * 64 + m * 16 + fr;
                EPI_COLS { const int cb = u.pn * 256 + bj * 128 + wc * 32 + n * 16; const f32x4 v = acc[ai][bj][m][n];
                    *(u32x2*)(O + (size_t)row * ldc + cb + 4 * sw) = pack4(v);
                    if (F32) *(f32x4*)(F32 + (size_t)row * ldf + cb + 4 * fq) = v;
                    if (F32T) { _Pragma("unroll") for (int j = 0; j < 4; ++j) F32T[(size_t)(cb + 4 * fq + j) * ldt + row] = v[j]; } } }
        } else {
            EPI_ROWS { const int row = u.pm * 256 + ai * 128 + wr * 64 + m * 16 + fr;
                _Pragma("unroll") for (int bj = 0; bj < 2; ++bj) { const int cb = u.pn * 256 + bj * 128 + wc * 32 + 8 * fq; const f32x4 v0 = acc[ai][bj][m][0], v1 = acc[ai][bj][m][1];
                    const u32x2 h0 = pack4(v0), h1 = pack4(v1); u32x4 w; w.x = h0.x; w.y = h0.y; w.z = h1.x; w.w = h1.y;
                    *(u32x4*)(O + (size_t)(rowswap ? swap23(row) : row) * ldc + cb) = w;
                    if (F32) { *(f32x4*)(F32 + (size_t)row * ldf + cb) = v0; *(f32x4*)(F32 + (size_t)row * ldf + cb + 4) = v1; }
                    if (F32T) { _Pragma("unroll") for (int j = 0; j < 4; ++j) { F32T[(size_t)(cb + j) * ldt + row] = v0[j]; F32T[(size_t)(cb + 4 + j) * ldt + row] = v1[j]; } } } }
        }
    }
};
struct EpiQ {
    static constexpr bool PERM = false, AFTER_DRAIN = false, MIDK = false;
    bf16_t* Q;
    __device__ __forceinline__ void operator()(const Acc& acc, const Unit& u, int wr, int wc, int fr, int fq) const {
        EPI_ROWS { const int row = u.pm * 256 + ai * 128 + wr * 64 + m * 16 + fr; bf16_t* qp = Q + (size_t)row * 768;
            if (u.pn < 2) { EPI_COLS { const int h = 2 * u.pn + bj, d = wc * 32 + n * 16 + 4 * fq; *(u32x2*)(qp + h * 192 + d) = pack4(acc[ai][bj][m][n] * QSCALE); } }
            else { const int pos = tok_pos(row);
                _Pragma("unroll") for (int n = 0; n < 2; ++n) { f32x4 o1, o2;
                    _Pragma("unroll") for (int j = 0; j < 4; ++j) { float c, s; rope_cs(pos, n * 16 + 4 * fq + j, c, s); const float x1 = acc[ai][0][m][n][j], x2 = acc[ai][1][m][n][j];
                        o1[j] = (x1 * c - x2 * s) * QSCALE; o2[j] = (x2 * c + x1 * s) * QSCALE; }
                    *(u32x2*)(qp + wc * 192 + 128 + n * 16 + 4 * fq) = pack4(o1); *(u32x2*)(qp + wc * 192 + 160 + n * 16 + 4 * fq) = pack4(o2); } }
        }
    }
};
struct EpiGlu {
    static constexpr bool PERM = true, AFTER_DRAIN = false, MIDK = false;
    bf16_t* MIX; float* ST;
    __device__ __forceinline__ void operator()(const Acc& acc, const Unit& u, int wr, int wc, int fr, int fq) const {
        EPI_ROWS { const int row = u.pm * 256 + ai * 128 + wr * 64 + m * 16 + fr; float q = 0.f; u32x2 h[2];
            _Pragma("unroll") for (int n = 0; n < 2; ++n) { const f32x4 v = acc[ai][0][m][n], g = acc[ai][1][m][n]; f32x4 o;
                _Pragma("unroll") for (int j = 0; j < 4; ++j) { o[j] = v[j] * __builtin_amdgcn_rcpf(1.f + __builtin_amdgcn_exp2f(-g[j] * LOG2E)); q += o[j] * o[j]; }
                h[n] = pack4(o); }
            u32x4 w; w.x = h[0].x; w.y = h[0].y; w.z = h[1].x; w.w = h[1].y;
            *(u32x4*)(MIX + (size_t)row * 1024 + u.pn * 128 + wc * 32 + 8 * fq) = w;
            q += __shfl_xor(q, 16); q += __shfl_xor(q, 32);
            if (fq == 0) ST[(size_t)(u.pn * 4 + wc) * MTOK + row] = q; }
    }
};
__device__ __forceinline__ void ln_stats16(const float* PS, const float* PQ, int row, float& mu, float& rstd) {
    float s = 0.f, q = 0.f;
#pragma unroll
    for (int i = 0; i < 16; ++i) { s += PS[(size_t)i * MTOK + row]; q += PQ[(size_t)i * MTOK + row]; }
    mu = s * (1.f / 1024.f); const float var = q * (1.f / 1024.f) - mu * mu; rstd = rsqrtf(var + EPSN);
}
template <int MODE> struct EpiRes {
    static constexpr bool PERM = true, AFTER_DRAIN = false, MIDK = (MODE == 0);
    const float* xp; const float* xs; float* R; bf16_t* Rb; const float* PSin; const float* PQin; const float* g; const float* b; float* PSout; float* PQout; const LAS float* tab;
    __device__ __forceinline__ void mid(Acc& acc, const Unit& u, int wr, int fr) const {
        EPI_ROWS { const float ratio = tab[(u.idx & 1) * 512 + ai * 128 + wr * 64 + m * 16 + fr];
            EPI_COLS acc[ai][bj][m][n] *= ratio; }
    }
    __device__ __forceinline__ void operator()(const Acc& acc, const Unit& u, int wr, int wc, int fr, int fq) const {
        const int c0 = u.pn * 256 + wc * 32 + 8 * fq;
        EPI_ROWS { const int row = u.pm * 256 + ai * 128 + wr * 64 + m * 16 + fr; float rowscale = 1.f, mu = 0.f, rstd = 1.f;
            if (MODE == 0) rowscale = tab[(u.idx & 1) * 512 + 256 + ai * 128 + wr * 64 + m * 16 + fr]; else { mu = tab[u.idx * 512 + ai * 128 + wr * 64 + m * 16 + fr]; rstd = tab[u.idx * 512 + 256 + ai * 128 + wr * 64 + m * 16 + fr]; }
            const float* rsrc = MODE == 0 ? (row < TP ? xp + (size_t)row * 1024 : xs + (size_t)(row - TP) * 1024) : R + (size_t)row * 1024;
            float s = 0.f, q = 0.f;
            _Pragma("unroll") for (int bj = 0; bj < 2; ++bj) { u32x2 hb[2];
                _Pragma("unroll") for (int n = 0; n < 2; ++n) { const int col = c0 + bj * 128 + n * 4; f32x4 res = *(const f32x4*)(rsrc + col);
                    if (MODE == 1) { const f32x4 g4 = *(const f32x4*)(g + col), b4 = *(const f32x4*)(b + col); res = (res - mu) * rstd * g4 + b4; }
                    const f32x4 v = res * ALPHA + acc[ai][bj][m][n] * rowscale;
                    s += (v[0] + v[1]) + (v[2] + v[3]); q += (v[0] * v[0] + v[1] * v[1]) + (v[2] * v[2] + v[3] * v[3]);
                    *(f32x4*)(R + (size_t)row * 1024 + col) = v; hb[n] = pack4(v); }
                if (Rb) { u32x4 w; w.x = hb[0].x; w.y = hb[0].y; w.z = hb[1].x; w.w = hb[1].y; *(u32x4*)(Rb + (size_t)row * 1024 + c0 + bj * 128) = w; } }
            s += __shfl_xor(s, 16); s += __shfl_xor(s, 32); q += __shfl_xor(q, 16); q += __shfl_xor(q, 32);
            if (fq == 0) { PSout[(size_t)(u.pn * 4 + wc) * MTOK + row] = s; PQout[(size_t)(u.pn * 4 + wc) * MTOK + row] = q; } }
    }
};
template <int ACT> struct EpiLnAct {
    static constexpr bool PERM = true, AFTER_DRAIN = false, MIDK = false;
    const LAS float* tab; const float* cs; const float* bw; bf16_t* O; int ldc;
    __device__ __forceinline__ void operator()(const Acc& acc, const Unit& u, int wr, int wc, int fr, int fq) const {
        const int c0 = u.pn * 256 + wc * 32 + 8 * fq; f32x4 cs4[2][2], bw4[2][2];
        EPI_COLS { cs4[bj][n] = *(const f32x4*)(cs + c0 + bj * 128 + n * 4); bw4[bj][n] = *(const f32x4*)(bw + c0 + bj * 128 + n * 4); }
        EPI_ROWS { const int row = u.pm * 256 + ai * 128 + wr * 64 + m * 16 + fr; const float mu = tab[u.idx * 512 + ai * 128 + wr * 64 + m * 16 + fr], rstd = tab[u.idx * 512 + 256 + ai * 128 + wr * 64 + m * 16 + fr];
            _Pragma("unroll") for (int bj = 0; bj < 2; ++bj) { u32x2 h[2];
                _Pragma("unroll") for (int n = 0; n < 2; ++n) { f32x4 v = (acc[ai][bj][m][n] - cs4[bj][n] * mu) * rstd + bw4[bj][n];
                    if (ACT == 0) v = v * XSCALE; else { _Pragma("unroll") for (int j = 0; j < 4; ++j) { const float r = fmaxf(v[j], 0.f); v[j] = r * r; } }
                    h[n] = pack4(v); }
                u32x4 w; w.x = h[0].x; w.y = h[0].y; w.z = h[1].x; w.w = h[1].y;
                *(u32x4*)(O + (size_t)row * ldc + c0 + bj * 128) = w; } }
    }
};

__device__ __forceinline__ void wo_fill_tab(const Unit& u, const float* STssm, const float* STmla, LAS float* tab) {
    const int t = threadIdx.x;
    if (t < 256) { const int row = u.pm * 256 + t; float s1 = 0.f, s2 = 0.f;
#pragma unroll
        for (int i = 0; i < 16; ++i) s1 += STssm[(size_t)i * MTOK + row];
#pragma unroll
        for (int i = 0; i < 4; ++i) s2 += STmla[(size_t)i * MTOK + row];
        const float r1 = rsqrtf(s1 * (1.f / 512.f) + EPSN), r2 = rsqrtf(s2 * (1.f / 512.f) + EPSN);
        tab[(u.idx & 1) * 512 + t] = r1 / r2; tab[(u.idx & 1) * 512 + 256 + t] = r2; }
}

__device__ __forceinline__ void ln_fill_tab(const pg8::StaticOrder& S, const float* PS, const float* PQ, LAS float* tab) {
    const int t = threadIdx.x; Unit u;
    if (t < 256) {
#pragma unroll 1
        for (int i = 0; i < 5; ++i) if (S.next(i, u)) { float mu, rstd; ln_stats16(PS, PQ, u.pm * 256 + t, mu, rstd); tab[i * 512 + t] = mu; tab[i * 512 + 256 + t] = rstd; } }
    __syncthreads();
}

template <int DQK, int DKN, int DV, bool SPLITDV>
__device__ __forceinline__ void attn_unit(LAS unsigned char* lds, const bf16_t* Qp, int ldq, const bf16_t* Kn, int ldkn, const bf16_t* Kpe, const bf16_t* Vt, int ldvt,
                                          int ntiles, int kvlim, bf16_t* Op, int ldo, float* statp, int nrows) {
    constexpr int NS = DQK / 16, KROWB = DQK * 2 + 16, VROWB = 144, KTILE = 64 * KROWB, VTILE = DV * VROWB, STAGE = KTILE + VTILE;
    constexpr int CPR = DQK / 8, KCH = 64 * CPR / 512, VCH = DV * 8 / 512, NKH = SPLITDV ? 2 : 1, NDB = 4;
    static_assert((SPLITDV ? DV / 64 : DV / 32) == NDB, "value tiling");
    int tid_ = threadIdx.x; asm volatile("" : "+v"(tid_));
    const int tid = tid_, wid = __builtin_amdgcn_readfirstlane(tid >> 6), lane = tid & 63, r32 = lane & 31, hi = lane >> 5, rg = wid & 3, grp = wid >> 2;
    const int keyoff = SPLITDV ? 0 : 32 * grp, dbase = SPLITDV ? grp * (DV / 2) : 0;
    const bool wact = kvlim > 0;
    bf16x8 qf[NS];
    { const bf16_t* qrow = Qp + (size_t)(rg * 32 + r32) * ldq + hi * 8;
#pragma unroll
      for (int s = 0; s < NS; ++s) qf[s] = wact ? *(const bf16x8*)(qrow + 16 * s) : (bf16x8){0, 0, 0, 0, 0, 0, 0, 0}; }
    constexpr bool KREG = (CPR == 32) && (DKN == DQK);
    const bf16_t* kp[KREG ? 1 : KCH]; int kst[KREG ? 1 : KCH], kld[KREG ? 1 : KCH];
    if constexpr (KREG) { const int row = tid >> 5, cc = tid & 31; kp[0] = Kn + (size_t)row * ldkn + cc * 8; kst[0] = 64 * ldkn; kld[0] = row * KROWB + cc * 16; }
    else {
#pragma unroll
        for (int i = 0; i < KCH; ++i) { const int c = tid + 512 * i, row = c / CPR, cc = c - row * CPR;
            if (cc < DKN / 8) { kp[i] = Kn + (size_t)row * ldkn + cc * 8; kst[i] = 64 * ldkn; } else { kp[i] = Kpe + (size_t)row * 64 + (cc - DKN / 8) * 8; kst[i] = 64 * 64; }
            kld[i] = row * KROWB + cc * 16; } }
    const bf16_t* vp0 = Vt + (size_t)(tid >> 3) * ldvt + (tid & 7) * 8; const int vld0 = KTILE + (tid >> 3) * VROWB + (tid & 7) * 16;
#define KP(i) (KREG ? kp[0] + (size_t)(i) * 16 * ldkn : kp[KREG ? 0 : (i)])
#define KST(i) kst[KREG ? 0 : (i)]
#define KLD(i) (KREG ? kld[0] + (i) * 16 * KROWB : kld[KREG ? 0 : (i)])
    u32x4 sk[KCH], sv[VCH];
#define AT_ISSUE_K(t) do { _Pragma("unroll") for (int i = 0; i < KCH; ++i) sk[i] = *(const u32x4*)(KP(i) + (size_t)(t) * KST(i)); } while (0)
#define AT_ISSUE_V(t) do { _Pragma("unroll") for (int i = 0; i < VCH; ++i) sv[i] = *(const u32x4*)(vp0 + (size_t)(i) * 64 * ldvt + (size_t)(t) * 64); } while (0)
#define AT_ISSUE(t) do { AT_ISSUE_K(t); AT_ISSUE_V(t); } while (0)
#define AT_WRITE(st) do { _Pragma("unroll") for (int i = 0; i < KCH; ++i) *(LAS u32x4*)(lds + (st) * STAGE + KLD(i)) = sk[i]; \
                          _Pragma("unroll") for (int i = 0; i < VCH; ++i) *(LAS u32x4*)(lds + (st) * STAGE + vld0 + (i) * 64 * VROWB) = sv[i]; } while (0)
    f32x16 o[NDB];
#pragma unroll
    for (int d = 0; d < NDB; ++d)
#pragma unroll
        for (int r = 0; r < 16; ++r) o[d][r] = 0.f;
    float mrun = -1e30f, lrun = 0.f;
    const int kboff = (keyoff + r32) * KROWB + hi * 16, vboff = KTILE + (dbase + r32) * VROWB + keyoff * 2 + hi * 16;
    AT_ISSUE(0); AT_WRITE(0); __syncthreads();
    if (!SPLITDV && ntiles > 1) AT_ISSUE(1);
    for (int t = 0; t < ntiles; ++t) {
        const int st = t & 1;
        if (SPLITDV) { if (t + 1 < ntiles) AT_ISSUE_K(t + 1); }
        else if (grp == 1) { if (t + 1 < ntiles) AT_WRITE(st ^ 1); if (t + 2 < ntiles) AT_ISSUE(t + 2); }
        if (t * 64 + keyoff < kvlim) {
            f32x16 p[NKH];
            const LAS unsigned char* kb = lds + st * STAGE + kboff;
#pragma unroll
            for (int kh = 0; kh < NKH; ++kh) {
#pragma unroll
                for (int r = 0; r < 16; ++r) p[kh][r] = 0.f;
#pragma unroll
                for (int s = 0; s < NS; ++s) { const bf16x8 kf = *(const LAS bf16x8*)(kb + kh * 32 * KROWB + s * 32); p[kh] = __builtin_amdgcn_mfma_f32_32x32x16_bf16(kf, qf[s], p[kh], 0, 0, 0); }
            }
            float tmax = p[0][0];
#pragma unroll
            for (int kh = 0; kh < NKH; ++kh)
#pragma unroll
                for (int r = 0; r < 16; ++r) tmax = fmaxf(tmax, p[kh][r]);
            { auto rr = __builtin_amdgcn_permlane32_swap(__float_as_uint(tmax), __float_as_uint(tmax), false, false); tmax = fmaxf(__uint_as_float(rr[0]), __uint_as_float(rr[1])); }
            const float mnew = fmaxf(mrun, tmax);
            if (__any(mnew > mrun)) { const float alpha = __builtin_amdgcn_exp2f(mrun - mnew); lrun *= alpha; mrun = mnew;
#pragma unroll
                for (int d = 0; d < NDB; ++d)
#pragma unroll
                    for (int r = 0; r < 16; ++r) o[d][r] *= alpha; }
            float ls = 0.f;
#pragma unroll
            for (int kh = 0; kh < NKH; ++kh)
#pragma unroll
                for (int r = 0; r < 16; ++r) { p[kh][r] = __builtin_amdgcn_exp2f(p[kh][r] - mrun); ls += p[kh][r]; }
            lrun += ls;
            bf16x8 pf[NKH * 2];
#pragma unroll
            for (int kh = 0; kh < NKH; ++kh)
#pragma unroll
                for (int s2 = 0; s2 < 2; ++s2) { u32x4 w; w.x = cvt_pk_bf16(p[kh][8 * s2 + 0], p[kh][8 * s2 + 1]); w.y = cvt_pk_bf16(p[kh][8 * s2 + 2], p[kh][8 * s2 + 3]);
                    w.z = cvt_pk_bf16(p[kh][8 * s2 + 4], p[kh][8 * s2 + 5]); w.w = cvt_pk_bf16(p[kh][8 * s2 + 6], p[kh][8 * s2 + 7]); pf[kh * 2 + s2] = *(bf16x8*)&w; }
            if (SPLITDV && t + 1 < ntiles) AT_ISSUE_V(t + 1);
            const LAS unsigned char* vb = lds + st * STAGE + vboff;
#pragma unroll
            for (int d = 0; d < NDB; ++d)
#pragma unroll
                for (int ks = 0; ks < NKH * 2; ++ks) { const bf16x8 vf = *(const LAS bf16x8*)(vb + d * 32 * VROWB + ks * 32); o[d] = __builtin_amdgcn_mfma_f32_32x32x16_bf16(vf, pf[ks], o[d], 0, 0, 0); }
        } else if (SPLITDV && t + 1 < ntiles) AT_ISSUE_V(t + 1);
        if (SPLITDV && t + 1 < ntiles) AT_WRITE(st ^ 1);
        if (!SPLITDV && grp == 0) { if (t + 1 < ntiles) AT_WRITE(st ^ 1); if (t + 2 < ntiles) AT_ISSUE(t + 2); }
        __syncthreads();
    }
#undef AT_ISSUE
#undef AT_ISSUE_K
#undef AT_ISSUE_V
#undef KP
#undef KST
#undef KLD
#undef AT_WRITE
    lrun += __shfl_xor(lrun, 32);
    if (!SPLITDV) {
        LAS float* MO = (LAS float*)lds; LAS float* MM = (LAS float*)(lds + 65536); LAS float* ML = (LAS float*)(lds + 65536 + 1024);
        if (grp == 1) {
#pragma unroll
            for (int d = 0; d < NDB; ++d)
#pragma unroll
                for (int r = 0; r < 16; ++r) MO[(rg * 64 + d * 16 + r) * 64 + lane] = o[d][r];
            MM[rg * 64 + lane] = mrun; ML[rg * 64 + lane] = lrun;
        }
        __syncthreads();
        if (grp == 0) {
            const float m1 = MM[rg * 64 + lane], l1 = ML[rg * 64 + lane], ms = fmaxf(mrun, m1);
            const float a0 = __builtin_amdgcn_exp2f(mrun - ms), a1 = __builtin_amdgcn_exp2f(m1 - ms);
            lrun = lrun * a0 + l1 * a1;
#pragma unroll
            for (int d = 0; d < NDB; ++d)
#pragma unroll
                for (int r = 0; r < 16; ++r) o[d][r] = o[d][r] * a0 + MO[(rg * 64 + d * 16 + r) * 64 + lane] * a1;
        }
    }
    if (SPLITDV || grp == 0) {
        const float inv = __builtin_amdgcn_rcpf(lrun); const int row = rg * 32 + r32; const bool ok = wact && row < nrows; float ss = 0.f;
        bf16_t* orow = Op + (size_t)row * ldo + dbase;
#pragma unroll
        for (int d = 0; d < NDB; ++d)
#pragma unroll
            for (int g4 = 0; g4 < 4; g4 += 2) { u32x2 pk[2];
#pragma unroll
                for (int e = 0; e < 2; ++e) { f32x4 v; v[0] = o[d][4 * (g4 + e)] * inv; v[1] = o[d][4 * (g4 + e) + 1] * inv; v[2] = o[d][4 * (g4 + e) + 2] * inv; v[3] = o[d][4 * (g4 + e) + 3] * inv;
                    ss += (v[0] * v[0] + v[1] * v[1]) + (v[2] * v[2] + v[3] * v[3]); pk[e] = pack4(v); }
                const u32x2 snd = hi ? pk[0] : pk[1]; u32x2 rcv; rcv.x = __shfl_xor(snd.x, 32); rcv.y = __shfl_xor(snd.y, 32);
                u32x4 w; if (hi == 0) { w.x = pk[0].x; w.y = pk[0].y; w.z = rcv.x; w.w = rcv.y; } else { w.x = rcv.x; w.y = rcv.y; w.z = pk[1].x; w.w = pk[1].y; }
                if (ok) *(u32x4*)(orow + 32 * d + 8 * (g4 + hi)) = w; }
        ss += __shfl_xor(ss, 32);
        if (statp && ok && hi == 0) statp[row] = ss;
    }
    __syncthreads();
}


__device__ __forceinline__ float gelu_tanh(float x) { const float z2 = 1.5957691216057308f * (x + 0.044715f * x * x * x); return x * __builtin_amdgcn_rcpf(1.f + __builtin_amdgcn_exp2f(-z2 * LOG2E)); }
struct SsmU { bf16x8 hi, lo; };
__device__ __forceinline__ void split_hilo(f32x4 a, f32x4 b, u32x4& hi, u32x4& lo) {
    hi.x = cvt_pk_bf16(a[0], a[1]); hi.y = cvt_pk_bf16(a[2], a[3]); hi.z = cvt_pk_bf16(b[0], b[1]); hi.w = cvt_pk_bf16(b[2], b[3]);
    lo.x = cvt_pk_bf16(a[0] - __uint_as_float(hi.x << 16), a[1] - __uint_as_float(hi.x & 0xffff0000u)); lo.y = cvt_pk_bf16(a[2] - __uint_as_float(hi.y << 16), a[3] - __uint_as_float(hi.y & 0xffff0000u));
    lo.z = cvt_pk_bf16(b[0] - __uint_as_float(hi.z << 16), b[1] - __uint_as_float(hi.z & 0xffff0000u)); lo.w = cvt_pk_bf16(b[2] - __uint_as_float(hi.w << 16), b[3] - __uint_as_float(hi.w & 0xffff0000u));
}
struct SsmW { float lr, li; bf16x8 ab[8]; };
__device__ __forceinline__ void ssm_load_w(const Frame& F, int g, int lane, SsmW& w) {
    const float* LAM = (const float*)(F.ws + W_LAM); const float* BB = (const float*)(F.ws + W_BB);
    w.lr = LAM[g * 64 + lane]; w.li = LAM[2048 + g * 64 + lane];
    const int q = lane >> 4;
#pragma unroll
    for (int blk = 0; blk < 8; ++blk) { const int row = 16 * blk + (lane & 15);
        const float* bp = (row < 64 ? BB + (size_t)(g * 64 + row) * 16 : BB + 32768 + (size_t)(g * 64 + row - 64) * 16) + 8 * (q & 1);
        u32x4 hi, lo; split_hilo(*(const f32x4*)bp, *(const f32x4*)(bp + 4), hi, lo); const u32x4 sel = q < 2 ? hi : lo; w.ab[blk] = *(const bf16x8*)&sel; }
}
__device__ __forceinline__ void ssm_load_u(const float* U, int tb, int g, int lane, SsmU& ub) {
    const int q = lane >> 4; const float* up = U + (size_t)(tb + (lane & 15)) * 512 + g * 16 + 8 * (q & 1);
    u32x4 hi, lo; split_hilo(*(const f32x4*)up, *(const f32x4*)(up + 4), hi, lo); if (q >= 2) lo = (u32x4){0u, 0u, 0u, 0u};
    ub.hi = *(const bf16x8*)&hi; ub.lo = *(const bf16x8*)&lo;
}
template <bool WR> __device__ __forceinline__ void ssm_block16(const SsmW& w, const SsmU& ub, int lane, float& xr, float& xi, LAS float* XW) {
#pragma unroll
    for (int blk = 0; blk < 8; ++blk) { f32x4 d = {0.f, 0.f, 0.f, 0.f};
        d = __builtin_amdgcn_mfma_f32_16x16x32_bf16(w.ab[blk], ub.hi, d, 0, 0, 0); d = __builtin_amdgcn_mfma_f32_16x16x32_bf16(w.ab[blk], ub.lo, d, 0, 0, 0);
        *(LAS f32x4*)(XW + (lane & 15) * 132 + 16 * blk + 4 * (lane >> 4)) = d; }
    float br[16], bi[16];
#pragma unroll
    for (int t = 0; t < 16; ++t) { br[t] = XW[t * 132 + lane]; bi[t] = XW[t * 132 + 64 + lane]; }
#pragma unroll
    for (int t = 0; t < 16; ++t) { const float nr = fmaf(w.lr, xr, fmaf(-w.li, xi, br[t])), ni = fmaf(w.lr, xi, fmaf(w.li, xr, bi[t])); xr = nr; xi = ni;
        if (WR) { XW[t * 132 + lane] = xr; XW[t * 132 + 64 + lane] = xi; } }
}
__device__ __forceinline__ void ssm_pass_a(const Frame& F) {
    const float* U = F.out; float* SEND = (float*)(F.ws + W_SEND); LAS float* XW = (LAS float*)(F.lds + F.wid * 8448);
    const int g = (F.bid * 8 + F.wid) & 31, p = F.lane; SsmW w; ssm_load_w(F, g, p, w);
    for (int it = F.bid * 8 + F.wid; it < 256 * 32; it += F.G * 8) { const int c = it >> 5;
        float xr = 0.f, xi = 0.f;
        SsmU ub[4];
#pragma unroll
        for (int sb = 0; sb < 4; ++sb) ssm_load_u(U, c * 64 + sb * 16, g, p, ub[sb]);
#pragma unroll
        for (int sb = 0; sb < 4; ++sb) ssm_block16<false>(w, ub[sb], p, xr, xi, XW);
        SEND[(size_t)c * 4096 + g * 64 + p] = xr; SEND[(size_t)c * 4096 + 2048 + g * 64 + p] = xi; }
}
__device__ __forceinline__ void ssm_pass_b(const Frame& F, int b0) {
    float* SEND = (float*)(F.ws + W_SEND); const float* LAM64 = (const float*)(F.ws + W_LAM64);
    const int i = b0 * 512 + F.tid; if (i < 0 || i >= 2048) return;
    const float l6r = LAM64[i], l6i = LAM64[2048 + i]; float xr = 0.f, xi = 0.f;
    float nr_[16], ni_[16];
#pragma unroll
    for (int j = 0; j < 16; ++j) { nr_[j] = SEND[(size_t)j * 4096 + i]; ni_[j] = SEND[(size_t)j * 4096 + 2048 + i]; }
    for (int c0 = 0; c0 < 256; c0 += 16) { float sr[16], si[16];
#pragma unroll
        for (int j = 0; j < 16; ++j) { sr[j] = nr_[j]; si[j] = ni_[j]; }
        if (c0 + 16 < 256) {
#pragma unroll
            for (int j = 0; j < 16; ++j) { nr_[j] = SEND[(size_t)(c0 + 16 + j) * 4096 + i]; ni_[j] = SEND[(size_t)(c0 + 16 + j) * 4096 + 2048 + i]; } }
#pragma unroll
        for (int j = 0; j < 16; ++j) { SEND[(size_t)(c0 + j) * 4096 + i] = xr; SEND[(size_t)(c0 + j) * 4096 + 2048 + i] = xi;
            const float nr = fmaf(l6r, xr, fmaf(-l6i, xi, sr[j])), ni = fmaf(l6r, xi, fmaf(l6i, xr, si[j])); xr = nr; xi = ni; } }
}
__device__ __forceinline__ void ssm_pass_c(const Frame& F) {
    const float* U = F.out; bf16_t* YG = (bf16_t*)((unsigned char*)F.out + 36 * MiB); const float* SEND = (const float*)(F.ws + W_SEND);
    const float* c_re = F.a->in[18]; const float* c_im = F.a->in[19]; const float* dsk = F.a->in[20];
    LAS float* XW = (LAS float*)(F.lds + F.wid * 8448);
    const int p = F.lane, hq = 4 * (F.lane >> 4), tl = F.lane & 15;
    const int g = (F.bid * 8 + F.wid) & 31; SsmW w; ssm_load_w(F, g, p, w);
    bf16x8 cab[4];
#pragma unroll
    for (int ks = 0; ks < 4; ++ks) { const int k = 32 * ks + 8 * (F.lane >> 4); const float* cp = ks < 2 ? c_re + (size_t)(g * 16 + tl) * 64 + k : c_im + (size_t)(g * 16 + tl) * 64 + (k - 64);
        f32x4 a = *(const f32x4*)cp, b = *(const f32x4*)(cp + 4); if (ks >= 2) { a = -a; b = -b; }
        u32x4 w; w.x = cvt_pk_bf16(a[0], a[1]); w.y = cvt_pk_bf16(a[2], a[3]); w.z = cvt_pk_bf16(b[0], b[1]); w.w = cvt_pk_bf16(b[2], b[3]); cab[ks] = *(bf16x8*)&w; }
    const f32x4 ds4 = *(const f32x4*)(dsk + g * 16 + hq);
    for (int it = F.bid * 8 + F.wid; it < 9216; it += F.G * 8) {
        const bool prompt = it < 8192; const int c = prompt ? (it >> 5) : ((it - 8192) >> 5);
        float xr, xi; int tok0, nsb;
        if (prompt) { xr = SEND[(size_t)c * 4096 + g * 64 + p]; xi = SEND[(size_t)c * 4096 + 2048 + g * 64 + p];
            tok0 = c * 64; nsb = 4;
        } else { xr = F.a->in[5][(size_t)(c * 32 + g) * 64 + p]; xi = F.a->in[6][(size_t)(c * 32 + g) * 64 + p]; tok0 = TP + c * 32; nsb = 2; }
        SsmU ub[4]; f32x4 u4a[4];
#pragma unroll
        for (int sb = 0; sb < 4; ++sb) { ssm_load_u(U, tok0 + sb * 16, g, p, ub[sb]); u4a[sb] = *(const f32x4*)(U + (size_t)(tok0 + sb * 16 + tl) * 512 + g * 16 + hq); }
#pragma unroll
        for (int sb = 0; sb < 4; ++sb) { if (sb >= nsb) break; const int tb = tok0 + sb * 16;
            ssm_block16<true>(w, ub[sb], p, xr, xi, XW);
            f32x4 y0 = {0.f, 0.f, 0.f, 0.f}, y1 = {0.f, 0.f, 0.f, 0.f};
#pragma unroll
            for (int ks = 0; ks < 4; ++ks) { const LAS float* xp = XW + tl * 132 + 32 * ks + 8 * (F.lane >> 4); const f32x4 xa = *(const LAS f32x4*)xp, xb = *(const LAS f32x4*)(xp + 4);
                u32x4 w; w.x = cvt_pk_bf16(xa[0], xa[1]); w.y = cvt_pk_bf16(xa[2], xa[3]); w.z = cvt_pk_bf16(xb[0], xb[1]); w.w = cvt_pk_bf16(xb[2], xb[3]); const bf16x8 xf = *(bf16x8*)&w;
                if (ks & 1) y1 = __builtin_amdgcn_mfma_f32_16x16x32_bf16(cab[ks], xf, y1, 0, 0, 0); else y0 = __builtin_amdgcn_mfma_f32_16x16x32_bf16(cab[ks], xf, y0, 0, 0, 0); }
            f32x4 y = y0 + y1 + ds4 * u4a[sb];
#pragma unroll
            for (int j = 0; j < 4; ++j) y[j] = gelu_tanh(y[j]);
            *(u32x2*)(YG + (size_t)(tb + tl) * 512 + g * 16 + hq) = pack4(y);
        }
        if (prompt) { if (c == 255) { F.out[O_SREP + g * 64 + p] = xr; F.out[O_SIMP + g * 64 + p] = xi; } }
        else { F.out[O_SRES + (size_t)(c * 32 + g) * 64 + p] = xr; F.out[O_SIMS + (size_t)(c * 32 + g) * 64 + p] = xi; }
    }
}

__device__ __forceinline__ float wave_sum(float v) {
#pragma unroll
    for (int o = 32; o > 0; o >>= 1) v += __shfl_xor(v, o);
    return v;
}
__device__ __forceinline__ void post_rows(const Frame& F) {
    const float* PQ = (const float*)(F.ws + A_PQ); bf16_t* CQN = (bf16_t*)(F.ws + A_CQN); bf16_t* CKV = (bf16_t*)(F.ws + A_CKV); bf16_t* KPE = (bf16_t*)(F.ws + A_KPE);
    const float* gkv = F.a->in[12];
    const int l = F.lane, rstep = F.G * 8; int row = F.bid * 8 + F.wid;
    f32x4 nq0 = {0.f, 0.f, 0.f, 0.f}, nkv = nq0; u32x2 nq1 = {0u, 0u}; float npe = 0.f;
    if (row < MTOK) { const float* pr = PQ + (size_t)row * 768; nq0 = *(const f32x4*)(pr + 4 * l); nq1 = *(const u32x2*)(pr + 256 + 2 * l); nkv = *(const f32x4*)(pr + 384 + 4 * l); npe = pr[640 + l]; }
    for (; row < MTOK; row += rstep) {
        const f32x4 q0 = nq0, kv = nkv; const u32x2 q1r = nq1; const float pe = npe; const float q10 = __uint_as_float(q1r.x), q11 = __uint_as_float(q1r.y);
        if (row + rstep < MTOK) { const float* pr = PQ + (size_t)(row + rstep) * 768; nq0 = *(const f32x4*)(pr + 4 * l); nq1 = *(const u32x2*)(pr + 256 + 2 * l); nkv = *(const f32x4*)(pr + 384 + 4 * l); npe = pr[640 + l]; }
        const float sq = wave_sum((q0[0] * q0[0] + q0[1] * q0[1]) + (q0[2] * q0[2] + q0[3] * q0[3]) + q10 * q10 + q11 * q11);
        const float skv = wave_sum((kv[0] * kv[0] + kv[1] * kv[1]) + (kv[2] * kv[2] + kv[3] * kv[3]));
        const float rq = rsqrtf(sq * (1.f / 384.f) + EPSN), rkv = rsqrtf(skv * (1.f / 256.f) + EPSN);
        *(u32x2*)(CQN + (size_t)row * 384 + 4 * l) = pack4(q0 * rq); *(unsigned*)(CQN + (size_t)row * 384 + 256 + 2 * l) = cvt_pk_bf16(q10 * rq, q11 * rq);
        const f32x4 g4 = *(const f32x4*)(gkv + 4 * l); const f32x4 kvn = kv * rkv * g4; const int kr = tok_kvrow(row);
        float* oc = row < TP ? F.out + O_CKVP + (size_t)row * 256 : F.out + O_CKVS + (size_t)(row - TP) * 256; float* ok = row < TP ? F.out + O_KPEP + (size_t)row * 64 : F.out + O_KPES + (size_t)(row - TP) * 64;
        *(f32x4*)(oc + 4 * l) = kvn; *(u32x2*)(CKV + (size_t)kr * 256 + 4 * l) = pack4(kvn);
        float c, s; rope_cs(tok_pos(row), l & 31, c, s); const float other = __shfl_xor(pe, 32);
        const float ro = l < 32 ? pe * c - other * s : pe * c + other * s;
        ok[l] = ro; const float ron = __shfl_xor(ro, 1); if ((l & 1) == 0) *(unsigned*)(KPE + (size_t)swap23(kr) * 64 + l) = cvt_pk_bf16(ro, ron); }
}
__device__ __forceinline__ void final_ln(const Frame& F) {
    const float* g = F.a->in[32] + 2048; const float* b = F.a->in[33] + 2048;
    const int rstep = F.G * 8; int row = F.bid * 8 + F.wid; f32x4 nv[4];
#pragma unroll
    for (int i = 0; i < 4; ++i) nv[i] = row < MTOK ? *(const f32x4*)(F.out + O_Y + (size_t)row * 1024 + i * 256 + 4 * F.lane) : (f32x4){0.f, 0.f, 0.f, 0.f};
    for (; row < MTOK; row += rstep) { float* pr = F.out + O_Y + (size_t)row * 1024; f32x4 v[4]; float s = 0.f;
#pragma unroll
        for (int i = 0; i < 4; ++i) { v[i] = nv[i]; s += (v[i][0] + v[i][1]) + (v[i][2] + v[i][3]); }
        if (row + rstep < MTOK) {
#pragma unroll
            for (int i = 0; i < 4; ++i) nv[i] = *(const f32x4*)(pr + (size_t)rstep * 1024 + i * 256 + 4 * F.lane); }
        if (row >= TP) {
            const float* ST2 = (const float*)(F.ws + W_ST2); float mu2, rstd2; ln_stats16(ST2, ST2 + 16 * MTOK, row, mu2, rstd2);
            const float* SL = (const float*)(F.ws + A_R2B) + (size_t)(row - TP) * 1024; s = 0.f;
#pragma unroll
            for (int i = 0; i < 4; ++i) { const int c = i * 256 + 4 * F.lane; const f32x4 g1 = *(const f32x4*)(F.a->in[32] + 1024 + c), b1 = *(const f32x4*)(F.a->in[33] + 1024 + c);
                f32x4 a = (v[i] - mu2) * rstd2 * g1 + b1; a = a * ALPHA;
#pragma unroll
                for (int k = 0; k < 8; ++k) a = a + *(const f32x4*)(SL + (size_t)k * 1024 * 1024 + c);
                v[i] = a; s += (a[0] + a[1]) + (a[2] + a[3]); } }
        const float mu = wave_sum(s) * (1.f / 1024.f); float q = 0.f;
#pragma unroll
        for (int i = 0; i < 4; ++i) { const f32x4 d = v[i] - mu; q += (d[0] * d[0] + d[1] * d[1]) + (d[2] * d[2] + d[3] * d[3]); }
        const float rstd = rsqrtf(wave_sum(q) * (1.f / 1024.f) + EPSN);
#pragma unroll
        for (int i = 0; i < 4; ++i) { const f32x4 g4 = *(const f32x4*)(g + i * 256 + 4 * F.lane), b4 = *(const f32x4*)(b + i * 256 + 4 * F.lane); *(f32x4*)(pr + i * 256 + 4 * F.lane) = (v[i] - mu) * rstd * g4 + b4; } }
}

struct MapId { __device__ __forceinline__ int operator()(int n) const { return n; } };
struct MapWin { __device__ __forceinline__ int operator()(int n) const { return n < 1216 ? n : -1; } };
struct MapWq { __device__ __forceinline__ int operator()(int n) const { if (n < 512) return (n >> 7) * 192 + (n & 127); const int x = n - 512, part = x >> 7, h = (x >> 5) & 3, i = x & 31; return h * 192 + 128 + part * 32 + i; } };
struct MapWk { __device__ __forceinline__ int operator()(int n) const { return (n >> 7) * 256 + (n & 127); } };
struct MapWv { __device__ __forceinline__ int operator()(int n) const { return (n >> 7) * 256 + 128 + (n & 127); } };
struct MapGlu { __device__ __forceinline__ int operator()(int n) const { const int pn = n >> 8, bj = (n >> 7) & 1, x = n & 127; return bj * 512 + pn * 128 + x; } };
template <class CM, bool PERMK = false> __device__ __forceinline__ void wconv(const Frame& F, bf16_t* __restrict__ dst, const float* __restrict__ src, int ld, int K, int N, CM cm, const float* sc0, const float* sc1, int ksplit, int& rot) {
    const int ntn = N >> 5, ntiles = ntn * (K >> 6), tid = F.tid, kr = tid >> 3, nq = tid & 7;
    LAS float* T = (LAS float*)F.lds;
    for (int base = ((F.bid + F.G - rot % F.G) % F.G) * 4; base < ntiles; base += F.G * 4) { f32x4 v[4];
#pragma unroll
        for (int u = 0; u < 4; ++u) { const int tile = base + u; v[u] = (f32x4){0.f, 0.f, 0.f, 0.f};
            if (tile < ntiles) { const int tn = tile % ntn, tk = tile / ntn, col = cm(tn * 32), k = tk * 64 + kr;
                if (col >= 0) { v[u] = *(const f32x4*)(src + (size_t)k * ld + col + 4 * nq); if (sc0) v[u] = v[u] * (k < ksplit ? sc0[k] : sc1[k - ksplit]); } } }
#pragma unroll
        for (int u = 0; u < 4; ++u) {
#pragma unroll
            for (int j = 0; j < 4; ++j) T[u * 2112 + kr * 33 + 4 * nq + j] = v[u][j]; }
        __syncthreads();
        { const int half = tid >> 8, tt = tid & 255, n = tt >> 3, kq = tt & 7;
#pragma unroll
          for (int uu = 0; uu < 2; ++uu) { const int u = half * 2 + uu, tile = base + u;
              if (tile < ntiles) { const int tn = tile % ntn, tk = tile / ntn; float x[8];
#pragma unroll
                  for (int j = 0; j < 8; ++j) { const int pos = 8 * kq + j, kk = PERMK ? ((pos & ~12) | ((pos & 4) << 1) | ((pos & 8) >> 1)) : pos; x[j] = T[u * 2112 + kk * 33 + n]; }
                  u32x4 w; w.x = cvt_pk_bf16(x[0], x[1]); w.y = cvt_pk_bf16(x[2], x[3]); w.z = cvt_pk_bf16(x[4], x[5]); w.w = cvt_pk_bf16(x[6], x[7]);
                  *(u32x4*)(dst + (size_t)(tn * 32 + n) * K + tk * 64 + 8 * kq) = w; } } }
        __syncthreads(); }
    rot += (ntiles + 3) >> 2;
}
__device__ __forceinline__ void cvt_flat(const Frame& F, bf16_t* __restrict__ dst, const float* __restrict__ src, long n8) {
    const long gs = (long)F.G * 512;
    for (long base = (long)F.bid * 512 + F.tid; base < n8; base += 4 * gs) { f32x4 a[4], b[4];
#pragma unroll
        for (int u = 0; u < 4; ++u) { const long i = base + u * gs; const long ii = i < n8 ? i : 0; a[u] = *(const f32x4*)(src + ii * 8); b[u] = *(const f32x4*)(src + ii * 8 + 4); }
#pragma unroll
        for (int u = 0; u < 4; ++u) { const long i = base + u * gs; if (i < n8) { u32x4 w; w.x = cvt_pk_bf16(a[u][0], a[u][1]); w.y = cvt_pk_bf16(a[u][2], a[u][3]); w.z = cvt_pk_bf16(b[u][0], b[u][1]); w.w = cvt_pk_bf16(b[u][2], b[u][3]); *(u32x4*)(dst + i * 8) = w; } } }
}
__device__ __forceinline__ void colsum_job(const Frame& F, const float* W, int N, const float* g, const float* b, float* cs, float* bw, int rotb) {
    LAS float* red = (LAS float*)F.lds;
    const int seg = F.tid >> 4, col = F.tid & 15;
    for (int task = (F.bid + F.G - rotb % F.G) % F.G; task < N / 16; task += F.G) { const int n = task * 16 + col; float s = 0.f, t = 0.f;
#pragma unroll
        for (int j = 0; j < 32; ++j) { const int k = seg * 32 + j; const float w = W[(size_t)k * N + n]; s += bf16_round(w * g[k]); t = fmaf(b[k], w, t); }
        red[F.tid] = s; red[512 + F.tid] = t; __syncthreads();
        if (F.tid < 16) { float a = 0.f, c = 0.f;
#pragma unroll
            for (int i = 0; i < 32; ++i) { a += red[i * 16 + F.tid]; c += red[512 + i * 16 + F.tid]; }
            cs[n] = a; bw[n] = c; }
        __syncthreads(); }
}
__device__ __forceinline__ void ssm_consts(const Frame& F) {
    const int i = F.bid * 512 + F.tid; if (i >= 2048) return;
    const int g = i >> 6; float* LAM = (float*)(F.ws + W_LAM); float* LAM64 = (float*)(F.ws + W_LAM64); float* BB = (float*)(F.ws + W_BB);
    const double ar = F.a->in[14][i], ai = F.a->in[15][i], dt = exp((double)F.a->in[21][g]);
    const double mag = exp(ar * dt), lr = mag * cos(ai * dt), li = mag * sin(ai * dt);
    LAM[i] = (float)lr; LAM[2048 + i] = (float)li;
    double pr = lr, pi = li;
#pragma unroll
    for (int k = 0; k < 6; ++k) { const double nr = pr * pr - pi * pi, ni = 2.0 * pr * pi; pr = nr; pi = ni; }
    LAM64[i] = (float)pr; LAM64[2048 + i] = (float)pi;
    const double nr = lr - 1.0, ni = li, den = ar * ar + ai * ai, fr = (nr * ar + ni * ai) / den, fi = (ni * ar - nr * ai) / den;
#pragma unroll
    for (int h = 0; h < 16; ++h) { const double br = F.a->in[16][(size_t)i * 16 + h], bi = F.a->in[17][(size_t)i * 16 + h];
        BB[(size_t)i * 16 + h] = (float)(fr * br - fi * bi); BB[32768 + (size_t)i * 16 + h] = (float)(fr * bi + fi * br); }
}
__device__ __forceinline__ void cvt_caches(const Frame& F, int b0, int nb) {
    unsigned char* ws = F.ws; { bf16_t* CKV = (bf16_t*)(ws + A_CKV); bf16_t* KPE = (bf16_t*)(ws + A_KPE); const long gs = (long)nb * 512;
#pragma unroll 4
      for (long i = (long)b0 * 512 + F.tid; i < 32L * 1024 * 32; i += gs) { const int c8 = (int)(i & 31), j = (int)((i >> 5) & 1023), bb = (int)(i >> 15);
          const float* s = F.a->in[3] + ((size_t)(bb * 1024 + j) * 256 + c8 * 8); const f32x4 a = *(const f32x4*)s, b = *(const f32x4*)(s + 4);
          u32x4 w; w.x = cvt_pk_bf16(a[0], a[1]); w.y = cvt_pk_bf16(a[2], a[3]); w.z = cvt_pk_bf16(b[0], b[1]); w.w = cvt_pk_bf16(b[2], b[3]);
          *(u32x4*)(CKV + (size_t)(TP + bb * KVS + j) * 256 + c8 * 8) = w; }
#pragma unroll 2
      for (long i = (long)b0 * 512 + F.tid; i < 32L * 1024 * 8; i += gs) { const int c8 = (int)(i & 7), j = (int)((i >> 3) & 1023), bb = (int)(i >> 13);
          const float* s = F.a->in[4] + ((size_t)(bb * 1024 + j) * 64 + c8 * 8); const f32x4 a = *(const f32x4*)s, b = *(const f32x4*)(s + 4);
          u32x4 w; w.x = cvt_pk_bf16(a[0], a[1]); w.y = cvt_pk_bf16(a[2], a[3]); w.z = cvt_pk_bf16(b[0], b[1]); w.w = cvt_pk_bf16(b[2], b[3]);
          *(u32x4*)(KPE + (size_t)swap23(TP + bb * KVS + j) * 64 + c8 * 8) = w; } }
}
#ifndef PRO_DUP
#define PRO_DUP 0
#endif
#define DUPP(j) _Pragma("unroll") for (int rp_ = 0; rp_ < (((PRO_DUP >> (j)) & 1) ? 2 : 1); ++rp_)
__device__ __forceinline__ void prologue(const Frame& F) {
    unsigned char* ws = F.ws;
    DUPP(0) ssm_consts(F);
    int rot = 8;
    DUPP(1) {
    wconv(F, (bf16_t*)(ws + W_WIN), F.a->in[9], 1216, 1024, 1280, MapWin(), nullptr, nullptr, 0, rot);
    }
    DUPP(2) {
    if (F.G > 8) { if (F.bid >= 4) { Frame F2 = F; F2.bid = F.bid - 4; F2.G = F.G - 4; cvt_flat(F2, (bf16_t*)(ws + A_XB), F.a->in[0], (long)TP * 128); } }
    else cvt_flat(F, (bf16_t*)(ws + A_XB), F.a->in[0], (long)TP * 128);
    cvt_flat(F, (bf16_t*)(ws + A_XB) + (size_t)TP * 1024, F.a->in[1], (long)TS * 128);
    cvt_flat(F, (bf16_t*)(ws + W_MEMB), F.a->in[2], 256 * 128);
    }
    DUPP(1) {
    wconv(F, (bf16_t*)(ws + W_WXK), F.a->in[27], 1024, 1024, 1024, MapId(), nullptr, nullptr, 0, rot);
    wconv(F, (bf16_t*)(ws + W_WXV), F.a->in[28], 1024, 1024, 1024, MapId(), nullptr, nullptr, 0, rot);
    wconv(F, (bf16_t*)(ws + W_WQ), F.a->in[11], 768, 384, 768, MapWq(), F.a->in[10], F.a->in[10], 384, rot);
    wconv(F, (bf16_t*)(ws + W_WK), F.a->in[13], 1024, 256, 512, MapWk(), nullptr, nullptr, 0, rot);
    wconv(F, (bf16_t*)(ws + W_WV), F.a->in[13], 1024, 256, 512, MapWv(), nullptr, nullptr, 0, rot);
    wconv(F, (bf16_t*)(ws + W_WGLU), F.a->in[22], 1024, 512, 1024, MapGlu(), nullptr, nullptr, 0, rot);
    wconv(F, (bf16_t*)(ws + W_WO), F.a->in[25], 1024, 1024, 1024, MapId(), F.a->in[23], F.a->in[24], 512, rot);
    wconv(F, (bf16_t*)(ws + W_WXQ), F.a->in[26], 1024, 1024, 1024, MapId(), F.a->in[32], F.a->in[32], 1024, rot);
    wconv(F, (bf16_t*)(ws + W_WXO), F.a->in[29], 1024, 1024, 1024, MapId(), nullptr, nullptr, 0, rot);
    wconv(F, (bf16_t*)(ws + W_WFF1), F.a->in[30], 4096, 1024, 4096, MapId(), F.a->in[32] + 1024, F.a->in[32] + 1024, 1024, rot);
    wconv(F, (bf16_t*)(ws + W_WFF2), F.a->in[31], 1024, 4096, 1024, MapId(), nullptr, nullptr, 0, rot);
    }
    DUPP(4) {
    colsum_job(F, F.a->in[26], 1024, F.a->in[32], F.a->in[33], (float*)(ws + W_CSXQ), (float*)(ws + W_BWXQ), 0);
    colsum_job(F, F.a->in[30], 4096, F.a->in[32] + 1024, F.a->in[33] + 1024, (float*)(ws + W_CSFF1), (float*)(ws + W_BWFF1), 64);
    }
}
__device__ __forceinline__ void cvt_memcache(const Frame& F, int b0, int bstride) {
    bf16_t* XKS = (bf16_t*)(F.ws + A_XKS); bf16_t* XVTS = (bf16_t*)(F.ws + A_XVTS); const float* ck = F.a->in[7]; const float* cv = F.a->in[8];
    const long gs = (long)bstride * 512;
    for (long i = (long)b0 * 512 + F.tid; i < 32L * 256 * 128; i += gs) { const f32x4 a = *(const f32x4*)(ck + i * 8), b = *(const f32x4*)(ck + i * 8 + 4);
        const long rowi = i >> 7, c8 = i & 127; const long drow = (rowi & ~255L) | swap23((int)(rowi & 255));
        u32x4 w; w.x = cvt_pk_bf16(a[0], a[1]); w.y = cvt_pk_bf16(a[2], a[3]); w.z = cvt_pk_bf16(b[0], b[1]); w.w = cvt_pk_bf16(b[2], b[3]); *(u32x4*)(XKS + drow * 1024 + c8 * 8) = w; }
    { Frame F2 = F; F2.bid = b0; F2.G = bstride; int rot = 0;
      for (int bb = 0; bb < 32; ++bb) wconv<MapId, false>(F2, XVTS + (size_t)bb * 262144, cv + (size_t)bb * 262144, 1024, 256, 1024, MapId(), nullptr, nullptr, 0, rot); }
}

#define XB_TMO      128
#define XB_XCNT(j)  (256  + 64 * (j))
#define XB_XSUB(j)  (1280 + 64 * (j))
#define XB_XGEN(j)  (2304 + 64 * (j))
#define XB_TOP      3328
#define XB_TOPGEN   3392
#define XCD_BAR_WORDS 3456
#define XB_SPIN_CAP (1u << 18)

__device__ __forceinline__ unsigned xb_ld(unsigned* p)              { return __hip_atomic_load(p, __ATOMIC_RELAXED, __HIP_MEMORY_SCOPE_AGENT); }
__device__ __forceinline__ unsigned xb_add(unsigned* p, unsigned v) { return __hip_atomic_fetch_add(p, v, __ATOMIC_RELAXED, __HIP_MEMORY_SCOPE_AGENT); }
__device__ __forceinline__ unsigned xb_xcc_id() { return (unsigned)__builtin_amdgcn_s_getreg((3 << 11) | 20) & 0xFu; }
#define XB_SPIN(cond, bar) do { unsigned _sp = 0; while (cond) { __builtin_amdgcn_s_sleep(1); \
    if ((++_sp & 255u) == 0u) { if (xb_ld(&(bar)[XB_TMO])) break; if (_sp > XB_SPIN_CAP) { atomicAdd(&(bar)[XB_TMO], 1u); break; } } } } while (0)

struct XcdBarrier {
    unsigned* bar; unsigned x;
    volatile LAS unsigned* st;
};

__device__ __forceinline__ XcdBarrier xcd_barrier_post(unsigned* bar, volatile LAS unsigned* st) {
    XcdBarrier b; b.bar = bar; b.x = xb_xcc_id(); b.st = st;
    if (threadIdx.x == 0) (void)xb_add(&bar[XB_XCNT(b.x)], 1u);
    return b;
}
__device__ __forceinline__ void xcd_barrier_complete(unsigned* bar, unsigned x, unsigned& nloc, unsigned& nx) {
    const unsigned G = gridDim.x * gridDim.y * gridDim.z;
    unsigned sum, cnt, mine, sp = 0u;
    for (;;) {
        sum = 0u; cnt = 0u; mine = 0u;
#pragma unroll
        for (unsigned j = 0; j < 16; ++j) { const unsigned c = xb_ld(&bar[XB_XCNT(j)]); sum += c; cnt += (c > 0u) ? 1u : 0u; mine = (j == x) ? c : mine; }
        if (sum == G) break;
        __builtin_amdgcn_s_sleep(1);
        if ((++sp & 255u) == 0u) { if (xb_ld(&bar[XB_TMO])) break; if (sp > XB_SPIN_CAP) { atomicAdd(&bar[XB_TMO], 1u); break; } }
    }
    nloc = mine > 0u ? mine : 1u; nx = cnt > 0u ? cnt : 1u;
}

__device__ __forceinline__ void xcd_barrier(const XcdBarrier& b) {
    asm volatile("s_waitcnt vmcnt(0)" ::: "memory");
    __syncthreads();
    if (threadIdx.x == 0) {
        unsigned* bar = b.bar;
        __builtin_amdgcn_s_waitcnt(0);
        unsigned nloc = b.st[0], nx = b.st[1];
        if (nloc == 0u) { xcd_barrier_complete(bar, b.x, nloc, nx); b.st[0] = nloc; b.st[1] = nx; }
        const unsigned old = xb_add(&bar[XB_XSUB(b.x)], 1u);
        const unsigned gen = old / nloc;
        if (old + 1u == (gen + 1u) * nloc) {
            __builtin_amdgcn_fence(__ATOMIC_RELEASE, "agent");
            asm volatile("s_waitcnt vmcnt(0)" ::: "memory");
            const unsigned og = xb_add(&bar[XB_TOP], 1u);
            const unsigned tg = og / nx;
            if (og + 1u == (tg + 1u) * nx) xb_add(&bar[XB_TOPGEN], 1u);
            else XB_SPIN(xb_ld(&bar[XB_TOPGEN]) == tg, bar);
            __builtin_amdgcn_fence(__ATOMIC_ACQUIRE, "agent");
            xb_add(&bar[XB_XGEN(b.x)], 1u);
            asm volatile("s_waitcnt vmcnt(0)" ::: "memory");
        } else {
            XB_SPIN(xb_ld(&bar[XB_XGEN(b.x)]) == gen, bar);
            __builtin_amdgcn_fence(__ATOMIC_ACQUIRE, "agent");
            asm volatile("s_waitcnt vmcnt(0)" ::: "memory");
        }
    }
    __syncthreads();
}

constexpr int NPHASE = 13;
#ifndef PHASE_MASK
#define PHASE_MASK 0x1FFF
#endif
#ifndef SUBMASK
#define SUBMASK 0xFF
#endif
#define SUB(j) if ((SUBMASK >> (j)) & 1)
#ifndef DUP_MASK
#define DUP_MASK 0
#endif
#define DUP(k) _Pragma("unroll") for (int rep_ = 0; rep_ < (((DUP_MASK >> (k)) & 1) ? 2 : 1); ++rep_)
#define PH(k) if (!((PHASE_MASK >> (k)) & 1)) break;
using pg8::Gemm; using pg8::StaticOrder;
#define RUN_GEMM_LN(EPI, gm, e, PS_, PQ_) do { StaticOrder S_; S_.init((gm).M, (gm).N, F.G, F.bid, 0); ln_fill_tab(S_, PS_, PQ_, (LAS float*)(F.lds + 131072)); pg8::gemm_phase<EPI, StaticOrder, true, true>(F.lds, gm, S_, e); } while (0)
#define RUN_GEMM(EPI, gm, e, rot) do { StaticOrder S_; S_.init((gm).M, (gm).N, F.G, F.bid, rot); pg8::gemm_phase<EPI, StaticOrder, true, true>(F.lds, gm, S_, e); } while (0)

#define WS (F.ws)
#define U (F.a->out)
#define YG ((bf16_t*)((unsigned char*)F.a->out + 36 * MiB))
#define STSSM ((float*)(WS + W_STSSM))
#define STMLA ((float*)(WS + W_STMLA))
#define ST1 ((float*)(WS + W_ST1))
#define ST2 ((float*)(WS + W_ST2))
#define KN ((bf16_t*)(WS + A_KN))
#define VT ((bf16_t*)(WS + A_VT))
#define Q ((bf16_t*)(WS + A_Q))
#define KPE ((bf16_t*)(WS + A_KPE))
#define MIX ((bf16_t*)(WS + A_MIX))
#define R (F.a->out + O_Y)
__global__ void __launch_bounds__(512, 2) fwd_kernel(Args a) {
    extern __shared__ __attribute__((aligned(16))) unsigned char lds_raw[];
    Frame F;
    F.a = (const Args*)__builtin_amdgcn_kernarg_segment_ptr();
    F.out = a.out; F.ws = a.ws; F.lds = (LAS unsigned char*)lds_raw; F.tid = threadIdx.x; F.lane = F.tid & 63; F.wid = __builtin_amdgcn_readfirstlane(F.tid >> 6); F.G = gridDim.x; F.bid = blockIdx.x;
    const int lo = a.ph_lo, hi = a.ph_hi;
    volatile LAS unsigned* bst = (volatile LAS unsigned*)(F.lds + LDS_BYTES - 16);
    if (F.tid < 2) bst[F.tid] = 0u;
    __syncthreads();
    (void)xcd_barrier_post((unsigned*)(WS + W_BAR), bst);
    if (hi > 1000) cg::this_grid().sync();
#define GSYNC(k) if ((k) + 1 < hi) { XcdBarrier b_; b_.bar = (unsigned*)(F.a->ws + W_BAR); b_.x = xb_xcc_id(); b_.st = (volatile LAS unsigned*)(F.lds + LDS_BYTES - 16); xcd_barrier(b_); }
        if (((PHASE_MASK >> 0) & 1) && lo <= 0 && 0 < hi) DUP(0) { prologue(F); }
        if (lo <= 0 && 0 < hi) GSYNC(0)
        if (((PHASE_MASK >> 1) & 1) && lo <= 1 && 1 < hi) DUP(1) { {
            SUB(0) { Gemm g{(const bf16_t*)(WS + A_XB), (const bf16_t*)(WS + W_WIN), MTOK, 1280, 1024}; EpiProj e{U, (float*)(WS + A_PQ)}; RUN_GEMM(EpiProj, g, e, 0); }
            SUB(1) { Gemm g{(const bf16_t*)(WS + W_MEMB), (const bf16_t*)(WS + W_WXK), 256, 1024, 1024}; EpiStore<false> e{(bf16_t*)(WS + W_XK0), 1024, F.a->out + O_MKP, 1024, nullptr, 0, 1}; RUN_GEMM(EpiStore<false>, g, e, 172); }
            SUB(2) { Gemm g{(const bf16_t*)(WS + W_WXV), (const bf16_t*)(WS + W_MEMB), 1024, 256, 1024}; EpiStore<false> e{(bf16_t*)(WS + W_XVT0), 256, nullptr, 0, F.a->out + O_MVP, 1024, 0}; RUN_GEMM(EpiStore<false>, g, e, 168); }
            if (F.G > 92) { if (F.bid >= 92) cvt_caches(F, F.bid - 92, F.G - 92); } else cvt_caches(F, F.bid, F.G);
        } }
        if (lo <= 1 && 1 < hi) GSYNC(1)
        if (((PHASE_MASK >> 2) & 1) && lo <= 2 && 2 < hi) DUP(2) { post_rows(F); ssm_pass_a(F); }
        if (lo <= 2 && 2 < hi) GSYNC(2)
        if (((PHASE_MASK >> 3) & 1) && lo <= 3 && 3 < hi) DUP(3) { {
            const bool fuse34 = lo <= 3 && 4 < hi && F.G >= 8; unsigned* cnt3 = (unsigned*)(WS + W_BAR + 14336) + 32;
            SUB(0) ssm_pass_b(F, F.bid - (F.G - 4)); asm volatile("s_waitcnt vmcnt(0)" ::: "memory"); __syncthreads();
            if (fuse34 && F.bid >= F.G - 4 && F.tid == 0) { __builtin_amdgcn_fence(__ATOMIC_RELEASE, "agent"); asm volatile("s_waitcnt vmcnt(0)" ::: "memory"); __hip_atomic_fetch_add(cnt3, 1u, __ATOMIC_RELAXED, __HIP_MEMORY_SCOPE_AGENT); }
            SUB(1) { Gemm g{(const bf16_t*)(WS + A_CQN), (const bf16_t*)(WS + W_WQ), MTOK, 768, 384}; EpiQ e{Q}; RUN_GEMM(EpiQ, g, e, 0); }
            SUB(2) { Gemm g{(const bf16_t*)(WS + A_CKV), (const bf16_t*)(WS + W_WK), KVROWS, 512, 256}; EpiStore<false> e{KN, 512, nullptr, 0, nullptr, 0, 1}; RUN_GEMM(EpiStore<false>, g, e, 52); }
            SUB(3) { Gemm g{(const bf16_t*)(WS + W_WV), (const bf16_t*)(WS + A_CKV), 512, KVROWS, 256}; EpiStore<false> e{VT, KVPAD, nullptr, 0, nullptr, 0, 0}; RUN_GEMM(EpiStore<false>, g, e, 172); }
            if (fuse34) {
                if (F.tid == 0) { unsigned sp = 0; while (__hip_atomic_load(cnt3, __ATOMIC_RELAXED, __HIP_MEMORY_SCOPE_AGENT) < 4u) { __builtin_amdgcn_s_sleep(2); if (++sp > (1u << 22)) break; }
                    __builtin_amdgcn_fence(__ATOMIC_ACQUIRE, "agent"); asm volatile("s_waitcnt vmcnt(0)" ::: "memory"); }
                __syncthreads();
                ssm_pass_c(F); }
        } }
        if (lo <= 3 && 3 < hi && !(lo <= 3 && 4 < hi && F.G >= 8)) GSYNC(3)
        if (((PHASE_MASK >> 4) & 1) && lo <= 4 && 4 < hi && !(lo <= 3 && 4 < hi && F.G >= 8)) DUP(4) { ssm_pass_c(F); }
        if (lo <= 4 && 4 < hi) GSYNC(4)
        if (((PHASE_MASK >> 5) & 1) && lo <= 5 && 5 < hi) DUP(5) { {
            SUB(0) { Gemm g{YG, (const bf16_t*)(WS + W_WGLU), MTOK, 1024, 512}; EpiGlu e{MIX, STSSM}; RUN_GEMM(EpiGlu, g, e, 0); }
            SUB(1) DUP(13) for (int it = F.bid; it < 256; it += F.G) { const int y = it >> 2, h = it & 3;
                for (int pass = 0; pass < 2; ++pass) { const int x = pass ? y : 127 - y, q0 = x * 128, rg = F.wid & 3;
                    attn_unit<192, 128, 128, false>(F.lds, Q + (size_t)q0 * 768 + h * 192, 768, KN + h * 128, 512, KPE, VT + (size_t)(h * 128) * KVPAD, KVPAD,
                                                    (q0 >> 6) + 2, 64 * ((q0 >> 6) + (rg >> 1) + 1), MIX + (size_t)q0 * 1024 + 512 + h * 128, 1024, STMLA + (size_t)h * MTOK + q0, 128); } }
            SUB(2) DUP(14) for (int it = F.G - 1 - F.bid; it < 128; it += F.G) { const int b = it >> 2, h = it & 3, q0 = TP + b * 32, k0 = TP + b * KVS, rg = F.wid & 3;
                attn_unit<192, 128, 128, false>(F.lds, Q + (size_t)q0 * 768 + h * 192, 768, KN + (size_t)k0 * 512 + h * 128, 512, KPE + (size_t)k0 * 64, VT + (size_t)(h * 128) * KVPAD + k0, KVPAD,
                                                17, rg == 0 ? KVS : 0, MIX + (size_t)q0 * 1024 + 512 + h * 128, 1024, STMLA + (size_t)h * MTOK + q0, 32); }
        } }
        if (lo <= 5 && 5 < hi) GSYNC(5)
        if (((PHASE_MASK >> 6) & 1) && lo <= 6 && 6 < hi) DUP(6) { {
            { Gemm g{MIX, (const bf16_t*)(WS + W_WO), MTOK, 1024, 1024};
              LAS float* tab = (LAS float*)(F.lds + 131072);
              EpiRes<0> e{F.a->in[0], F.a->in[1], R, (bf16_t*)(WS + A_R1B), nullptr, nullptr, nullptr, nullptr, ST1, ST1 + 16 * MTOK, tab};
              StaticOrder S_; S_.init(g.M, g.N, F.G, F.bid, 0); Unit u0;
              if (S_.next(0, u0)) wo_fill_tab(u0, STSSM, STMLA, tab);
              if (S_.next(1, u0)) wo_fill_tab(u0, STSSM, STMLA, tab);
              __syncthreads();
              pg8::gemm_phase<EpiRes<0>, StaticOrder, true, true>(F.lds, g, S_, e); }
            if (F.G > 16) { if (F.bid >= 16) cvt_memcache(F, F.bid - 16, F.G - 16); } else cvt_memcache(F, F.bid, F.G);
        } }
        if (lo <= 6 && 6 < hi) GSYNC(6)
        if (((PHASE_MASK >> 7) & 1) && lo <= 7 && 7 < hi) DUP(7) { { Gemm g{(const bf16_t*)(WS + A_R1B), (const bf16_t*)(WS + W_WXQ), (F.G >= 80) ? TP : MTOK, 1024, 1024};
            EpiLnAct<0> e{(const LAS float*)(F.lds + 131072), (const float*)(WS + W_CSXQ), (const float*)(WS + W_BWXQ), (bf16_t*)(WS + A_XQ), 1024}; RUN_GEMM_LN(EpiLnAct<0>, g, e, ST1, ST1 + 16 * MTOK); } }
        if (lo <= 7 && 7 < hi) GSYNC(7)
        if (((PHASE_MASK >> 8) & 1) && lo <= 8 && 8 < hi) DUP(8) { {
            const bf16_t* XQ = (const bf16_t*)(WS + A_XQ); bf16_t* XO = (bf16_t*)(WS + A_XO); unsigned* cnt2 = (unsigned*)(WS + W_BAR + 14336) + 16;
            if (F.G >= 80 && F.bid >= F.G - 16) {
                const int u = F.bid - (F.G - 16), pm = TP / 256 + (u >> 2); LAS float* tab = (LAS float*)(F.lds + 131072);
                if (F.tid < 256) { float mu, rstd; ln_stats16(ST1, ST1 + 16 * MTOK, pm * 256 + F.tid, mu, rstd); tab[F.tid] = mu; tab[256 + F.tid] = rstd; }
                __syncthreads();
                Gemm gx{(const bf16_t*)(WS + A_R1B), (const bf16_t*)(WS + W_WXQ), MTOK, 1024, 1024}; pg8::OneUnitOrder Sx{pm, u & 3};
                EpiLnAct<0> ex{tab, (const float*)(WS + W_CSXQ), (const float*)(WS + W_BWXQ), (bf16_t*)(WS + A_XQ), 1024};
                pg8::gemm_phase<EpiLnAct<0>, pg8::OneUnitOrder, true, true>(F.lds, gx, Sx, ex);
                asm volatile("s_waitcnt vmcnt(0)" ::: "memory"); __syncthreads();
                if (F.tid == 0) { __builtin_amdgcn_fence(__ATOMIC_RELEASE, "agent"); asm volatile("s_waitcnt vmcnt(0)" ::: "memory"); __hip_atomic_fetch_add(cnt2, 1u, __ATOMIC_RELAXED, __HIP_MEMORY_SCOPE_AGENT); }
                __syncthreads(); }
            for (int it = F.bid; it < 640; it += F.G) {
                if (it >= 512 && F.G >= 80) {
                    if (F.tid == 0) { unsigned sp = 0; while (__hip_atomic_load(cnt2, __ATOMIC_RELAXED, __HIP_MEMORY_SCOPE_AGENT) < 16u) { __builtin_amdgcn_s_sleep(2); if (++sp > (1u << 22)) break; }
                        __builtin_amdgcn_fence(__ATOMIC_ACQUIRE, "agent"); asm volatile("s_waitcnt vmcnt(0)" ::: "memory"); }
                    __syncthreads(); }
                if (it < 512) { const int x = it >> 2, h = it & 3, q0 = x * 128;
                    attn_unit<256, 256, 256, true>(F.lds, XQ + (size_t)q0 * 1024 + h * 256, 1024, (const bf16_t*)(WS + W_XK0) + h * 256, 1024, nullptr, (const bf16_t*)(WS + W_XVT0) + (size_t)h * 65536, 256,
                                                   4, 256, XO + (size_t)q0 * 1024 + h * 256, 1024, nullptr, 128); }
                else { const int b = (it - 512) >> 2, h = it & 3, q0 = TP + b * 32, rg = F.wid & 3;
                    attn_unit<256, 256, 256, true>(F.lds, XQ + (size_t)q0 * 1024 + h * 256, 1024, (const bf16_t*)(WS + A_XKS) + (size_t)b * 262144 + h * 256, 1024, nullptr,
                                                   (const bf16_t*)(WS + A_XVTS) + (size_t)(b * 4 + h) * 65536, 256, 4, rg == 0 ? 256 : 0, XO + (size_t)q0 * 1024 + h * 256, 1024, nullptr, 32); } }
        } }
        if (lo <= 8 && 8 < hi) GSYNC(8)
        if (((PHASE_MASK >> 9) & 1) && lo <= 9 && 9 < hi) DUP(9) { { Gemm g{(const bf16_t*)(WS + A_XO), (const bf16_t*)(WS + W_WXO), (F.G >= 80) ? TP : MTOK, 1024, 1024};
            EpiRes<1> e{nullptr, nullptr, R, (bf16_t*)(WS + A_R2B), nullptr, nullptr, F.a->in[32], F.a->in[33], ST2, ST2 + 16 * MTOK, (const LAS float*)(F.lds + 131072)}; RUN_GEMM_LN(EpiRes<1>, g, e, ST1, ST1 + 16 * MTOK); } }
        if (lo <= 9 && 9 < hi) GSYNC(9)
        if (((PHASE_MASK >> 10) & 1) && lo <= 10 && 10 < hi) DUP(10) { {
            LAS float* tab = (LAS float*)(F.lds + 131072); unsigned* cnt = (unsigned*)(WS + W_BAR + 14336);
            if (F.G >= 80 && F.bid >= F.G - 16) { const int u = F.bid - (F.G - 16); const int pm = TP / 256 + (u >> 2);
                if (F.tid < 256) { float mu, rstd; ln_stats16(ST1, ST1 + 16 * MTOK, pm * 256 + F.tid, mu, rstd); tab[F.tid] = mu; tab[256 + F.tid] = rstd; }
                __syncthreads();
                Gemm gx{(const bf16_t*)(WS + A_XO), (const bf16_t*)(WS + W_WXO), MTOK, 1024, 1024}; pg8::OneUnitOrder Sx{pm, u & 3};
                EpiRes<1> ex{nullptr, nullptr, R, (bf16_t*)(WS + A_R2B), nullptr, nullptr, F.a->in[32], F.a->in[33], ST2, ST2 + 16 * MTOK, tab};
                pg8::gemm_phase<EpiRes<1>, pg8::OneUnitOrder, true, true>(F.lds, gx, Sx, ex);
                asm volatile("s_waitcnt vmcnt(0)" ::: "memory"); __syncthreads();
                if (F.tid == 0) { __builtin_amdgcn_fence(__ATOMIC_RELEASE, "agent"); asm volatile("s_waitcnt vmcnt(0)" ::: "memory"); __hip_atomic_fetch_add(cnt, 1u, __ATOMIC_RELAXED, __HIP_MEMORY_SCOPE_AGENT); }
                __syncthreads(); }
            EpiLnAct<1> e{tab, (const float*)(WS + W_CSFF1), (const float*)(WS + W_BWFF1), (bf16_t*)(WS + A_Z), 4096};
            { Gemm g{(const bf16_t*)(WS + A_R2B), (const bf16_t*)(WS + W_WFF1), (F.G >= 80) ? TP : MTOK, 4096, 1024}; RUN_GEMM_LN(EpiLnAct<1>, g, e, ST2, ST2 + 16 * MTOK); }
            if (F.G >= 80 && F.bid < 64) {
                if (F.tid == 0) { unsigned sp = 0; while (__hip_atomic_load(cnt, __ATOMIC_RELAXED, __HIP_MEMORY_SCOPE_AGENT) < 16u) { __builtin_amdgcn_s_sleep(2); if (++sp > (1u << 22)) break; }
                    __builtin_amdgcn_fence(__ATOMIC_ACQUIRE, "agent"); asm volatile("s_waitcnt vmcnt(0)" ::: "memory"); }
                __syncthreads();
                const int pm = TP / 256 + (F.bid >> 4);
                if (F.tid < 256) { float mu, rstd; ln_stats16(ST2, ST2 + 16 * MTOK, pm * 256 + F.tid, mu, rstd); tab[F.tid] = mu; tab[256 + F.tid] = rstd; }
                __syncthreads();
                Gemm gs{(const bf16_t*)(WS + A_R2B), (const bf16_t*)(WS + W_WFF1), MTOK, 4096, 1024}; pg8::OneUnitOrder Ss{pm, F.bid & 15};
                pg8::gemm_phase<EpiLnAct<1>, pg8::OneUnitOrder, true, true>(F.lds, gs, Ss, e); } } }
        if (lo <= 10 && 10 < hi) GSYNC(10)
        if (((PHASE_MASK >> 11) & 1) && lo <= 11 && 11 < hi) DUP(11) { { Gemm g{(const bf16_t*)(WS + A_Z), (const bf16_t*)(WS + W_WFF2), TP, 1024, 4096};
            EpiRes<1> e{nullptr, nullptr, R, nullptr, nullptr, nullptr, F.a->in[32] + 1024, F.a->in[33] + 1024, ST1, ST1 + 16 * MTOK, (const LAS float*)(F.lds + 131072)}; RUN_GEMM_LN(EpiRes<1>, g, e, ST2, ST2 + 16 * MTOK); }
          { Gemm g{(const bf16_t*)(WS + A_Z) + (size_t)TP * 4096, (const bf16_t*)(WS + W_WFF2), TS, 1024, 512, 4096};
            pg8::SplitKOrder S_{16, 4, 8, 512, F.G, F.bid}; EpiSlab e{(float*)(WS + A_R2B)}; pg8::gemm_phase<EpiSlab, pg8::SplitKOrder, true, true>(F.lds, g, S_, e); } }
        if (lo <= 11 && 11 < hi) GSYNC(11)
        if (((PHASE_MASK >> 12) & 1) && lo <= 12 && 12 < hi) DUP(12) { final_ln(F); }
}

#undef WS
#undef U
#undef YG
#undef STSSM
#undef STMLA
#undef ST1
#undef ST2
#undef KN
#undef VT
#undef Q
#undef KPE
#undef MIX
#undef R
extern "C" void kernel_launch(void* const* d_in, const int* in_sizes, int n_in, void* d_out, int out_size, void* d_ws, size_t ws_size, hipStream_t stream) {
    static int grid = 0;
    if (grid == 0) {
        int dev = 0, cus = 0, per_cu = 0;
        (void)hipGetDevice(&dev); (void)hipDeviceGetAttribute(&cus, hipDeviceAttributeMultiprocessorCount, dev);
        if (hipFuncSetAttribute((const void*)fwd_kernel, hipFuncAttributeMaxDynamicSharedMemorySize, LDS_BYTES) != hipSuccess) fprintf(stderr, "kernel_launch: hipFuncSetAttribute failed\n");
        if (hipOccupancyMaxActiveBlocksPerMultiprocessor(&per_cu, (const void*)fwd_kernel, 512, LDS_BYTES) != hipSuccess || per_cu < 1) { fprintf(stderr, "kernel_launch: occupancy query says %d\n", per_cu); per_cu = 1; }
        (void)hipGetLastError();
        grid = cus > 0 ? cus : 256;
        if (n_in != 34 || ws_size < WS_END) fprintf(stderr, "kernel_launch: unexpected n_in %d / ws_size %zu (need %zu)\n", n_in, ws_size, (size_t)WS_END);
    }
    if (hipMemsetAsync((char*)d_ws + W_BAR, 0, BAR_BYTES, stream) != hipSuccess) fprintf(stderr, "kernel_launch: memset failed\n");
    Args a{};
    for (int i = 0; i < 34; ++i) a.in[i] = (const float*)d_in[i];
    a.out = (float*)d_out; a.ws = (unsigned char*)d_ws;
#if N_LAUNCH_MODE == 1
    a.ph_lo = 0; a.ph_hi = NPHASE;
    void* args[] = {&a};
    hipError_t e = hipLaunchCooperativeKernel((const void*)fwd_kernel, dim3(grid), dim3(512), args, LDS_BYTES, stream);
    if (e != hipSuccess) fprintf(stderr, "cooperative launch failed: %s (grid %d)\n", hipGetErrorString(e), grid);
#else
    for (int ph = 0; ph < NPHASE; ++ph) { a.ph_lo = ph; a.ph_hi = ph + 1; hipLaunchKernelGGL(fwd_kernel, dim3(grid), dim3(512), LDS_BYTES, stream, a); }
#endif
}
```
